# Optimizing an MI355X kernel written in HIP

```python
import jax, jax.numpy as jnp
from jax import lax
import numpy as np

D_MODEL = 1024
BATCH = 1
SEQ = 16384
DEPTH = 2

MIX_WIDTH = D_MODEL
CONV_WIDTH = MIX_WIDTH // 2
ATT_WIDTH = MIX_WIDTH - CONV_WIDTH
HEAD_DIM = 64
N_ATT_HEADS = ATT_WIDTH // HEAD_DIM
N_CONV_GROUPS = CONV_WIDTH // HEAD_DIM
CONV_K = 3
N_MEM = 256
N_XHEADS = 4
XHEAD_DIM = D_MODEL // N_XHEADS
D_FF = 2816
Q_BLOCK = 128
EPS = 1e-6
IN_COLS = 3 * CONV_WIDTH + 3 * ATT_WIDTH + N_ATT_HEADS
SPLITS = [CONV_WIDTH, 2 * CONV_WIDTH, 3 * CONV_WIDTH,
          3 * CONV_WIDTH + ATT_WIDTH, 3 * CONV_WIDTH + 2 * ATT_WIDTH,
          3 * CONV_WIDTH + 3 * ATT_WIDTH]

kernel_name = "hybrid_conv_fox_macaron_memxattn"


def rmsnorm(x, g):
    xf = x.astype(jnp.float32)
    y = xf * lax.rsqrt(jnp.mean(xf * xf, axis=-1, keepdims=True) + EPS)
    return (y * g.astype(jnp.float32)).astype(x.dtype)


def swiglu(h, w_gu, w_down):
    gate, up = jnp.split(h @ w_gu, 2, axis=-1)
    return (jax.nn.silu(gate) * up) @ w_down


def causal_depthwise_conv(u, w):
    kern = w[:, None, :].astype(u.dtype)
    return lax.conv_general_dilated(
        u, kern, window_strides=(1,), padding=[(CONV_K - 1, 0)],
        dimension_numbers=('NWC', 'WIO', 'NWC'), feature_group_count=u.shape[-1])


def forgetting_attention(q, k, v, log_f):
    B, S, H, Dh = q.shape
    nb = S // Q_BLOCK
    scale = Dh ** -0.5
    c = jnp.cumsum(log_f, axis=1).transpose(0, 2, 1)
    qb = q.reshape(B, nb, Q_BLOCK, H, Dh).transpose(1, 0, 3, 2, 4)
    cqb = c.reshape(B, H, nb, Q_BLOCK).transpose(2, 0, 1, 3)
    kpos = jnp.arange(S)

    def block(args):
        i, q_i, cq_i = args
        s = jnp.einsum('bhqd,bkhd->bhqk', q_i, k,
                       preferred_element_type=jnp.float32) * scale
        s = s + cq_i[..., None] - c[:, :, None, :]
        qpos = i * Q_BLOCK + jnp.arange(Q_BLOCK)
        mask = kpos[None, :] <= qpos[:, None]
        s = jnp.where(mask, s, -jnp.inf)
        p = jax.nn.softmax(s, axis=-1)
        return jnp.einsum('bhqk,bkhd->bqhd', p.astype(v.dtype), v)

    out = lax.map(block, (jnp.arange(nb), qb, cqb))
    return out.transpose(1, 0, 2, 3, 4).reshape(B, S, H * Dh)


def memory_cross_attention(h, m, w_q, w_kv, w_o):
    B, S, _ = h.shape
    M = m.shape[1]
    q = (h @ w_q).reshape(B, S, N_XHEADS, XHEAD_DIM)
    k, v = jnp.split(m @ w_kv, 2, axis=-1)
    k = k.reshape(B, M, N_XHEADS, XHEAD_DIM)
    v = v.reshape(B, M, N_XHEADS, XHEAD_DIM)
    s = jnp.einsum('bshd,bmhd->bhsm', q, k,
                   preferred_element_type=jnp.float32) * (XHEAD_DIM ** -0.5)
    p = jax.nn.softmax(s, axis=-1)
    o = jnp.einsum('bhsm,bmhd->bshd', p.astype(v.dtype), v).reshape(B, S, D_MODEL)
    return o @ w_o


def setup_inputs(seed: int = 0) -> dict:
    key = jax.random.key(seed)
    ks = jax.random.split(key, 24)
    f32 = jnp.float32

    def w(k, shape, fan_in):
        return jax.random.normal(k, shape, f32) * (fan_in ** -0.5)

    def gain(k, shape):
        return 1.0 + 0.1 * jax.random.normal(k, shape, f32)

    return {
        "x": jax.random.normal(ks[0], (BATCH, SEQ, D_MODEL), f32),
        "mem": jax.random.normal(ks[1], (BATCH, N_MEM, D_MODEL), f32),
        "g_ffn1": gain(ks[2], (DEPTH, D_MODEL)),
        "w_ffn1_gu": w(ks[3], (DEPTH, D_MODEL, 2 * D_FF), D_MODEL),
        "w_ffn1_down": w(ks[4], (DEPTH, D_FF, D_MODEL), D_FF),
        "g_mix": gain(ks[5], (DEPTH, D_MODEL)),
        "w_mix_in": w(ks[6], (DEPTH, D_MODEL, IN_COLS), D_MODEL),
        "w_conv": w(ks[7], (DEPTH, CONV_K, CONV_WIDTH), CONV_K),
        "b_f": 2.0 + 0.5 * jax.random.normal(ks[8], (DEPTH, N_ATT_HEADS), f32),
        "g_conv_out": gain(ks[9], (DEPTH, CONV_WIDTH)),
        "g_att_out": gain(ks[10], (DEPTH, ATT_WIDTH)),
        "w_mix_out": w(ks[11], (DEPTH, MIX_WIDTH, D_MODEL), MIX_WIDTH),
        "g_xattn": gain(ks[12], (DEPTH, D_MODEL)),
        "g_mem": gain(ks[13], (DEPTH, D_MODEL)),
        "w_xq": w(ks[14], (DEPTH, D_MODEL, D_MODEL), D_MODEL),
        "w_xkv": w(ks[15], (DEPTH, D_MODEL, 2 * D_MODEL), D_MODEL),
        "w_xo": w(ks[16], (DEPTH, D_MODEL, D_MODEL), D_MODEL),
        "g_ffn2": gain(ks[17], (DEPTH, D_MODEL)),
        "w_ffn2_gu": w(ks[18], (DEPTH, D_MODEL, 2 * D_FF), D_MODEL),
        "w_ffn2_down": w(ks[19], (DEPTH, D_FF, D_MODEL), D_FF),
        "g_final": gain(ks[20], (D_MODEL,)),
    }


def reference(x, mem, g_ffn1, w_ffn1_gu, w_ffn1_down, g_mix, w_mix_in, w_conv, b_f,
              g_conv_out, g_att_out, w_mix_out, g_xattn, g_mem, w_xq, w_xkv, w_xo,
              g_ffn2, w_ffn2_gu, w_ffn2_down, g_final):
    B, S, _ = x.shape
    for l in range(DEPTH):
        x = x + 0.5 * swiglu(rmsnorm(x, g_ffn1[l]), w_ffn1_gu[l], w_ffn1_down[l])

        h = rmsnorm(x, g_mix[l])
        z = h @ w_mix_in[l]
        zb, zc, zv, zq, zk, zval, zf = jnp.split(z, SPLITS, axis=-1)

        y_conv = zb * causal_depthwise_conv(zc * zv, w_conv[l])

        log_f = jax.nn.log_sigmoid((zf + b_f[l]).astype(jnp.float32))
        q = zq.reshape(B, S, N_ATT_HEADS, HEAD_DIM)
        k = zk.reshape(B, S, N_ATT_HEADS, HEAD_DIM)
        v = zval.reshape(B, S, N_ATT_HEADS, HEAD_DIM)
        y_att = forgetting_attention(q, k, v, log_f)

        y = jnp.concatenate([rmsnorm(y_conv, g_conv_out[l]),
                             rmsnorm(y_att, g_att_out[l])], axis=-1)
        x = x + y @ w_mix_out[l]

        x = x + memory_cross_attention(rmsnorm(x, g_xattn[l]), rmsnorm(mem, g_mem[l]),
                                       w_xq[l], w_xkv[l], w_xo[l])

        x = x + 0.5 * swiglu(rmsnorm(x, g_ffn2[l]), w_ffn2_gu[l], w_ffn2_down[l])
    return rmsnorm(x, g_final)
```

```cpp
#include <hip/hip_runtime.h>
#include <hip/hip_cooperative_groups.h>
#include <cstdio>
#include <cstdint>
#include <cmath>
typedef unsigned wt_u32x4 __attribute__((ext_vector_type(4)));
__device__ __forceinline__ void store16_wt(void* p, wt_u32x4 v) { asm volatile("global_store_dwordx4 %0, %1, off sc1\n\ts_nop 1" :: "v"(p), "v"(v) : "memory"); }
__device__ __forceinline__ float lane_get(float v, int src_lane) { return __builtin_bit_cast(float, __builtin_amdgcn_ds_bpermute(src_lane << 2, __builtin_bit_cast(int, v))); }
namespace pg8 {
#define PG8_LAS __attribute__((address_space(3)))
typedef unsigned short bf16_t;
typedef short bf16x8 __attribute__((ext_vector_type(8)));
typedef float f32x4 __attribute__((ext_vector_type(4)));
typedef unsigned u32x4 __attribute__((ext_vector_type(4)));
constexpr int BM = 256, BK = 64, HALF = 128, HTB = HALF * BK * 2  , STAGE_BYTES = 8 * HTB, NXCD = 8, WGM = 8;

__host__ __device__ __forceinline__ int lds_byte(int r, int c) { const int st = (r >> 4) * 2 + (c >> 5), rr = r & 15, cc = c & 31, ob = rr * 64 + cc * 2; return st * 1024 + (ob ^ (((ob >> 9) & 1) << 5)); }
__host__ __device__ __forceinline__ void stage_rc(int b, int& R, int& C) { const int st = b / 1024, sb = b % 1024, swz = sb ^ (((sb >> 9) & 1) << 5); R = (st >> 1) * 16 + swz / 64; C = (st & 1) * 32 + (swz % 64) / 2; }
__host__ __device__ __forceinline__ int perm32(int rho) { const int n = rho >> 4, i = rho & 15; return 8 * (i >> 2) + 4 * n + (i & 3); }

struct Unit { int pm, pn; };
struct Gemm { const bf16_t* A; const bf16_t* Bt; int M, N, K; int lda, ldb; long a_pn, b_pn; };

struct StaticOrder {
    int nM, nN, nwg, G, c;
    __host__ __device__ __forceinline__ void init(int M, int N, int G_, int c_) { nM = M / BM; nN = N / BM; nwg = nM * nN; G = G_; c = c_; }
    __host__ __device__ __forceinline__ bool next(int i, Unit& u) const {
        const long L = (long)i * G + c; if (L >= nwg) return false;
        int wgid = (int)L; { const int q = nwg / NXCD, r = nwg % NXCD, xcd = wgid % NXCD, off = wgid / NXCD; wgid = (xcd < r ? xcd * (q + 1) : r * (q + 1) + (xcd - r) * q) + off; }
        const int nig = WGM * nN, gid = wgid / nig, fm = gid * WGM, gsz = (nM - fm) < WGM ? (nM - fm) : WGM;
        u.pm = fm + ((wgid % nig) % gsz); u.pn = (wgid % nig) / gsz; return true;
    }
    __device__ __forceinline__ void a_ready(const Unit&) const {}
    __device__ __forceinline__ void done(const Unit&) const {}
};

__device__ __forceinline__ unsigned cvt_pk_bf16(float lo, float hi) { unsigned r; asm volatile("v_cvt_pk_bf16_f32 %0, %1, %2" : "=v"(r) : "v"(lo), "v"(hi)); return r; }
typedef float f32x2 __attribute__((ext_vector_type(2)));
__device__ __forceinline__ float row_rstd(const float* stats, int row) { const f32x4* sp = (const f32x4*)(stats + (size_t)row * 16); const f32x4 a = sp[0], b = sp[1], c = sp[2], d = sp[3];
    const float s = ((a[0] + a[1]) + (a[2] + a[3])) + ((b[0] + b[1]) + (b[2] + b[3])) + ((c[0] + c[1]) + (c[2] + c[3])) + ((d[0] + d[1]) + (d[2] + d[3])); return rsqrtf(s * (1.0f / 1024.0f) + 1e-6f); }
template <class Sched> __device__ __forceinline__ void fill_rstd_table(PG8_LAS float* rsL, const float* stats, const Sched& S, int tid) {
    Unit u; int n = 0; while (n < 8 && S.next(n, u)) ++n;
    for (int idx = tid; idx < n * 256; idx += 512) { S.next(idx >> 8, u); rsL[idx] = row_rstd(stats, u.pm * BM + (idx & 255)); }
    asm volatile("s_waitcnt lgkmcnt(0)" ::: "memory"); __builtin_amdgcn_s_barrier(); asm volatile("" ::: "memory");
}
struct EpiScaleBf16 {
    static constexpr bool PERM = true, AFTER_DRAIN = false, HAS_INIT = false;
    bf16_t* O; int ldc; float s_all; int pn_lo, pn_hi; float s_rng; const float* stats; bool wt;
    __device__ __forceinline__ void operator()(const f32x4 (&acc)[2][2][4][2], const Unit& u, int wr, int wc, int fr, int fq, int ui) const {
        const int row0 = u.pm * BM + wr * 64 + fr, col0 = u.pn * BM + wc * 32 + 8 * fq;
        const float sc = (u.pn >= pn_lo && u.pn < pn_hi) ? s_rng : s_all;
        float rs[2][4];
#pragma unroll
        for (int ai = 0; ai < 2; ++ai)
#pragma unroll
            for (int m = 0; m < 4; ++m) rs[ai][m] = stats ? row_rstd(stats, row0 + ai * HALF + m * 16) : 1.0f;
#pragma unroll
        for (int ai = 0; ai < 2; ++ai)
#pragma unroll
            for (int m = 0; m < 4; ++m) { bf16_t* rowp = O + (size_t)(row0 + ai * HALF + m * 16) * ldc + col0; const float scr = sc * rs[ai][m];
#pragma unroll
                for (int bj = 0; bj < 2; ++bj) { const f32x4 v0 = acc[ai][bj][m][0] * scr, v1 = acc[ai][bj][m][1] * scr;
                    u32x4 w; w.x = cvt_pk_bf16(v0[0], v0[1]); w.y = cvt_pk_bf16(v0[2], v0[3]); w.z = cvt_pk_bf16(v1[0], v1[1]); w.w = cvt_pk_bf16(v1[2], v1[3]);
                    if (wt) store16_wt(rowp + bj * HALF, w); else *(u32x4*)(rowp + bj * HALF) = w; } }
    }
};
struct EpiMixIn {
    static constexpr bool PERM = true, AFTER_DRAIN = false, HAS_INIT = false;
    bf16_t* O; int ldc; float qscale; float* kpart; const PG8_LAS float* rsL;
    __device__ __forceinline__ void operator()(const f32x4 (&acc)[2][2][4][2], const Unit& u, int wr, int wc, int fr, int fq, int ui) const {
        const int row0 = u.pm * BM + wr * 64 + fr, col0 = u.pn * BM + wc * 32 + 8 * fq;
        const float sc = (u.pn == 6 || u.pn == 7) ? qscale : 1.0f;
        float rs[2][4];
#pragma unroll
        for (int ai = 0; ai < 2; ++ai)
#pragma unroll
            for (int m = 0; m < 4; ++m) rs[ai][m] = rsL[ui * 256 + wr * 64 + fr + ai * HALF + m * 16];
#pragma unroll
        for (int ai = 0; ai < 2; ++ai)
#pragma unroll
            for (int m = 0; m < 4; ++m) { bf16_t* rowp = O + (size_t)(row0 + ai * HALF + m * 16) * ldc + col0; const float scr = sc * rs[ai][m];
#pragma unroll
                for (int bj = 0; bj < 2; ++bj) { const f32x4 v0 = acc[ai][bj][m][0] * scr, v1 = acc[ai][bj][m][1] * scr;
                    u32x4 w; w.x = cvt_pk_bf16(v0[0], v0[1]); w.y = cvt_pk_bf16(v0[2], v0[3]); w.z = cvt_pk_bf16(v1[0], v1[1]); w.w = cvt_pk_bf16(v1[2], v1[3]);
                    store16_wt(rowp + bj * HALF, w); } }
        if (u.pn == 8 || u.pn == 9) { const int lane = fq * 16 + fr;
#pragma unroll
            for (int bj = 0; bj < 2; ++bj) { float mx = 0.f;
#pragma unroll
                for (int ai = 0; ai < 2; ++ai)
#pragma unroll
                    for (int m = 0; m < 4; ++m) { const f32x4 a0 = acc[ai][bj][m][0], a1 = acc[ai][bj][m][1];
                        float p = ((a0[0] * a0[0] + a0[1] * a0[1]) + (a0[2] * a0[2] + a0[3] * a0[3])) + ((a1[0] * a1[0] + a1[1] * a1[1]) + (a1[2] * a1[2] + a1[3] * a1[3]));
                        p *= rs[ai][m] * rs[ai][m]; p += lane_get(p, lane ^ 16); p += lane_get(p, lane ^ 32); mx = fmaxf(mx, p); }
#pragma unroll
                for (int o = 1; o < 16; o <<= 1) mx = fmaxf(mx, lane_get(mx, lane ^ o));
                if (lane == 0) atomicMax((unsigned*)(kpart + ((u.pn - 8) * 4 + 2 * bj + (wc >> 1)) * 2 + (wc & 1)), __float_as_uint(mx)); } }
    }
};
__device__ __forceinline__ f32x4 silu_mul4(f32x4 g, f32x4 u) { const f32x4 t = g * (-1.4426950408889634f); f32x4 e;
    e[0] = __builtin_amdgcn_exp2f(t[0]); e[1] = __builtin_amdgcn_exp2f(t[1]); e[2] = __builtin_amdgcn_exp2f(t[2]); e[3] = __builtin_amdgcn_exp2f(t[3]);
    const f32x4 d = e + 1.0f; f32x4 r; r[0] = __builtin_amdgcn_rcpf(d[0]); r[1] = __builtin_amdgcn_rcpf(d[1]); r[2] = __builtin_amdgcn_rcpf(d[2]); r[3] = __builtin_amdgcn_rcpf(d[3]);
    return (g * r) * u; }
struct EpiSwiglu {
    static constexpr bool PERM = true, AFTER_DRAIN = false, HAS_INIT = false;
    bf16_t* O; int ldc; const PG8_LAS float* rsL;
    __device__ __forceinline__ void operator()(const f32x4 (&acc)[2][2][4][2], const Unit& u, int wr, int wc, int fr, int fq, int ui) const {
        const int row0 = u.pm * BM + wr * 64 + fr, col0 = u.pn * HALF + wc * 32 + 8 * fq; const PG8_LAS float* rsu = rsL + ui * 256 + wr * 64 + fr;
        float rs[2][4];
#pragma unroll
        for (int ai = 0; ai < 2; ++ai)
#pragma unroll
            for (int m = 0; m < 4; ++m) rs[ai][m] = rsu[ai * HALF + m * 16];
#pragma unroll
        for (int ai = 0; ai < 2; ++ai)
#pragma unroll
            for (int m = 0; m < 4; ++m) { bf16_t* rowp = O + (size_t)(row0 + ai * HALF + m * 16) * ldc + col0;
                const float rsv = rs[ai][m];
                const f32x4 g0 = acc[ai][0][m][0] * rsv, g1 = acc[ai][0][m][1] * rsv, u0 = acc[ai][1][m][0] * rsv, u1 = acc[ai][1][m][1] * rsv;
                const f32x4 o0 = silu_mul4(g0, u0), o1 = silu_mul4(g1, u1);
                u32x4 w; w.x = cvt_pk_bf16(o0[0], o0[1]); w.y = cvt_pk_bf16(o0[2], o0[3]); w.z = cvt_pk_bf16(o1[0], o1[1]); w.w = cvt_pk_bf16(o1[2], o1[3]);
                store16_wt(rowp, w); }
    }
};
struct EpiResid {
    static constexpr bool PERM = true, AFTER_DRAIN = false, HAS_INIT = true;
    bf16_t* XB; int ldc; float* stats;
    __device__ __forceinline__ void init(f32x4 (&acc)[2][2][4][2], const Unit& u, int wr, int wc, int fr, int fq) const {
        const bf16_t* const XB = this->XB; const int ldc = this->ldc; const int row0 = u.pm * BM + wr * 64 + fr, col0 = u.pn * BM + wc * 32 + 8 * fq;
        u32x4 raw[2][2][4];
#pragma unroll
        for (int ai = 0; ai < 2; ++ai)
#pragma unroll
            for (int m = 0; m < 4; ++m)
#pragma unroll
                for (int bj = 0; bj < 2; ++bj) raw[ai][bj][m] = *(const u32x4*)(XB + (size_t)(row0 + ai * HALF + m * 16) * ldc + col0 + bj * HALF);
#pragma unroll
        for (int ai = 0; ai < 2; ++ai)
#pragma unroll
            for (int m = 0; m < 4; ++m)
#pragma unroll
                for (int bj = 0; bj < 2; ++bj) { const u32x4 w = raw[ai][bj][m];
                    acc[ai][bj][m][0] = (f32x4){__builtin_bit_cast(float, w.x << 16), __builtin_bit_cast(float, w.x & 0xffff0000u), __builtin_bit_cast(float, w.y << 16), __builtin_bit_cast(float, w.y & 0xffff0000u)};
                    acc[ai][bj][m][1] = (f32x4){__builtin_bit_cast(float, w.z << 16), __builtin_bit_cast(float, w.z & 0xffff0000u), __builtin_bit_cast(float, w.w << 16), __builtin_bit_cast(float, w.w & 0xffff0000u)}; }
    }
    __device__ __forceinline__ void operator()(const f32x4 (&acc)[2][2][4][2], const Unit& u, int wr, int wc, int fr, int fq, int ui) const {
        bf16_t* const XB = this->XB; float* const stats = this->stats; const int ldc = this->ldc;
        const int row0 = u.pm * BM + wr * 64 + fr, col0 = u.pn * BM + wc * 32 + 8 * fq, lane = fq * 16 + fr;
#pragma unroll
        for (int ai = 0; ai < 2; ++ai)
#pragma unroll
            for (int m = 0; m < 4; ++m) { const int row = row0 + ai * HALF + m * 16; bf16_t* rowb = XB + (size_t)row * ldc + col0; float ss = 0.f;
#pragma unroll
                for (int bj = 0; bj < 2; ++bj) { const f32x4 x0 = acc[ai][bj][m][0], x1 = acc[ai][bj][m][1];
                    ss += ((x0[0] * x0[0] + x0[1] * x0[1]) + (x0[2] * x0[2] + x0[3] * x0[3])) + ((x1[0] * x1[0] + x1[1] * x1[1]) + (x1[2] * x1[2] + x1[3] * x1[3]));
                    u32x4 w; w.x = cvt_pk_bf16(x0[0], x0[1]); w.y = cvt_pk_bf16(x0[2], x0[3]); w.z = cvt_pk_bf16(x1[0], x1[1]); w.w = cvt_pk_bf16(x1[2], x1[3]); store16_wt(rowb + bj * HALF, w); }
                ss += lane_get(ss, lane ^ 16); ss += lane_get(ss, lane ^ 32);
                if (fq == 0) __hip_atomic_store((unsigned*)stats + (size_t)row * 16 + u.pn * 4 + wc, __float_as_uint(ss), __ATOMIC_RELAXED, __HIP_MEMORY_SCOPE_AGENT); }
    }
};
struct EpiSoftmax {
    static constexpr bool PERM = true, AFTER_DRAIN = true, HAS_INIT = false;
    bf16_t* O; int ldc;
    __device__ __forceinline__ void fused(f32x4 (&acc)[2][2][4][2], const Unit& u, int wr, int wc, int fr, int fq, PG8_LAS unsigned char* lds, int wid, int lane) const {
        PG8_LAS float* T1 = (PG8_LAS float*)lds;
        PG8_LAS float* T2 = (PG8_LAS float*)(lds + 4096);
#pragma unroll
        for (int ai = 0; ai < 2; ++ai)
#pragma unroll
            for (int m = 0; m < 4; ++m) { float mx = -INFINITY;
#pragma unroll
                for (int bj = 0; bj < 2; ++bj)
#pragma unroll
                    for (int n = 0; n < 2; ++n) { const f32x4 x = acc[ai][bj][m][n]; mx = fmaxf(mx, fmaxf(fmaxf(x[0], x[1]), fmaxf(x[2], x[3]))); }
                mx = fmaxf(mx, lane_get(mx, lane ^ 16)); mx = fmaxf(mx, lane_get(mx, lane ^ 32));
                if (fq == 0) T1[(ai * HALF + wr * 64 + m * 16 + fr) * 4 + wc] = mx; }
        asm volatile("s_waitcnt lgkmcnt(0)" ::: "memory"); __builtin_amdgcn_s_barrier(); asm volatile("" ::: "memory");
#pragma unroll
        for (int ai = 0; ai < 2; ++ai)
#pragma unroll
            for (int m = 0; m < 4; ++m) { const int r = ai * HALF + wr * 64 + m * 16 + fr; const f32x4 t = *(const PG8_LAS f32x4*)(T1 + r * 4);
                const float mx = fmaxf(fmaxf(t[0], t[1]), fmaxf(t[2], t[3])); float s = 0.f;
#pragma unroll
                for (int bj = 0; bj < 2; ++bj)
#pragma unroll
                    for (int n = 0; n < 2; ++n) { f32x4 x = acc[ai][bj][m][n];
                        x[0] = __builtin_amdgcn_exp2f(x[0] - mx); x[1] = __builtin_amdgcn_exp2f(x[1] - mx); x[2] = __builtin_amdgcn_exp2f(x[2] - mx); x[3] = __builtin_amdgcn_exp2f(x[3] - mx);
                        s += (x[0] + x[1]) + (x[2] + x[3]); acc[ai][bj][m][n] = x; }
                s += lane_get(s, lane ^ 16); s += lane_get(s, lane ^ 32);
                if (fq == 0) T2[r * 4 + wc] = s; }
        asm volatile("s_waitcnt lgkmcnt(0)" ::: "memory"); __builtin_amdgcn_s_barrier(); asm volatile("" ::: "memory");
        const int row0 = u.pm * BM + wr * 64 + fr, col0 = u.pn * BM + wc * 32 + 8 * fq;
#pragma unroll
        for (int ai = 0; ai < 2; ++ai)
#pragma unroll
            for (int m = 0; m < 4; ++m) { const int r = ai * HALF + wr * 64 + m * 16 + fr; const f32x4 t = *(const PG8_LAS f32x4*)(T2 + r * 4);
                const float inv = 1.0f / ((t[0] + t[1]) + (t[2] + t[3])); bf16_t* rowp = O + (size_t)(row0 + ai * HALF + m * 16) * ldc + col0;
#pragma unroll
                for (int bj = 0; bj < 2; ++bj) { const f32x4 v0 = acc[ai][bj][m][0] * inv, v1 = acc[ai][bj][m][1] * inv;
                    u32x4 w; w.x = cvt_pk_bf16(v0[0], v0[1]); w.y = cvt_pk_bf16(v0[2], v0[3]); w.z = cvt_pk_bf16(v1[0], v1[1]); w.w = cvt_pk_bf16(v1[2], v1[3]);
                    *(u32x4*)(rowp + bj * HALF) = w; } }
    }
};

template <class Epi, class Sched, bool ALIGN_EPI = false, bool SP2 = false>
__device__ __forceinline__ void gemm_phase(PG8_LAS unsigned char* lds, const Gemm g, const Sched S, const Epi E, const int tid) {
    const int wid = __builtin_amdgcn_readfirstlane(tid >> 6), lane = tid & 63, wr = wid >> 2, wc = wid & 3, fr = lane & 15, fq = lane >> 4;
    const int K = g.K, nt = K / BK;
    unsigned voffA[2], voffB[2];
#pragma unroll
    for (int i = 0; i < 2; ++i) { int R, C; stage_rc(tid * 16 + i * 8192, R, C); const int Rb = Epi::PERM ? ((R & ~31) + perm32(R & 31)) : R;
        voffA[i] = (unsigned)(R * g.lda + C) * 2u; voffB[i] = (unsigned)(Rb * g.ldb + C) * 2u; }
    const size_t kstep = (size_t)(BK * 2);
    const size_t hstepA = (size_t)HALF * g.lda * 2, hstepB = (size_t)HALF * g.ldb * 2;
    const size_t tstepA = 2 * hstepA, apn = (size_t)g.a_pn * 2, bpn = (size_t)g.b_pn * 2;
    const unsigned ldsw = (unsigned)wid * 1024u;
    const int aoff = lds_byte(wr * 64 + fr, fq * 8), boff = lds_byte(wc * 32 + fr, fq * 8);
#define PG8_SA(b, h) (((b) * 2 + (h)) * HTB)
#define PG8_SB(b, h) ((4 + (b) * 2 + (h)) * HTB)
#define PG8_STAGE(bufoff, gbase, voff) do { _Pragma("unroll") for (int _i = 0; _i < 2; ++_i) \
        __builtin_amdgcn_global_load_lds((const unsigned*)((const char*)(gbase) + (voff)[_i]), (PG8_LAS unsigned*)(lds + (bufoff) + ldsw + _i * 8192), 16, 0, 0); } while (0)
#define PG8_LDA(dst, b, h) do { _Pragma("unroll") for (int m = 0; m < 4; ++m) _Pragma("unroll") for (int k = 0; k < 2; ++k) dst[m][k] = *(const PG8_LAS bf16x8*)(lds + PG8_SA(b, h) + aoff + m * 2048 + k * 1024); } while (0)
#define PG8_LDB(dst, b, h) do { _Pragma("unroll") for (int n = 0; n < 2; ++n) _Pragma("unroll") for (int k = 0; k < 2; ++k) dst[n][k] = *(const PG8_LAS bf16x8*)(lds + PG8_SB(b, h) + boff + n * 2048 + k * 1024); } while (0)
#define PG8_MMA(ai, bj, At, Bt) do { __builtin_amdgcn_s_setprio(1); _Pragma("unroll") for (int m = 0; m < 4; ++m) _Pragma("unroll") for (int n = 0; n < 2; ++n) _Pragma("unroll") for (int k = 0; k < 2; ++k) \
        acc[ai][bj][m][n] = __builtin_amdgcn_mfma_f32_16x16x32_bf16(Bt[n][k], At[m][k], acc[ai][bj][m][n], 0, 0, 0); __builtin_amdgcn_s_setprio(0); } while (0)
#define PG8_WAIT_V(n) asm volatile("s_waitcnt vmcnt(" #n ")" ::: "memory")
#define PG8_WAIT_L(n) asm volatile("s_waitcnt lgkmcnt(" #n ")" ::: "memory")
#define PG8_BAR __builtin_amdgcn_s_barrier()
#define PG8_SCHED __builtin_amdgcn_sched_barrier(0)
    Unit cur, nxt; int ui = 0;
    if (!S.next(0, cur)) return;
    f32x4 acc[2][2][4][2];
    if constexpr (Epi::HAS_INIT) E.init(acc, cur, wr, wc, fr, fq);
    else {
#pragma unroll
    for (int a = 0; a < 2; ++a)
#pragma unroll
        for (int b = 0; b < 2; ++b)
#pragma unroll
            for (int m = 0; m < 4; ++m)
#pragma unroll
                for (int n = 0; n < 2; ++n) acc[a][b][m][n] = (f32x4){0.f, 0.f, 0.f, 0.f};
    }
    bf16x8 At[4][2], B0[2][2], B1[2][2];
    const char* cA = (const char*)g.A + (size_t)cur.pm * tstepA + (size_t)cur.pn * apn; const char* cB = (const char*)g.Bt + (size_t)cur.pn * bpn;
    S.a_ready(cur);
    if constexpr (SP2) {
        PG8_STAGE(PG8_SB(0, 0), cB, voffB); PG8_STAGE(PG8_SB(0, 1), cB + hstepB, voffB); PG8_STAGE(PG8_SA(0, 0), cA, voffA); PG8_STAGE(PG8_SA(0, 1), cA + hstepA, voffA);
        if (wr == 1) PG8_BAR;
        PG8_WAIT_V(2); PG8_BAR;
        PG8_STAGE(PG8_SB(1, 0), cB + kstep, voffB); PG8_STAGE(PG8_SA(1, 0), cA + kstep, voffA); PG8_STAGE(PG8_SB(1, 1), cB + hstepB + kstep, voffB);
        PG8_WAIT_V(6); PG8_BAR;
    } else {
        PG8_STAGE(PG8_SB(0, 0), cB, voffB); PG8_STAGE(PG8_SA(0, 0), cA, voffA); PG8_STAGE(PG8_SB(0, 1), cB + hstepB, voffB); PG8_STAGE(PG8_SA(0, 1), cA + hstepA, voffA);
        if (wr == 1) PG8_BAR;
        PG8_WAIT_V(4); PG8_BAR;
        PG8_STAGE(PG8_SB(1, 0), cB + kstep, voffB); PG8_STAGE(PG8_SA(1, 0), cA + kstep, voffA); PG8_STAGE(PG8_SB(1, 1), cB + hstepB + kstep, voffB);
        PG8_WAIT_V(6); PG8_BAR;
    }
    for (;;) {
        const bool has_next = S.next(ui + 1, nxt);
        const char* nA = has_next ? (const char*)g.A + (size_t)nxt.pm * tstepA + (size_t)nxt.pn * apn : cA; const char* nB = has_next ? (const char*)g.Bt + (size_t)nxt.pn * bpn : cB;
        for (int t = 0; t < nt; t += 2) {
            const bool last = (t == nt - 2);
            const char* a1 = cA + (size_t)(t + 1) * kstep;
            const char* a2 = last ? nA : cA + (size_t)(t + 2) * kstep; const char* b2 = last ? nB : cB + (size_t)(t + 2) * kstep;
            const char* a3 = a2 + kstep; const char* b3 = b2 + kstep;
            if (last && has_next) S.a_ready(nxt);
            if constexpr (SP2) {
            PG8_LDB(B0, 0, 0); PG8_LDB(B1, 0, 1); PG8_SCHED; PG8_LDA(At, 0, 0); PG8_STAGE(PG8_SA(1, 1), a1 + hstepA, voffA);
            PG8_WAIT_V(8); PG8_WAIT_L(0); PG8_BAR; PG8_MMA(0, 0, At, B0); PG8_MMA(0, 1, At, B1); PG8_BAR; PG8_SCHED;
            PG8_LDA(At, 0, 1); PG8_STAGE(PG8_SB(0, 0), b2, voffB); PG8_STAGE(PG8_SB(0, 1), b2 + hstepB, voffB); PG8_STAGE(PG8_SA(0, 0), a2, voffA);
            PG8_WAIT_V(8); PG8_WAIT_L(0); PG8_BAR; PG8_MMA(1, 0, At, B0); PG8_MMA(1, 1, At, B1); PG8_BAR; PG8_SCHED;
            PG8_LDB(B0, 1, 0); PG8_LDB(B1, 1, 1); PG8_SCHED; PG8_LDA(At, 1, 0); PG8_STAGE(PG8_SA(0, 1), a2 + hstepA, voffA);
            PG8_WAIT_V(8); PG8_WAIT_L(0); PG8_BAR; PG8_MMA(0, 0, At, B0); PG8_MMA(0, 1, At, B1); PG8_BAR; PG8_SCHED;
            PG8_LDA(At, 1, 1); PG8_STAGE(PG8_SB(1, 0), b3, voffB); PG8_STAGE(PG8_SB(1, 1), b3 + hstepB, voffB); PG8_STAGE(PG8_SA(1, 0), a3, voffA);
            PG8_WAIT_V(8); PG8_WAIT_L(0); PG8_BAR; PG8_MMA(1, 0, At, B0); PG8_MMA(1, 1, At, B1); PG8_BAR; PG8_SCHED;
            } else {
            PG8_LDB(B0, 0, 0); PG8_SCHED; PG8_LDA(At, 0, 0); PG8_STAGE(PG8_SA(1, 1), a1 + hstepA, voffA);
            PG8_WAIT_L(8); PG8_BAR; PG8_WAIT_L(0); PG8_MMA(0, 0, At, B0); PG8_BAR; PG8_SCHED;
            PG8_LDB(B1, 0, 1); PG8_STAGE(PG8_SB(0, 0), b2, voffB);
            PG8_BAR; PG8_WAIT_L(0); PG8_MMA(0, 1, At, B1); PG8_BAR;
            PG8_LDA(At, 0, 1); PG8_STAGE(PG8_SA(0, 0), a2, voffA);
            PG8_BAR; PG8_WAIT_L(0); PG8_MMA(1, 0, At, B0); PG8_BAR; PG8_SCHED;
            PG8_STAGE(PG8_SB(0, 1), b2 + hstepB, voffB);
            PG8_WAIT_V(6); PG8_BAR; PG8_MMA(1, 1, At, B1); PG8_BAR;
            PG8_LDB(B0, 1, 0); PG8_SCHED; PG8_LDA(At, 1, 0); PG8_STAGE(PG8_SA(0, 1), a2 + hstepA, voffA);
            PG8_WAIT_L(8); PG8_BAR; PG8_WAIT_L(0); PG8_MMA(0, 0, At, B0); PG8_BAR; PG8_SCHED;
            PG8_LDB(B1, 1, 1); PG8_STAGE(PG8_SB(1, 0), b3, voffB);
            PG8_BAR; PG8_WAIT_L(0); PG8_MMA(0, 1, At, B1); PG8_BAR;
            PG8_LDA(At, 1, 1); PG8_STAGE(PG8_SA(1, 0), a3, voffA);
            PG8_BAR; PG8_WAIT_L(0); PG8_MMA(1, 0, At, B0); PG8_BAR; PG8_SCHED;
            PG8_STAGE(PG8_SB(1, 1), b3 + hstepB, voffB);
            PG8_WAIT_V(6); PG8_BAR; PG8_MMA(1, 1, At, B1); PG8_BAR;
            }
        }
        if constexpr (ALIGN_EPI) { if (wr == 0) PG8_BAR; }
        if constexpr (!Epi::AFTER_DRAIN) { E(acc, cur, wr, wc, fr, fq, ui); S.done(cur); }
        if (!has_next) break;
        if constexpr (Epi::HAS_INIT) E.init(acc, nxt, wr, wc, fr, fq);
        else {
#pragma unroll
        for (int a = 0; a < 2; ++a)
#pragma unroll
            for (int b = 0; b < 2; ++b)
#pragma unroll
                for (int m = 0; m < 4; ++m)
#pragma unroll
                    for (int n = 0; n < 2; ++n) acc[a][b][m][n] = (f32x4){0.f, 0.f, 0.f, 0.f};
        }
        cur = nxt; cA = nA; cB = nB; ++ui;
        if constexpr (ALIGN_EPI) { if (wr == 1) PG8_BAR; }
    }
    PG8_WAIT_V(0);
    if constexpr (!ALIGN_EPI) { if (wr == 0) PG8_BAR; }
    PG8_BAR;
    if constexpr (Epi::AFTER_DRAIN) { E.fused(acc, cur, wr, wc, fr, fq, lds, wid, lane); S.done(cur); }
#undef PG8_SA
#undef PG8_SB
#undef PG8_STAGE
#undef PG8_LDA
#undef PG8_LDB
#undef PG8_MMA
#undef PG8_WAIT_V
#undef PG8_WAIT_L
#undef PG8_BAR
#undef PG8_SCHED
}
}

#include <hip/hip_bf16.h>
#include <cmath>
namespace attn_body {
using bf16=__hip_bfloat16;
using bf16x8=__attribute__((ext_vector_type(8)))short;
using s16x4=__attribute__((ext_vector_type(4)))short;
using f32x16=__attribute__((ext_vector_type(16)))float;
using u32x4=__attribute__((ext_vector_type(4)))unsigned;
using f32x4v=__attribute__((ext_vector_type(4)))float;
constexpr int BATCH=1,NHEAD=8,SEQ=16384,D=64,DM=3072;
constexpr int NW=8,QBLK=32,QB=QBLK*NW,KVBLK=64,NQB=SEQ/QB;
constexpr int ATTN_PITCH=DM, ATTN_UNIT_ROWS=QB;
__device__ __forceinline__ int crow(int r,int hi){return (r&3)+8*(r>>2)+4*hi;}
#define SBAR() __builtin_amdgcn_sched_barrier(0)
__device__ __forceinline__ void cmask(f32x16&p0,f32x16&p1,int jb,int qrel,int hi){
  const float NEG=-INFINITY; int kb=64*jb+4*hi;
  #pragma unroll
  for(int r=0;r<16;++r){int kv=kb+(r&3)+8*(r>>2); if(kv>qrel)p0[r]=NEG; if(kv+32>qrel)p1[r]=NEG;}
}

constexpr int NSLOT=3, SLOTB=8192;
constexpr int LDS_K=0, LDS_V=NSLOT*SLOTB, LDS_WS=2*NSLOT*SLOTB, LDS_OST=LDS_WS+NW*64*4, LDS_BIAS=LDS_OST+NW*4096, LDS_PRE=LDS_BIAS+SEQ*4, LDS_BYTES=LDS_PRE+1024;
constexpr float C2=0.125f*1.4426950408889634f;
__device__ __forceinline__ void glds16(const void*gsrc,unsigned lds_dst){unsigned keep;
  asm volatile("s_mov_b32 %0, m0\n\ts_mov_b32 m0, %2\n\ts_nop 0\n\tglobal_load_lds_dwordx4 %1, off\n\ts_mov_b32 m0, %0":"=&s"(keep):"v"(gsrc),"s"(lds_dst):"memory");}
__device__ __forceinline__ float max3f(float a,float b,float c){float r;asm("v_max3_f32 %0, %1, %2, %3":"=v"(r):"v"(a),"v"(b),"v"(c));return r;}
__device__ __forceinline__ float max2f(float a,float b){float r;asm("v_max_f32_e32 %0, %1, %2":"=v"(r):"v"(a),"v"(b));return r;}
__device__ __forceinline__ float fadd_s(float a,float b){float r;asm("v_add_f32_e32 %0, %1, %2":"=v"(r):"v"(a),"v"(b));return r;}
__device__ __forceinline__ float fsub_s(float a,float b){float r;asm("v_sub_f32_e32 %0, %1, %2":"=v"(r):"v"(a),"v"(b));return r;}
typedef float f32x2_t __attribute__((ext_vector_type(2))); typedef __bf16 bf16x2_t __attribute__((ext_vector_type(2)));
__device__ __forceinline__ unsigned cvtpk_s(float lo,float hi){f32x2_t v={lo,hi};bf16x2_t b=__builtin_convertvector(v,bf16x2_t);return __builtin_bit_cast(unsigned,b);}
#define WAIT_BAR(N) asm volatile("s_waitcnt vmcnt(" #N ") lgkmcnt(0)\n\ts_barrier":::"memory")

__device__ __forceinline__ void qkt(f32x16&p0,f32x16&p1,const char*Kslot,const bf16x8*qr,int r32,int hi){
  const char*kb=Kslot+hi*1024+r32*16;
  #pragma unroll
  for(int d0=0;d0<4;++d0){
    const bf16x8 b0=*reinterpret_cast<const bf16x8*>(kb+d0*2048);
    const bf16x8 b1=*reinterpret_cast<const bf16x8*>(kb+d0*2048+512);
    {p0=__builtin_amdgcn_mfma_f32_32x32x16_bf16(b0,qr[d0],p0,0,0,0);p1=__builtin_amdgcn_mfma_f32_32x32x16_bf16(b1,qr[d0],p1,0,0,0);}}
}
typedef __attribute__((address_space(3))) const char* lds_cptr;
typedef short v4i16_t __attribute__((ext_vector_type(4)));
__device__ __forceinline__ void kload8(bf16x8*kf,lds_cptr kp){
  kf[0]=*(const __attribute__((address_space(3))) bf16x8*)(kp);      kf[1]=*(const __attribute__((address_space(3))) bf16x8*)(kp+512);
  kf[2]=*(const __attribute__((address_space(3))) bf16x8*)(kp+2048); kf[3]=*(const __attribute__((address_space(3))) bf16x8*)(kp+2560);
  kf[4]=*(const __attribute__((address_space(3))) bf16x8*)(kp+4096); kf[5]=*(const __attribute__((address_space(3))) bf16x8*)(kp+4608);
  kf[6]=*(const __attribute__((address_space(3))) bf16x8*)(kp+6144); kf[7]=*(const __attribute__((address_space(3))) bf16x8*)(kp+6656);
}
__device__ __forceinline__ void kload2(bf16x8*kf,lds_cptr kp,int j){ kf[2*j]=*(const __attribute__((address_space(3))) bf16x8*)(kp+j*2048); kf[2*j+1]=*(const __attribute__((address_space(3))) bf16x8*)(kp+j*2048+512); }
__device__ __forceinline__ s16x4 vtr(lds_cptr p){ return __builtin_bit_cast(s16x4,__builtin_amdgcn_ds_read_tr16_b64_v4i16((__attribute__((address_space(3))) v4i16_t*)p)); }
__device__ __forceinline__ float rowmax(const f32x16&p0,const f32x16&p1){
  float a=max3f(p0[0],p0[1],p1[0]),b=max3f(p0[2],p0[3],p1[1]);a=max3f(a,p1[2],p1[3]);
  #pragma unroll
  for(int r=4;r<16;r+=4){a=max3f(a,p0[r],p0[r+1]);b=max3f(b,p0[r+2],p0[r+3]);a=max3f(a,p1[r],p1[r+1]);b=max3f(b,p1[r+2],p1[r+3]);}
  const float m=max2f(a,b);
  auto rr=__builtin_amdgcn_permlane32_swap(__float_as_uint(m),__float_as_uint(m),false,false);
  return max2f(__uint_as_float(rr[0]),__uint_as_float(rr[1]));
}
__device__ __forceinline__ void pv(f32x16*o,int vb,bf16x8 pa0,bf16x8 pa1,bf16x8 pa2,bf16x8 pa3){
  #pragma unroll
  for(int d0=0;d0<2;++d0){s16x4 lo[4],hi[4];
    #pragma unroll
    for(int ks=0;ks<4;++ks){
      asm volatile("ds_read_b64_tr_b16 %0,%1 offset:%c2":"=&v"(lo[ks]):"v"(vb),"i"(d0*4096+ks*1024):"memory");
      asm volatile("ds_read_b64_tr_b16 %0,%1 offset:%c2":"=&v"(hi[ks]):"v"(vb),"i"(d0*4096+ks*1024+512):"memory");}
    asm volatile("s_waitcnt lgkmcnt(0)":::"memory");SBAR();
    #define PK(k) (bf16x8){lo[k][0],lo[k][1],lo[k][2],lo[k][3],hi[k][0],hi[k][1],hi[k][2],hi[k][3]}
    o[d0]=__builtin_amdgcn_mfma_f32_32x32x16_bf16(pa0,PK(0),o[d0],0,0,0);
    o[d0]=__builtin_amdgcn_mfma_f32_32x32x16_bf16(pa1,PK(1),o[d0],0,0,0);
    o[d0]=__builtin_amdgcn_mfma_f32_32x32x16_bf16(pa2,PK(2),o[d0],0,0,0);
    o[d0]=__builtin_amdgcn_mfma_f32_32x32x16_bf16(pa3,PK(3),o[d0],0,0,0);
    #undef PK
  }
}

#ifndef ATTN_STORE16
#define ATTN_STORE16(p,v) store16_wt((p),(v))
#endif
template<int THRL> __device__ __forceinline__ void attn_unit(int b,int h,int qb,const bf16*Q,const bf16*__restrict__ K,const bf16*__restrict__ V,bf16*O,const float*__restrict__ cl,const float*__restrict__ ctot,const float*__restrict__ kpart,char*shm,const int tid,const int odm){
  const int lane=tid&63,r32=lane&31,hi=lane>>5; const int wid=__builtin_amdgcn_readfirstlane(tid>>6);
  const long rowbase=(long)b*SEQ; const int q0=qb*QB; const int NTF=(q0+QB)/KVBLK;
  const bf16*Qw=Q+(rowbase+q0+wid*QBLK)*DM+h*D;
  const unsigned lds0=(unsigned)(uintptr_t)shm;
  float*wsf=(float*)(shm+LDS_WS)+wid*64;
  const char*Kbase=shm+LDS_K; bf16x8 kf[8];
  const lds_cptr shm3=(lds_cptr)shm; const lds_cptr kp0=shm3+LDS_K+hi*1024+r32*16; const lds_cptr vp0=shm3+LDS_V+((lane>>4)&1)*32+(lane&3)*8+(4*hi+((lane&15)>>2))*64;
  bf16x8 qr[4];
  #pragma unroll
  for(int d0=0;d0<4;++d0)qr[d0]=*reinterpret_cast<const bf16x8*>(&Qw[(long)r32*DM+d0*16+hi*8]);
  typedef __attribute__((address_space(3))) float lds_f; typedef __attribute__((address_space(3))) f32x4v lds_f4;
  lds_f* preL=(lds_f*)(shm3+LDS_PRE); lds_f4* bias4=(lds_f4*)(shm3+LDS_BIAS); lds_f* wsq=(lds_f*)(shm3+LDS_WS);
  int ln_=lane; asm volatile("":"+v"(ln_));
  if(wid==0){ const f32x4v tq=*(const f32x4v*)(ctot+4*lane); const float s0=tq[0],s1=s0+tq[1],s2=s1+tq[2],s3=s2+tq[3]; float inc=s3;
    _Pragma("unroll") for(int of=1;of<64;of<<=1){ const float vv=lane_get(inc,ln_-of); if(ln_>=of)inc+=vv; }
    const float exc=inc-s3; preL[4*lane]=exc; preL[4*lane+1]=exc+s0; preL[4*lane+2]=exc+s1; preL[4*lane+3]=exc+s2; }
  { float qs=0.f;
    _Pragma("unroll") for(int d0=0;d0<4;++d0) _Pragma("unroll") for(int e=0;e<8;++e){ const float qf=__builtin_bit_cast(float,((unsigned)(unsigned short)qr[d0][e])<<16); qs+=qf*qf; }
    { auto rr=__builtin_amdgcn_permlane32_swap(__float_as_uint(qs),__float_as_uint(qs),false,false); qs=__uint_as_float(rr[0])+__uint_as_float(rr[1]); }
    _Pragma("unroll") for(int of=1;of<32;of<<=1) qs=fmaxf(qs,lane_get(qs,ln_^of));
    if(lane==0) wsq[wid*64]=qs; }
  asm volatile("s_waitcnt lgkmcnt(0)\n\ts_barrier":::"memory");
  int t0=0;
  { float qm=0.f; _Pragma("unroll") for(int w=0;w<NW;++w) qm=fmaxf(qm,wsq[w*64]);
    const float km=kpart[2*h]+kpart[2*h+1];
    const float QK=sqrtf(qm*km)*1.02f+0.01f;
    const float thr=-preL[4*qb]*1.4426950408889634f-2.f*QK-40.f;
    for(int base=0;base<NTF-4;base+=64){ const int tau=base+lane; const bool sk=(tau<NTF-4)&&(-preL[tau+1]*1.4426950408889634f<thr); t0+=__builtin_popcountll(__builtin_amdgcn_ballot_w64(sk)); }
    t0=__builtin_amdgcn_readfirstlane(t0)&~1; }
  const int NT=NTF-t0;
  const bf16*Kh=K+(rowbase+(long)t0*KVBLK)*DM+h*D,*Vh=V+(rowbase+(long)t0*KVBLK)*DM+h*D;
  const bf16*ksrc=Kh+(long)lane*DM+wid*8;
  const bf16*vsrc=Vh+(long)(16*(wid&3)+(lane>>2))*DM+(wid>>2)*32+(lane&3)*8;
  const unsigned kdst=lds0+LDS_K+wid*1024, vdst=lds0+LDS_V+wid*1024;
  #define DMA_K(t,slot) glds16(ksrc+(long)(t)*KVBLK*DM,(unsigned)__builtin_amdgcn_readfirstlane(kdst+(slot)))
  #define DMA_V(t,slot) glds16(vsrc+(long)(t)*KVBLK*DM,(unsigned)__builtin_amdgcn_readfirstlane(vdst+(slot)))
  DMA_K(0,0);DMA_V(0,0);DMA_K(1,SLOTB);
  float mhat=0.f,l_reg=0.f;f32x16 o[2];o[0]=f32x16{};o[1]=f32x16{};
  for(int i=tid;i<NT*16;i+=NW*64){ const f32x4v c=*(const f32x4v*)(cl+4*(t0*16+i)); const float pp=preL[t0+(i>>4)]; bias4[i]=(c+pp)*(-1.4426950408889634f); }

  const int qrel=wid*QBLK+r32;
  #define CMASK(P0,P1,t) do{int jb_=(t)-(NT-4); if(jb_>=0)cmask(P0,P1,jb_,qrel,hi);}while(0)
  #define LOADB1(C0,t,o8) do{ const lds_f4* bp_=bias4+(t)*16+hi+(o8); _Pragma("unroll") for(int j_=0;j_<4;++j_){ const f32x4v b0_=bp_[2*j_]; \
      _Pragma("unroll") for(int i_=0;i_<4;++i_){ C0[4*j_+i_]=b0_[i_]-mhat; } } }while(0)
  #define LOADB(C0,C1,t) do{ LOADB1(C0,t,0); LOADB1(C1,t,8); }while(0)
  bool resc=false;
  #define START(P0,P1) do{ const float rm=rowmax(P0,P1); resc=false; \
    { const float dl=rm; mhat=fadd_s(mhat,dl); \
      _Pragma("unroll") for(int r=0;r<16;++r){P0[r]=fsub_s(P0[r],dl);P1[r]=fsub_s(P1[r],dl);} } \
    _Pragma("unroll") for(int r=0;r<16;++r)P0[r]=__builtin_amdgcn_exp2f(P0[r]); }while(0)
  #define RESC() do{ if(resc){ asm volatile("s_waitcnt lgkmcnt(0)":::"memory"); \
      _Pragma("unroll") for(int d_=0;d_<2;++d_) _Pragma("unroll") for(int r=0;r<16;++r)o[d_][r]*=wsf[crow(r,hi)]; } }while(0)
  f32x16 pA0,pA1,pB0,pB1;
  int sl_prev=0,sl_cur=0,sl_next=SLOTB;
  #define ROT() do{sl_prev=sl_cur;sl_cur=sl_next;sl_next=(sl_next==(NSLOT-1)*SLOTB)?0:sl_next+SLOTB;}while(0)
  DMA_K(2,2*SLOTB);
  WAIT_BAR(3);
  LOADB(pA0,pA1,0);
  qkt(pA0,pA1,Kbase,qr,r32,hi);asm volatile("s_nop 15\n\ts_nop 7":"+v"(pA0),"+v"(pA1));CMASK(pA0,pA1,0);
  START(pA0,pA1);
  _Pragma("unroll") for(int r=0;r<16;++r)pA1[r]=__builtin_amdgcn_exp2f(pA1[r]);
  WAIT_BAR(0);
  DMA_K(3,0);DMA_V(1,SLOTB);
  ROT();
  kload8(kf,kp0+sl_cur);
  WAIT_BAR(2);
  s16x4 vlo[8],vhi[8]; u32x4 pw0,pw1,pw2,pw3;
  #define PKW(P,B) cvtpk_s(P[B],P[B+1])
  #define PAF(k) __builtin_bit_cast(bf16x8,pw##k)
  #define VFR(i) (bf16x8){vlo[i][0],vlo[i][1],vlo[i][2],vlo[i][3],vhi[i][0],vhi[i][1],vhi[i][2],vhi[i][3]}
  #define PIN(x) asm volatile("":"+v"(x))
  #define MX3(a,b,c) __builtin_fmaxf(__builtin_fmaxf((a),(b)),(c))
  #define GAPA(MF,A0,A1,A2,A3,W0,W1,PW) do{ MF; sacc+=A0; sacc+=A1; sacc+=A2; sacc+=A3; PIN(sacc); W0; W1; PIN(PW); SBAR(); }while(0)
  #define EX(v) __builtin_amdgcn_exp2f(v)
  #define GAPB(MF,X,B) do{ MF; X[B]=EX(X[B]); X[B+1]=EX(X[B+1]); X[B+2]=EX(X[B+2]); X[B+3]=EX(X[B+3]); PIN(X); SBAR(); }while(0)
  #define VRD(i) do{ vlo[i]=vtr(vp_+(((i)>>2)*4096+((i)&3)*1024)); vhi[i]=vtr(vp_+(((i)>>2)*4096+((i)&3)*1024+512)); }while(0)
  #define KRD(G,j) do{ if(G){ kload2(kf,kp0+sl_next,j); SBAR(); } }while(0)
  #define STEP(C0,C1,P0,P1,t,GK,GV,GL) do{ SBAR(); \
    LOADB1(C0,t,0); SBAR(); \
    const lds_cptr vp_=vp0+sl_prev; \
    VRD(0); SBAR(); float sacc=(P0[0]+P0[1]); \
    GAPA(C0=__builtin_amdgcn_mfma_f32_32x32x16_bf16(kf[0],qr[0],C0,0,0,0), P0[2],P0[3],P0[4],P0[5],     pw0[0]=PKW(P0,0), pw0[1]=PKW(P0,2), pw0); \
    LOADB1(C1,t,8); SBAR(); VRD(4); SBAR(); GAPA(C1=__builtin_amdgcn_mfma_f32_32x32x16_bf16(kf[1],qr[0],C1,0,0,0), P0[6],P0[7],P0[8],P0[9],     pw0[2]=PKW(P0,4), pw0[3]=PKW(P0,6), pw0); \
    VRD(1); SBAR(); GAPA(C0=__builtin_amdgcn_mfma_f32_32x32x16_bf16(kf[2],qr[1],C0,0,0,0),   P0[10],P0[11],P0[12],P0[13], pw1[0]=PKW(P0,8), pw1[1]=PKW(P0,10), pw1); \
    VRD(5); SBAR(); GAPA(C1=__builtin_amdgcn_mfma_f32_32x32x16_bf16(kf[3],qr[1],C1,0,0,0),   P0[14],P0[15],P1[0],P1[1],   pw1[2]=PKW(P0,12),pw1[3]=PKW(P0,14), pw1); \
    VRD(2); SBAR(); GAPA(C0=__builtin_amdgcn_mfma_f32_32x32x16_bf16(kf[4],qr[2],C0,0,0,0),   P1[2],P1[3],P1[4],P1[5],     pw2[0]=PKW(P1,0), pw2[1]=PKW(P1,2), pw2); \
    VRD(6); SBAR(); GAPA(C1=__builtin_amdgcn_mfma_f32_32x32x16_bf16(kf[5],qr[2],C1,0,0,0),   P1[6],P1[7],P1[8],P1[9],     pw2[2]=PKW(P1,4), pw2[3]=PKW(P1,6), pw2); \
    VRD(3); SBAR(); GAPA(C0=__builtin_amdgcn_mfma_f32_32x32x16_bf16(kf[6],qr[3],C0,0,0,0),   P1[10],P1[11],P1[12],P1[13], pw3[0]=PKW(P1,8), pw3[1]=PKW(P1,10), pw3); \
    VRD(7); SBAR(); GAPA(C1=__builtin_amdgcn_mfma_f32_32x32x16_bf16(kf[7],qr[3],C1,0,0,0),   P1[14],P1[15],0.f,0.f,       pw3[2]=PKW(P1,12),pw3[3]=PKW(P1,14), pw3); \
    l_reg+=sacc; \
    if(GK){DMA_K((t)+3,sl_cur);} if(GV){DMA_V((t)+1,sl_next);} \
    CMASK(C0,C1,t); \
    { float a=MX3(C0[0],C0[1],C1[0]),b=MX3(C0[2],C0[3],C1[1]); a=MX3(a,C1[2],C1[3]); \
      _Pragma("unroll") for(int r=4;r<16;r+=4){a=MX3(a,C0[r],C0[r+1]);b=MX3(b,C0[r+2],C0[r+3]);a=MX3(a,C1[r],C1[r+1]);b=MX3(b,C1[r+2],C1[r+3]);} \
      float rm=__builtin_fmaxf(a,b); { auto rr=__builtin_amdgcn_permlane32_swap(__float_as_uint(rm),__float_as_uint(rm),false,false); rm=__builtin_fmaxf(__uint_as_float(rr[0]),__uint_as_float(rr[1])); } \
      resc=false; \
      if(__builtin_expect(__any(rm>(float)THRL),0)){ const float dl=__builtin_fmaxf(rm,0.f); mhat+=dl; \
        _Pragma("unroll") for(int r=0;r<16;++r){C0[r]-=dl;C1[r]-=dl;} \
        const float f=__builtin_amdgcn_exp2f(-dl); l_reg*=f; if(hi==0)wsf[r32]=f; resc=true; } } \
    SBAR(); \
    GAPB(o[0]=__builtin_amdgcn_mfma_f32_32x32x16_bf16(PAF(0),VFR(0),o[0],0,0,0), C0,0); \
    GAPB(o[1]=__builtin_amdgcn_mfma_f32_32x32x16_bf16(PAF(0),VFR(4),o[1],0,0,0), C0,4); \
    KRD(GL,0); GAPB(o[0]=__builtin_amdgcn_mfma_f32_32x32x16_bf16(PAF(1),VFR(1),o[0],0,0,0), C0,8); \
    KRD(GL,1); GAPB(o[1]=__builtin_amdgcn_mfma_f32_32x32x16_bf16(PAF(1),VFR(5),o[1],0,0,0), C0,12); \
    KRD(GL,2); GAPB(o[0]=__builtin_amdgcn_mfma_f32_32x32x16_bf16(PAF(2),VFR(2),o[0],0,0,0), C1,0); \
    KRD(GL,3); GAPB(o[1]=__builtin_amdgcn_mfma_f32_32x32x16_bf16(PAF(2),VFR(6),o[1],0,0,0), C1,4); \
    GAPB(o[0]=__builtin_amdgcn_mfma_f32_32x32x16_bf16(PAF(3),VFR(3),o[0],0,0,0), C1,8); \
    GAPB(o[1]=__builtin_amdgcn_mfma_f32_32x32x16_bf16(PAF(3),VFR(7),o[1],0,0,0), C1,12); \
    }while(0)
  int t=1;
  #undef CMASK
  #define CMASK(P0,P1,t) do{}while(0)
  for(;t+5<NT;t+=2){
    STEP(pB0,pB1,pA0,pA1,t,true,true,true);     WAIT_BAR(2); RESC(); ROT();
    STEP(pA0,pA1,pB0,pB1,t+1,true,true,true);   WAIT_BAR(2); RESC(); ROT();
  }
  #undef CMASK
  #define CMASK(P0,P1,t) do{int jb_=(t)-(NT-4); if(jb_>=0)cmask(P0,P1,jb_,qrel,hi);}while(0)
  #define ENDW(tt) do{ if((tt)+3<NT){WAIT_BAR(2);} else if((tt)+2<NT){WAIT_BAR(1);} else {WAIT_BAR(0);} }while(0)
  for(;t+1<NT;t+=2){
    STEP(pB0,pB1,pA0,pA1,t,(t+3<NT),(t+1<NT),(t+1<NT));       ENDW(t);   RESC(); ROT();
    STEP(pA0,pA1,pB0,pB1,t+1,(t+4<NT),(t+2<NT),(t+2<NT));     ENDW(t+1); RESC(); ROT();
  }
  STEP(pB0,pB1,pA0,pA1,NT-1,false,false,false); RESC();
  { float sacc=pB0[0]+pB0[1]; _Pragma("unroll") for(int r=2;r<16;++r)sacc+=pB0[r]; _Pragma("unroll") for(int r=0;r<16;++r)sacc+=pB1[r]; l_reg+=sacc;
    pw0=(u32x4){PKW(pB0,0),PKW(pB0,2),PKW(pB0,4),PKW(pB0,6)};pw1=(u32x4){PKW(pB0,8),PKW(pB0,10),PKW(pB0,12),PKW(pB0,14)};pw2=(u32x4){PKW(pB1,0),PKW(pB1,2),PKW(pB1,4),PKW(pB1,6)};pw3=(u32x4){PKW(pB1,8),PKW(pB1,10),PKW(pB1,12),PKW(pB1,14)};
    SBAR(); pv(o,(int)(unsigned)(uintptr_t)vp0+sl_cur,PAF(0),PAF(1),PAF(2),PAF(3)); }
  #undef PKW
  #undef PAF
  #undef VFR
  #undef PIN
  #undef MX3
  #undef GAPA
  #undef GAPB
  #undef EX
  #undef VRD
  #undef KRD
  #undef STEP
  #undef ENDW
  {auto rr=__builtin_amdgcn_permlane32_swap(__float_as_uint(l_reg),__float_as_uint(l_reg),false,false);l_reg=__uint_as_float(rr[0])+__uint_as_float(rr[1]);}
  if(hi==0)wsf[32+r32]=l_reg;asm volatile("s_waitcnt lgkmcnt(0)":::"memory");
  float rli[16];
  #pragma unroll
  for(int r=0;r<16;++r)rli[r]=__builtin_amdgcn_rcpf(wsf[32+crow(r,hi)]);
  bf16*Ow=O+(rowbase+q0+wid*QBLK)*(long)odm+h*D;
  { bf16*stg=(bf16*)(shm+LDS_OST)+wid*2048;
    #pragma unroll
    for(int r=0;r<16;++r){const int orow=crow(r,hi);
      #pragma unroll
      for(int d0=0;d0<2;++d0)stg[orow*64+d0*32+r32]=__float2bfloat16(o[d0][r]*rli[r]);}
    asm volatile("s_waitcnt lgkmcnt(0)":::"memory");
    #pragma unroll
    for(int i=0;i<4;++i){const int row=i*8+(lane>>3),ch=lane&7; const u32x4 v=*(const u32x4*)(stg+row*64+ch*8); ATTN_STORE16(Ow+(long)row*odm+ch*8,v);} }
  asm volatile("s_waitcnt lgkmcnt(0)\n\ts_barrier":::"memory");
  #undef DMA_K
  #undef DMA_V
  #undef CMASK
  #undef LOADB
  #undef LOADB1
  #undef START
  #undef RESC
  #undef ROT
}
constexpr int ATTN_LDS_BYTES=LDS_BYTES;
struct AttnTensors { const bf16* Q; const bf16* K; const bf16* V; bf16* O; const float* cl; const float* ctot; const float* kpart; int odm; };
template<int THRL> __device__ __forceinline__ void attn_phase(char*lds,const AttnTensors&T,int G,int vcu,int tid){
  constexpr int NP=NHEAD*NQB/2;
  for(int L=vcu;L<2*NP;L+=G){ const int p=L%NP, s=p%(NQB/2), qb=(L<NP)?(NQB-1-s):s, h=(L<NP)?p/(NQB/2):((p/(NQB/2)+NHEAD/2)%NHEAD);
    attn_unit<THRL>(0,h,qb,T.Q,T.K,T.V,T.O,T.cl+(long)h*SEQ,T.ctot+(long)h*(SEQ/64),T.kpart,lds,tid,T.odm); }
}
#undef SBAR
#undef WAIT_BAR
}

namespace cg = cooperative_groups;
#define LAS __attribute__((address_space(3)))
typedef unsigned short bfr;
typedef unsigned v4u __attribute__((ext_vector_type(4)));
typedef float f32x4 __attribute__((ext_vector_type(4)));
constexpr int M = 16384, D = 1024, FF = 2816, NGU = 2 * FF, ZP = 3072, INC = 3080, NMEM = 256, NH = 8, CW = 512, DEPTH = 2;
constexpr float EPS = 1e-6f, LOG2E = 1.4426950408889634f;
constexpr size_t KiB = 1024, MiB = 1u << 20;
constexpr size_t WS_MEMN = 0, WS_KMEM = 512 * KiB, WS_VT = 1024 * KiB, WS_MEMKV_L = 1 * MiB;
constexpr size_t WS_CL = 3 * MiB, WS_CTOT = 3 * MiB + 512 * KiB, WS_WF = 3 * MiB + 768 * KiB, WS_KPART = 3 * MiB + 576 * KiB, WS_BAR = 3 * MiB + 640 * KiB, WS_PCNT = 3 * MiB + 656 * KiB,     WS_STATS = 4 * MiB;
constexpr size_t WS_W = 8 * MiB, W_LAYER = 49 * MiB;
constexpr size_t OFF_GU1 = 0, OFF_D1 = 11 * MiB, OFF_MI = 16 * MiB + 512 * KiB, OFF_MO = 22 * MiB + 512 * KiB, OFF_XQ = 24 * MiB + 512 * KiB, OFF_XKV = 26 * MiB + 512 * KiB,
                 OFF_XO = 30 * MiB + 512 * KiB, OFF_GU2 = 32 * MiB + 512 * KiB, OFF_D2 = 43 * MiB + 512 * KiB;
static_assert(OFF_D2 + (size_t)D * FF * 2 == W_LAYER && OFF_D1 == (size_t)NGU * D * 2, "weight map");
constexpr size_t WS_XB = 106 * MiB, WS_BIG = 138 * MiB, WS_END = 234 * MiB;
constexpr int RSTD_OFF = 139264;
constexpr int LDS_MISC = 155648 - 64;
constexpr int LDS_BYTES = 155648;
static_assert(attn_body::LDS_BYTES <= LDS_MISC && pg8::STAGE_BYTES <= LDS_MISC, "LDS map");
static_assert(attn_body::LDS_BYTES <= LDS_BYTES && pg8::STAGE_BYTES <= LDS_BYTES, "LDS map");

__device__ __forceinline__ float wave_sum(float v, int lane) {
#pragma unroll
    for (int o = 1; o < 64; o <<= 1) v += lane_get(v, lane ^ o);
    return v;
}
__device__ __forceinline__ unsigned f2bf(float f) { unsigned u = __builtin_bit_cast(unsigned, f); return (u + 0x7fffu + ((u >> 16) & 1u)) >> 16; }
__device__ __forceinline__ unsigned pk2(float lo, float hi) { return f2bf(lo) | (f2bf(hi) << 16); }
__device__ __forceinline__ float bf_lo(unsigned u) { return __builtin_bit_cast(float, u << 16); }
__device__ __forceinline__ float bf_hi(unsigned u) { return __builtin_bit_cast(float, u & 0xffff0000u); }

constexpr int TR_SCR_BYTES = 17408;
__device__ __forceinline__ void p0_transpose_item(const float* W, int srcN, int K, int ndst, bfr* WT, LAS float* scr, int item, int lane, const float* g, int mode, float wsc = 1.0f) {
    const int nblk = ndst / 64, kb = item / nblk, nb = item % nblk, k0 = 64 * kb, n0 = 64 * nb;
    int sc = n0; if (mode == 1) { const int tile = n0 >> 8, loc = n0 & 255; sc = (loc < 128) ? (tile * 128 + loc) : (FF + tile * 128 + loc - 128); }
    const float* src = W + (size_t)k0 * srcN + sc + lane;
    float v[64];
#pragma unroll
    for (int kk = 0; kk < 64; ++kk) v[kk] = src[(size_t)kk * srcN];
    if (g) {
#pragma unroll
        for (int kk = 0; kk < 64; ++kk) v[kk] *= g[k0 + kk] * wsc; }
    else if (wsc != 1.0f) {
#pragma unroll
        for (int kk = 0; kk < 64; ++kk) v[kk] *= wsc; }
#pragma unroll
    for (int kk = 0; kk < 64; ++kk) scr[kk * 65 + lane] = v[kk];
    asm volatile("s_waitcnt lgkmcnt(0)" ::: "memory");
    const int c = lane & 7;
#pragma unroll
    for (int j = 0; j < 8; ++j) { const int n = (lane >> 3) + 8 * j; const LAS float* s = scr + (8 * c) * 65 + n;
        v4u o; o.x = pk2(s[0 * 65], s[1 * 65]); o.y = pk2(s[2 * 65], s[3 * 65]); o.z = pk2(s[4 * 65], s[5 * 65]); o.w = pk2(s[6 * 65], s[7 * 65]);
        store16_wt(WT + (size_t)(n0 + n) * K + k0 + 8 * c, o); }
    asm volatile("s_waitcnt lgkmcnt(0)" ::: "memory");
}
struct In { const float* p[21]; };
constexpr int I_GU = (D / 64) * (NGU / 64), I_DN = (FF / 64) * (D / 64), I_MI = (D / 64) * (ZP / 64), I_SQ = (D / 64) * (D / 64), I_KV = (D / 64) * (2 * D / 64);
constexpr int PER_LAYER = 2 * I_GU + 2 * I_DN + I_MI + 3 * I_SQ + I_KV;
__device__ __forceinline__ void convert_mat_item(const In& in, unsigned char* ws, int l, int mat, int r, LAS float* scr, int lane) {
    unsigned char* wl = ws + WS_W + (size_t)l * W_LAYER;
    switch (mat) {
    case 0: p0_transpose_item(in.p[3] + (size_t)l * D * NGU, NGU, D, NGU, (bfr*)(wl + OFF_GU1), scr, r, lane, in.p[2] + l * D, 1); break;
    case 1: p0_transpose_item(in.p[4] + (size_t)l * FF * D, D, FF, D, (bfr*)(wl + OFF_D1), scr, r, lane, nullptr, 0, 0.5f); break;
    case 2: p0_transpose_item(in.p[6] + (size_t)l * D * INC, INC, D, ZP, (bfr*)(wl + OFF_MI), scr, r, lane, in.p[5] + l * D, 0); break;
    case 3: p0_transpose_item(in.p[11] + (size_t)l * D * D, D, D, D, (bfr*)(wl + OFF_MO), scr, r, lane, nullptr, 0); break;
    case 4: p0_transpose_item(in.p[14] + (size_t)l * D * D, D, D, D, (bfr*)(wl + OFF_XQ), scr, r, lane, in.p[12] + l * D, 0); break;
    case 5: p0_transpose_item(in.p[15] + (size_t)l * D * 2 * D, 2 * D, D, 2 * D, (bfr*)(wl + OFF_XKV), scr, r, lane, in.p[13] + l * D, 0); break;
    case 6: p0_transpose_item(in.p[16] + (size_t)l * D * D, D, D, D, (bfr*)(wl + OFF_XO), scr, r, lane, nullptr, 0); break;
    case 7: p0_transpose_item(in.p[18] + (size_t)l * D * NGU, NGU, D, NGU, (bfr*)(wl + OFF_GU2), scr, r, lane, in.p[17] + l * D, 1); break;
    default: p0_transpose_item(in.p[19] + (size_t)l * FF * D, D, FF, D, (bfr*)(wl + OFF_D2), scr, r, lane, nullptr, 0, 0.5f); break;
    }
}
template <int STAGE> __device__ __forceinline__ constexpr int stage_items() {
    return STAGE == 0 ? I_GU + I_KV : STAGE == 1 ? I_DN + I_MI + 3 * I_SQ + I_GU : STAGE == 2 ? 2 * I_DN + I_GU + I_KV : STAGE == 3 ? I_MI + 3 * I_SQ + I_GU : I_DN;
}
#define CV_TRY(L_, MAT_, CNT_) if (k < (CNT_)) { convert_mat_item(in, ws, L_, MAT_, k, scr, lane); return; } k -= (CNT_);
template <int STAGE> __device__ __forceinline__ void convert_stage_item(const In& in, unsigned char* ws, int k, LAS float* scr, int lane) {
    if constexpr (STAGE == 0) { CV_TRY(0, 0, I_GU) CV_TRY(0, 5, I_KV) }
    else if constexpr (STAGE == 1) { CV_TRY(0, 1, I_DN) CV_TRY(0, 2, I_MI) CV_TRY(0, 3, I_SQ) CV_TRY(0, 4, I_SQ) CV_TRY(0, 6, I_SQ) CV_TRY(0, 7, I_GU) }
    else if constexpr (STAGE == 2) { CV_TRY(0, 8, I_DN) CV_TRY(1, 0, I_GU) CV_TRY(1, 5, I_KV) CV_TRY(1, 1, I_DN) }
    else if constexpr (STAGE == 3) { CV_TRY(1, 2, I_MI) CV_TRY(1, 3, I_SQ) CV_TRY(1, 4, I_SQ) CV_TRY(1, 6, I_SQ) CV_TRY(1, 7, I_GU) }
    else { CV_TRY(1, 8, I_DN) }
}
#undef CV_TRY
static_assert(stage_items<0>() + stage_items<1>() + stage_items<2>() + stage_items<3>() + stage_items<4>() == 2 * PER_LAYER, "conversion schedule covers every item once");
template <int STAGE> __device__ __forceinline__ void convert_in_idle_slot(const In& in, unsigned char* ws, LAS unsigned char* lds, int bx, int G, int wave, int lane) {
    constexpr int NU = (M / 256) * (NGU / 256);
    const int r = NU % G, idx = ((r != 0) ? bx - r : bx) - 8, nl = ((r != 0) ? G - r : G) - 8;
    if (idx < 0 || nl <= 0) return;
    LAS float* scr = (LAS float*)(lds + wave * TR_SCR_BYTES);
    for (int it = idx * 8 + wave; it < stage_items<STAGE>(); it += nl * 8) convert_stage_item<STAGE>(in, ws, it, scr, lane);
}
__device__ __forceinline__ void prologue_phase(const In& in, float* out, unsigned char* ws, LAS unsigned char* lds, int gw, int NGW, int wave, int lane) {
    LAS float* scr = (LAS float*)(lds + wave * TR_SCR_BYTES);
    for (int it = gw; it < stage_items<0>(); it += NGW) convert_stage_item<0>(in, ws, it, scr, lane);
    float* wf = (float*)(ws + WS_WF);
    for (int i = gw * 64 + lane; i < DEPTH * NH * D; i += NGW * 64) { const int l = i / (NH * D), h = (i / D) % NH, k = i % D; wf[i] = in.p[5][l * D + k] * in.p[6][((size_t)l * D + k) * INC + ZP + h]; }
    for (int m = gw; m < NMEM; m += NGW) { const f32x4* xr = (const f32x4*)(in.p[1] + (size_t)m * D) + lane; f32x4 v[4]; float s = 0.f;
#pragma unroll
        for (int j = 0; j < 4; ++j) { v[j] = xr[64 * j]; s += (v[j].x * v[j].x + v[j].y * v[j].y) + (v[j].z * v[j].z + v[j].w * v[j].w); }
        const float rstd = rsqrtf(wave_sum(s, lane) * (1.f / D) + EPS); unsigned long long* o8 = (unsigned long long*)((bfr*)(ws + WS_MEMN) + (size_t)m * D) + lane;
#pragma unroll
        for (int j = 0; j < 4; ++j) o8[64 * j] = (unsigned long long)pk2(v[j].x * rstd, v[j].y * rstd) | ((unsigned long long)pk2(v[j].z * rstd, v[j].w * rstd) << 32); }
    for (int m0 = gw; m0 < M; m0 += 4 * NGW) { f32x4 v[4][4]; float s[4];
#pragma unroll
        for (int u = 0; u < 4; ++u) { const int m = m0 + u * NGW; const f32x4* xr = (const f32x4*)(in.p[0] + (size_t)(m < M ? m : m0) * D) + lane;
#pragma unroll
            for (int j = 0; j < 4; ++j) v[u][j] = xr[64 * j]; }
#pragma unroll
        for (int u = 0; u < 4; ++u) { const int m = m0 + u * NGW; s[u] = 0.f; unsigned long long* o8 = (unsigned long long*)((bfr*)(ws + WS_XB) + (size_t)(m < M ? m : m0) * D) + lane;
#pragma unroll
            for (int j = 0; j < 4; ++j) { s[u] += (v[u][j].x * v[u][j].x + v[u][j].y * v[u][j].y) + (v[u][j].z * v[u][j].z + v[u][j].w * v[u][j].w);
                if (m < M) o8[64 * j] = (unsigned long long)pk2(v[u][j].x, v[u][j].y) | ((unsigned long long)pk2(v[u][j].z, v[u][j].w) << 32); } }
#pragma unroll
        for (int o = 1; o < 64; o <<= 1) {
#pragma unroll
            for (int u = 0; u < 4; ++u) s[u] += lane_get(s[u], lane ^ o); }
#pragma unroll
        for (int u = 0; u < 4; ++u) { const int m = m0 + u * NGW; if (m < M && lane < 16) ((float*)(ws + WS_STATS))[(size_t)m * 16 + lane] = lane == 0 ? s[u] : 0.f; } }
}
__device__ __forceinline__ void norm_phase(const float* x, bfr* xb, int gw, int NGW, int lane, float* zero16) {
    if (zero16 && gw == 0 && lane < 16) zero16[lane] = 0.f;
    for (int m = gw; m < M; m += NGW) { const f32x4* xr = (const f32x4*)(x + (size_t)m * D) + lane; f32x4 v[4]; float s = 0.f;
#pragma unroll
        for (int j = 0; j < 4; ++j) { v[j] = xr[64 * j]; s += (v[j].x * v[j].x + v[j].y * v[j].y) + (v[j].z * v[j].z + v[j].w * v[j].w); }
        const float rstd = rsqrtf(wave_sum(s, lane) * (1.f / D) + EPS); unsigned long long* o8 = (unsigned long long*)(xb + (size_t)m * D) + lane;
#pragma unroll
        for (int j = 0; j < 4; ++j) o8[64 * j] = (unsigned long long)pk2(v[j].x * rstd, v[j].y * rstd) | ((unsigned long long)pk2(v[j].z * rstd, v[j].w * rstd) << 32); }
}
__device__ __forceinline__ void final_phase(const bfr* xbs, float* x, const float* g, int gw, int NGW, int mend, int lane) {
    const f32x4* gr = (const f32x4*)g + lane; f32x4 gv[4];
#pragma unroll
    for (int j = 0; j < 4; ++j) gv[j] = gr[64 * j];
    for (int m0 = gw; m0 < mend; m0 += 4 * NGW) { f32x4 v[4][4]; float s[4];
#pragma unroll
        for (int u = 0; u < 4; ++u) { const int m = m0 + u * NGW; typedef unsigned u32x2 __attribute__((ext_vector_type(2))); const u32x2* xr = (const u32x2*)(xbs + (size_t)(m < mend ? m : m0) * D) + lane;
#pragma unroll
            for (int j = 0; j < 4; ++j) { const u32x2 w = xr[64 * j]; v[u][j] = (f32x4){bf_lo(w.x), bf_hi(w.x), bf_lo(w.y), bf_hi(w.y)}; } }
#pragma unroll
        for (int u = 0; u < 4; ++u) { s[u] = 0.f;
#pragma unroll
            for (int j = 0; j < 4; ++j) s[u] += (v[u][j].x * v[u][j].x + v[u][j].y * v[u][j].y) + (v[u][j].z * v[u][j].z + v[u][j].w * v[u][j].w); }
#pragma unroll
        for (int o = 1; o < 64; o <<= 1) {
#pragma unroll
            for (int u = 0; u < 4; ++u) s[u] += lane_get(s[u], lane ^ o); }
#pragma unroll
        for (int u = 0; u < 4; ++u) { const int m = m0 + u * NGW; if (m < mend) { const float rstd = rsqrtf(s[u] * (1.f / D) + EPS); f32x4* xr = (f32x4*)(x + (size_t)m * D) + lane;
#pragma unroll
            for (int j = 0; j < 4; ++j) xr[64 * j] = v[u][j] * rstd * gv[j]; } }
    }
}
__device__ __forceinline__ void fgate_phase(const bfr* x, const float* wf, const float* bfg, float* cl, float* ctot, LAS float* scr, int bx, int G, int tid, int lane, int wave) {
    for (int chunk = bx; chunk < M / 64; chunk += G) {
#pragma unroll 1
        for (int j = 0; j < 8; j += 2) { const int row = chunk * 64 + wave * 8 + j; typedef unsigned u32x2 __attribute__((ext_vector_type(2))); const u32x2* xa = (const u32x2*)(x + (size_t)row * D) + lane; const u32x2* xb2 = xa + D / 4; f32x4 va[4], vb[4]; float r[18]; int zo = 0; asm volatile("" : "+v"(zo));
#pragma unroll
            for (int jj = 0; jj < 4; ++jj) { const u32x2 wa = xa[64 * jj], wb = xb2[64 * jj]; va[jj] = (f32x4){bf_lo(wa.x), bf_hi(wa.x), bf_lo(wa.y), bf_hi(wa.y)}; vb[jj] = (f32x4){bf_lo(wb.x), bf_hi(wb.x), bf_lo(wb.y), bf_hi(wb.y)}; }
            r[16] = 0.f; r[17] = 0.f;
#pragma unroll
            for (int jj = 0; jj < 4; ++jj) { r[16] += (va[jj].x * va[jj].x + va[jj].y * va[jj].y) + (va[jj].z * va[jj].z + va[jj].w * va[jj].w); r[17] += (vb[jj].x * vb[jj].x + vb[jj].y * vb[jj].y) + (vb[jj].z * vb[jj].z + vb[jj].w * vb[jj].w); }
#pragma unroll
            for (int h = 0; h < NH; ++h) { const f32x4* wr = (const f32x4*)(wf + h * D) + lane + zo; float da = 0.f, db = 0.f;
#pragma unroll
                for (int jj = 0; jj < 4; ++jj) { const f32x4 w = wr[64 * jj]; da += (va[jj].x * w.x + va[jj].y * w.y) + (va[jj].z * w.z + va[jj].w * w.w); db += (vb[jj].x * w.x + vb[jj].y * w.y) + (vb[jj].z * w.z + vb[jj].w * w.w); }
                r[h] = da; r[8 + h] = db; }
#pragma unroll
            for (int o = 1; o < 64; o <<= 1) {
#pragma unroll
                for (int q = 0; q < 18; ++q) r[q] += lane_get(r[q], lane ^ o); }
            const float rsa = rsqrtf(r[16] * (1.f / D) + EPS), rsb = rsqrtf(r[17] * (1.f / D) + EPS);
            if (lane < 16) { const int h = lane & 7; float dsel = r[0];
#pragma unroll
                for (int q = 1; q < 16; ++q) dsel = (lane == q) ? r[q] : dsel;
                const float zz = dsel * (lane < 8 ? rsa : rsb) + bfg[h]; const float lf = fminf(zz, 0.f) - 0.6931471805599453f * __builtin_amdgcn_logf(1.0f + __builtin_amdgcn_exp2f(-LOG2E * fabsf(zz)));
                scr[(wave * 8 + j + (lane >> 3)) * 8 + h] = lf; } }
        __syncthreads();
        if (tid < NH) { float run = 0.f; for (int r = 0; r < 64; ++r) { run += scr[r * 8 + tid]; cl[(size_t)tid * M + chunk * 64 + r] = run; } ctot[tid * (M / 64) + chunk] = run; }
        __syncthreads();
    }
}
__device__ __forceinline__ void mixnorm_phase(bfr* z, const float* wconv, const float* gc, const float* ga, int p0, int pend, int pstep, int lane) {
    const int c8 = lane * 8; float w0[8], w1[8], w2[8], gcv[8], gav[8];
#pragma unroll
    for (int i = 0; i < 8; ++i) { w0[i] = wconv[c8 + i]; w1[i] = wconv[CW + c8 + i]; w2[i] = wconv[2 * CW + c8 + i]; gcv[i] = gc[c8 + i]; gav[i] = ga[c8 + i]; }
    for (int p = p0; p < pend; p += pstep) { const int r0 = 2 * p; bfr* zr = z + (size_t)r0 * ZP; const v4u z4 = {0u, 0u, 0u, 0u};
        const v4u zbA = *(const v4u*)(zr + c8), zbB = *(const v4u*)(zr + ZP + c8), oA = *(const v4u*)(zr + 3 * CW + c8), oB = *(const v4u*)(zr + ZP + 3 * CW + c8);
        const v4u cc0 = *(const v4u*)(zr + CW + c8), vv0 = *(const v4u*)(zr + 2 * CW + c8), cc1 = *(const v4u*)(zr + ZP + CW + c8), vv1 = *(const v4u*)(zr + ZP + 2 * CW + c8);
        const v4u cm1 = r0 >= 2 ? *(const v4u*)(zr - ZP + CW + c8) : z4, vm1 = r0 >= 2 ? *(const v4u*)(zr - ZP + 2 * CW + c8) : z4;
        const v4u cm2 = r0 >= 2 ? *(const v4u*)(zr - 2 * ZP + CW + c8) : z4, vm2 = r0 >= 2 ? *(const v4u*)(zr - 2 * ZP + 2 * CW + c8) : z4;
        float yA[8], yB[8], pA[8], pB[8]; float s4[4] = {0.f, 0.f, 0.f, 0.f};
#pragma unroll
        for (int q = 0; q < 4; ++q) {
            { const float um2 = bf_lo(cm2[q]) * bf_lo(vm2[q]), um1 = bf_lo(cm1[q]) * bf_lo(vm1[q]), u0 = bf_lo(cc0[q]) * bf_lo(vv0[q]), u1 = bf_lo(cc1[q]) * bf_lo(vv1[q]);
              const float a = bf_lo(zbA[q]) * (w0[2 * q] * um2 + w1[2 * q] * um1 + w2[2 * q] * u0), b = bf_lo(zbB[q]) * (w0[2 * q] * um1 + w1[2 * q] * u0 + w2[2 * q] * u1);
              yA[2 * q] = a; yB[2 * q] = b; s4[0] += a * a; s4[1] += b * b; const float e = bf_lo(oA[q]), f = bf_lo(oB[q]); pA[2 * q] = e; pB[2 * q] = f; s4[2] += e * e; s4[3] += f * f; }
            { const float um2 = bf_hi(cm2[q]) * bf_hi(vm2[q]), um1 = bf_hi(cm1[q]) * bf_hi(vm1[q]), u0 = bf_hi(cc0[q]) * bf_hi(vv0[q]), u1 = bf_hi(cc1[q]) * bf_hi(vv1[q]);
              const float a = bf_hi(zbA[q]) * (w0[2 * q + 1] * um2 + w1[2 * q + 1] * um1 + w2[2 * q + 1] * u0), b = bf_hi(zbB[q]) * (w0[2 * q + 1] * um1 + w1[2 * q + 1] * u0 + w2[2 * q + 1] * u1);
              yA[2 * q + 1] = a; yB[2 * q + 1] = b; s4[0] += a * a; s4[1] += b * b; const float e = bf_hi(oA[q]), f = bf_hi(oB[q]); pA[2 * q + 1] = e; pB[2 * q + 1] = f; s4[2] += e * e; s4[3] += f * f; } }
#pragma unroll
        for (int o = 1; o < 64; o <<= 1) {
#pragma unroll
            for (int u = 0; u < 4; ++u) s4[u] += lane_get(s4[u], lane ^ o); }
        const float rcA = rsqrtf(s4[0] * (1.f / CW) + EPS), rcB = rsqrtf(s4[1] * (1.f / CW) + EPS), raA = rsqrtf(s4[2] * (1.f / CW) + EPS), raB = rsqrtf(s4[3] * (1.f / CW) + EPS);
        v4u ocA, ocB, oaA, oaB;
#pragma unroll
        for (int q = 0; q < 4; ++q) { ocA[q] = pk2(yA[2 * q] * rcA * gcv[2 * q], yA[2 * q + 1] * rcA * gcv[2 * q + 1]); ocB[q] = pk2(yB[2 * q] * rcB * gcv[2 * q], yB[2 * q + 1] * rcB * gcv[2 * q + 1]);
            oaA[q] = pk2(pA[2 * q] * raA * gav[2 * q], pA[2 * q + 1] * raA * gav[2 * q + 1]); oaB[q] = pk2(pB[2 * q] * raB * gav[2 * q], pB[2 * q + 1] * raB * gav[2 * q + 1]); }
        store16_wt(zr + 4 * CW + c8, ocA); store16_wt(zr + 5 * CW + c8, oaA); store16_wt(zr + ZP + 4 * CW + c8, ocB); store16_wt(zr + ZP + 5 * CW + c8, oaB); }
}

#define XB_TMO      128
#define XB_XCNT(j)  (256  + 64 * (j))
#define XB_XSUB(j)  (1280 + 64 * (j))
#define XB_XGEN(j)  (2304 + 64 * (j))
#define XB_TOP      3328
#define XB_TOPGEN   3392
#define XCD_BAR_WORDS 3456
#define XB_SPIN_CAP (1u << 18)

__device__ __forceinline__ unsigned xb_ld(unsigned* p)              { return __hip_atomic_load(p, __ATOMIC_RELAXED, __HIP_MEMORY_SCOPE_AGENT); }
__device__ __forceinline__ unsigned xb_add(unsigned* p, unsigned v) { return __hip_atomic_fetch_add(p, v, __ATOMIC_RELAXED, __HIP_MEMORY_SCOPE_AGENT); }
__device__ __forceinline__ unsigned xb_xcc_id() { return (unsigned)__builtin_amdgcn_s_getreg((3 << 11) | 20) & 0xFu; }
#define XB_SPIN(cond, bar) do { unsigned _sp = 0; while (cond) { __builtin_amdgcn_s_sleep(1); \
    if ((++_sp & 255u) == 0u) { if (xb_ld(&(bar)[XB_TMO])) break; if (_sp > XB_SPIN_CAP) { atomicAdd(&(bar)[XB_TMO], 1u); break; } } } } while (0)

struct XcdBarrier {
    unsigned* bar; unsigned x;
    volatile LAS unsigned* st;
};

__device__ __forceinline__ XcdBarrier xcd_barrier_post(unsigned* bar, volatile LAS unsigned* st) {
    XcdBarrier b; b.bar = bar; b.x = xb_xcc_id(); b.st = st;
    if (threadIdx.x == 0) (void)xb_add(&bar[XB_XCNT(b.x)], 1u);
    return b;
}
__device__ __forceinline__ void xcd_barrier_complete(unsigned* bar, unsigned x, unsigned& nloc, unsigned& nx) {
    const unsigned G = gridDim.x * gridDim.y * gridDim.z;
    unsigned sum, cnt, mine, sp = 0u;
    for (;;) {
        sum = 0u; cnt = 0u; mine = 0u;
#pragma unroll
        for (unsigned j = 0; j < 16; ++j) { const unsigned c = xb_ld(&bar[XB_XCNT(j)]); sum += c; cnt += (c > 0u) ? 1u : 0u; mine = (j == x) ? c : mine; }
        if (sum == G) break;
        __builtin_amdgcn_s_sleep(1);
        if ((++sp & 255u) == 0u) { if (xb_ld(&bar[XB_TMO])) break; if (sp > XB_SPIN_CAP) { atomicAdd(&bar[XB_TMO], 1u); break; } }
    }
    nloc = mine > 0u ? mine : 1u; nx = cnt > 0u ? cnt : 1u;
}

__device__ __forceinline__ void xcd_barrier(const XcdBarrier& b) {
    asm volatile("s_waitcnt vmcnt(0)" ::: "memory");
    __syncthreads();
    if (threadIdx.x == 0) {
        unsigned* bar = b.bar;
        __builtin_amdgcn_s_waitcnt(0);
        unsigned nloc = b.st[0], nx = b.st[1];
        if (nloc == 0u) { xcd_barrier_complete(bar, b.x, nloc, nx); b.st[0] = nloc; b.st[1] = nx; }
        const unsigned old = xb_add(&bar[XB_XSUB(b.x)], 1u);
        const unsigned gen = old / nloc;
        if (old + 1u == (gen + 1u) * nloc) {
            __builtin_amdgcn_fence(__ATOMIC_RELEASE, "agent");
            asm volatile("s_waitcnt vmcnt(0)" ::: "memory");
            const unsigned og = xb_add(&bar[XB_TOP], 1u);
            const unsigned tg = og / nx;
            if (og + 1u == (tg + 1u) * nx) xb_add(&bar[XB_TOPGEN], 1u);
            else XB_SPIN(xb_ld(&bar[XB_TOPGEN]) == tg, bar);
            __builtin_amdgcn_fence(__ATOMIC_ACQUIRE, "agent");
            xb_add(&bar[XB_XGEN(b.x)], 1u);
            asm volatile("s_waitcnt vmcnt(0)" ::: "memory");
        } else {
            XB_SPIN(xb_ld(&bar[XB_XGEN(b.x)]) == gen, bar);
            __builtin_amdgcn_fence(__ATOMIC_ACQUIRE, "agent");
            asm volatile("s_waitcnt vmcnt(0)" ::: "memory");
        }
    }
    __syncthreads();
}

__device__ __forceinline__ int opaque_s(int v, int z) { return __builtin_amdgcn_readfirstlane(v + z); }
template <class T> __device__ __forceinline__ T* opaque_p(T* p, int z) { return (T*)((unsigned char*)p + (size_t)(unsigned)__builtin_amdgcn_readfirstlane(z)); }
__device__ __forceinline__ void panel_sync(unsigned* w) {
    asm volatile("s_waitcnt vmcnt(0)" ::: "memory"); __syncthreads();
    if (threadIdx.x == 0) { __hip_atomic_fetch_add(w, 1u, __ATOMIC_RELAXED, __HIP_MEMORY_SCOPE_AGENT); unsigned sp = 0;
        while (__hip_atomic_load(w, __ATOMIC_RELAXED, __HIP_MEMORY_SCOPE_AGENT) < 4u) { __builtin_amdgcn_s_sleep(1); if (++sp > (1u << 22)) break; }
        __builtin_amdgcn_fence(__ATOMIC_ACQUIRE, "agent"); asm volatile("s_waitcnt vmcnt(0)" ::: "memory"); }
    __syncthreads();
}
struct Args { const float* in[21]; float* out; unsigned char* ws; int ph_lo, ph_hi; };
constexpr int NPH = 1 + DEPTH * 8;
#ifndef MK_ONE_LAUNCH
#define MK_ONE_LAUNCH 1
#endif
__global__ void __launch_bounds__(512, 2) mk_fwd(Args a) {
    extern __shared__ __attribute__((aligned(16))) unsigned char lds_raw[];
    LAS unsigned char* lds = (LAS unsigned char*)lds_raw;
    const int lo = a.ph_lo, hi = a.ph_hi; int ph = 0;
    if (threadIdx.x < 16) ((LAS unsigned*)(lds + LDS_MISC))[threadIdx.x] = 0u;
    __syncthreads();
    XcdBarrier xbar; xbar.bar = nullptr; xbar.x = 0; xbar.st = nullptr;
    if (hi - lo > 1) xbar = xcd_barrier_post((unsigned*)(a.ws + WS_BAR), (volatile LAS unsigned*)(lds + LDS_MISC));
    if (hi < 0) cg::this_grid().sync();
#define PH_BEGIN if (ph >= lo && ph < hi) { int tid = threadIdx.x, zz_ = 0; asm volatile("" : "+v"(tid), "+v"(zz_)); \
    unsigned char* const ws = opaque_p(a.ws, zz_); float* const out = opaque_p(a.out, zz_); const int G = opaque_s((int)gridDim.x, zz_), bx = opaque_s((int)blockIdx.x, zz_); \
    const int lane = tid & 63, wave = __builtin_amdgcn_readfirstlane(tid >> 6), vcu = (G % 8 == 0) ? (bx % 8) * (G / 8) + bx / 8 : bx, gw = bx * 8 + wave, NGW = G * 8; \
    (void)lane; (void)vcu; (void)gw; (void)NGW; \
    bfr* const xb = (bfr*)(ws + WS_XB); bfr* const big = (bfr*)(ws + WS_BIG); bfr* const memn = (bfr*)(ws + WS_MEMN); \
    bfr* const act = big; bfr* const z = big; bfr* const qx = big; bfr* const Pb = big + (size_t)M * D; bfr* const ox = big + 2 * (size_t)M * D; \
    float* const cl = (float*)(ws + WS_CL); float* const ctot = (float*)(ws + WS_CTOT); float* const stats = (float*)(ws + WS_STATS); (void)stats; \
    const unsigned char* const wl = ws + WS_W + (size_t)l * W_LAYER; bfr* const kmem = (bfr*)(ws + WS_KMEM + (size_t)l * WS_MEMKV_L); bfr* const vt = (bfr*)(ws + WS_VT + (size_t)l * WS_MEMKV_L); \
    (void)xb; (void)memn; (void)act; (void)z; (void)qx; (void)Pb; (void)ox; (void)cl; (void)ctot; (void)wl; (void)kmem; (void)vt;
#define PH_END   if (ph + 1 < hi) xcd_barrier(xbar); } ++ph;
    using pg8::Gemm; using pg8::StaticOrder; using pg8::gemm_phase;

    { const int l = 0; PH_BEGIN { In in;
#pragma unroll
        for (int i = 0; i < 21; ++i) in.p[i] = a.in[i];
        prologue_phase(in, out, ws, lds, gw, NGW, wave, lane); } PH_END }

    { constexpr int l = 0; constexpr int f = 0;
            PH_BEGIN {
                const Gemm g{xb, (const bfr*)(wl + (f ? OFF_GU2 : OFF_GU1)), M, NGU, D, D, D, 0, 256L * D}; StaticOrder S; S.init(M, NGU, G, bx);
                const pg8::EpiSwiglu E{act, FF, (const LAS float*)(lds + RSTD_OFF)}; pg8::fill_rstd_table((LAS float*)(lds + RSTD_OFF), stats, S, tid);
                if (f == 0 && bx == 0 && tid < 16) ((float*)(ws + WS_KPART))[tid] = 0.f;
                gemm_phase<pg8::EpiSwiglu, StaticOrder, true, true>(lds, g, S, E, tid);
                { In in;
#pragma unroll
                    for (int i = 0; i < 21; ++i) in.p[i] = a.in[i];
                    convert_in_idle_slot<1 + 2 * l + f>(in, ws, lds, bx, G, wave, lane); __syncthreads(); }
                if (f == 0) {
                    const Gemm gk{memn, (const bfr*)(wl + OFF_XKV), NMEM, D, D, D, D, 0, 256L * D}; StaticOrder Sk; Sk.init(NMEM, D, G, (bx + G - 128 % G) % G);
                    const pg8::EpiScaleBf16 Ek{kmem, D, 1.f, 0, 0, 1.f, nullptr, true};
                    gemm_phase<pg8::EpiScaleBf16, StaticOrder, true, true>(lds, gk, Sk, Ek, tid);
                    const Gemm gv{(const bfr*)(wl + OFF_XKV) + (size_t)D * D, memn, D, NMEM, D, D, D, 0, 256L * D}; StaticOrder Sv; Sv.init(D, NMEM, G, (bx + G - 132 % G) % G);
                    const pg8::EpiScaleBf16 Ev{vt, NMEM, 1.f, 0, 0, 1.f, nullptr, true};
                    gemm_phase<pg8::EpiScaleBf16, StaticOrder, true, true>(lds, gv, Sv, Ev, tid);
                } } PH_END
            PH_BEGIN {
                const Gemm g{act, (const bfr*)(wl + (f ? OFF_D2 : OFF_D1)), M, D, FF, FF, FF, 0, 256L * FF}; StaticOrder S; S.init(M, D, G, bx);
                const pg8::EpiResid E{xb, D, stats};
                gemm_phase<pg8::EpiResid, StaticOrder, true, true>(lds, g, S, E, tid);
                if constexpr (l == DEPTH - 1 && f == 1) {
                    pg8::Unit u0; if (S.next(0, u0)) { panel_sync((unsigned*)(ws + WS_PCNT) + 4 * 4096 + 64 * u0.pm); const int rb = u0.pm * 256 + u0.pn * 64; final_phase(xb, out, a.in[20], rb + wave, 8, rb + 64, lane); } }
                } PH_END
            if (f == 0) {
                PH_BEGIN {
                    const Gemm g{xb, (const bfr*)(wl + OFF_MI), M, ZP, D, D, D, 0, 256L * D}; StaticOrder S; S.init(M, ZP, G, bx);
                    const pg8::EpiMixIn E{z, ZP, attn_body::C2, (float*)(ws + WS_KPART), (const LAS float*)(lds + RSTD_OFF)}; pg8::fill_rstd_table((LAS float*)(lds + RSTD_OFF), stats, S, tid);
                    gemm_phase<pg8::EpiMixIn, StaticOrder, true, true>(lds, g, S, E, tid);
                    fgate_phase(xb, (const float*)(ws + WS_WF) + (size_t)l * NH * D, a.in[8] + l * NH, cl, ctot, (LAS float*)lds, bx, G, tid, lane, wave);
                    } PH_END
                PH_BEGIN {
                    const attn_body::AttnTensors AT{(const attn_body::bf16*)(z + 3 * CW), (const attn_body::bf16*)(z + 4 * CW), (const attn_body::bf16*)(z + 5 * CW), (attn_body::bf16*)(z + 3 * CW), cl, ctot, (const float*)(ws + WS_KPART), ZP};
                    attn_body::attn_phase<32>((char*)lds_raw, AT, G, vcu, tid);
                    } PH_END
                PH_BEGIN {
                    const Gemm g{z + 4 * CW, (const bfr*)(wl + OFF_MO), M, D, D, ZP, D, 0, 256L * D}; StaticOrder S; S.init(M, D, G, bx);
                    { pg8::Unit u0; if (S.next(0, u0)) { const int pb = (u0.pm * 256 + u0.pn * 64) / 2;
                        mixnorm_phase(z, a.in[7] + (size_t)l * 3 * CW, a.in[9] + l * CW, a.in[10] + l * CW, pb + wave, pb + 32, 8, lane);
                        panel_sync((unsigned*)(ws + WS_PCNT) + (2 * l + 0) * 4096 + 64 * u0.pm); } }
                    const pg8::EpiResid E{xb, D, stats};
                    gemm_phase<pg8::EpiResid, StaticOrder, true, true>(lds, g, S, E, tid); } PH_END
                PH_BEGIN {
                    const Gemm g{xb, (const bfr*)(wl + OFF_XQ), M, D, D, D, D, 0, 256L * D}; StaticOrder S; S.init(M, D, G, bx);
                    const pg8::EpiScaleBf16 E{qx, D, 0.0625f * LOG2E, 0, 0, 1.f, stats, false};
                    gemm_phase<pg8::EpiScaleBf16, StaticOrder, true, true>(lds, g, S, E, tid);
                    asm volatile("s_waitcnt vmcnt(0)" ::: "memory"); __syncthreads(); if (tid == 0) { __builtin_amdgcn_fence(__ATOMIC_ACQUIRE, "agent"); asm volatile("s_waitcnt vmcnt(0)" ::: "memory"); } __syncthreads();
                    const Gemm gs{qx, kmem, M, D, 256, D, D, 256, 256};
                    const pg8::EpiSoftmax Es{Pb, D};
                    gemm_phase<pg8::EpiSoftmax, StaticOrder, false, true>(lds, gs, S, Es, tid);
                    asm volatile("s_waitcnt vmcnt(0)" ::: "memory"); __syncthreads(); if (tid == 0) { __builtin_amdgcn_fence(__ATOMIC_ACQUIRE, "agent"); asm volatile("s_waitcnt vmcnt(0)" ::: "memory"); } __syncthreads();
                    const Gemm go{Pb, vt, M, D, 256, D, 256, 256, 256L * 256};
                    const pg8::EpiScaleBf16 Eo{ox, D, 1.f, 0, 0, 1.f, nullptr, true};
                    gemm_phase<pg8::EpiScaleBf16, StaticOrder, true, true>(lds, go, S, Eo, tid);
                    { pg8::Unit u0; if (S.next(0, u0)) panel_sync((unsigned*)(ws + WS_PCNT) + (2 * l + 1) * 4096 + 64 * u0.pm); }
                    const Gemm gx{ox, (const bfr*)(wl + OFF_XO), M, D, D, D, D, 0, 256L * D};
                    const pg8::EpiResid Ex{xb, D, stats};
                    gemm_phase<pg8::EpiResid, StaticOrder, true, true>(lds, gx, S, Ex, tid); } PH_END
            }
    }
    { constexpr int l = 0; constexpr int f = 1;
            PH_BEGIN {
                const Gemm g{xb, (const bfr*)(wl + (f ? OFF_GU2 : OFF_GU1)), M, NGU, D, D, D, 0, 256L * D}; StaticOrder S; S.init(M, NGU, G, bx);
                const pg8::EpiSwiglu E{act, FF, (const LAS float*)(lds + RSTD_OFF)}; pg8::fill_rstd_table((LAS float*)(lds + RSTD_OFF), stats, S, tid);
                if (f == 0 && bx == 0 && tid < 16) ((float*)(ws + WS_KPART))[tid] = 0.f;
                gemm_phase<pg8::EpiSwiglu, StaticOrder, true, true>(lds, g, S, E, tid);
                { In in;
#pragma unroll
                    for (int i = 0; i < 21; ++i) in.p[i] = a.in[i];
                    convert_in_idle_slot<1 + 2 * l + f>(in, ws, lds, bx, G, wave, lane); __syncthreads(); }
                if (f == 0) {
                    const Gemm gk{memn, (const bfr*)(wl + OFF_XKV), NMEM, D, D, D, D, 0, 256L * D}; StaticOrder Sk; Sk.init(NMEM, D, G, (bx + G - 128 % G) % G);
                    const pg8::EpiScaleBf16 Ek{kmem, D, 1.f, 0, 0, 1.f, nullptr, true};
                    gemm_phase<pg8::EpiScaleBf16, StaticOrder, true, true>(lds, gk, Sk, Ek, tid);
                    const Gemm gv{(const bfr*)(wl + OFF_XKV) + (size_t)D * D, memn, D, NMEM, D, D, D, 0, 256L * D}; StaticOrder Sv; Sv.init(D, NMEM, G, (bx + G - 132 % G) % G);
                    const pg8::EpiScaleBf16 Ev{vt, NMEM, 1.f, 0, 0, 1.f, nullptr, true};
                    gemm_phase<pg8::EpiScaleBf16, StaticOrder, true, true>(lds, gv, Sv, Ev, tid);
                } } PH_END
            PH_BEGIN {
                const Gemm g{act, (const bfr*)(wl + (f ? OFF_D2 : OFF_D1)), M, D, FF, FF, FF, 0, 256L * FF}; StaticOrder S; S.init(M, D, G, bx);
                const pg8::EpiResid E{xb, D, stats};
                gemm_phase<pg8::EpiResid, StaticOrder, true, true>(lds, g, S, E, tid);
                if constexpr (l == DEPTH - 1 && f == 1) {
                    pg8::Unit u0; if (S.next(0, u0)) { panel_sync((unsigned*)(ws + WS_PCNT) + 4 * 4096 + 64 * u0.pm); const int rb = u0.pm * 256 + u0.pn * 64; final_phase(xb, out, a.in[20], rb + wave, 8, rb + 64, lane); } }
                } PH_END
            if (f == 0) {
                PH_BEGIN {
                    const Gemm g{xb, (const bfr*)(wl + OFF_MI), M, ZP, D, D, D, 0, 256L * D}; StaticOrder S; S.init(M, ZP, G, bx);
                    const pg8::EpiMixIn E{z, ZP, attn_body::C2, (float*)(ws + WS_KPART), (const LAS float*)(lds + RSTD_OFF)}; pg8::fill_rstd_table((LAS float*)(lds + RSTD_OFF), stats, S, tid);
                    gemm_phase<pg8::EpiMixIn, StaticOrder, true, true>(lds, g, S, E, tid);
                    fgate_phase(xb, (const float*)(ws + WS_WF) + (size_t)l * NH * D, a.in[8] + l * NH, cl, ctot, (LAS float*)lds, bx, G, tid, lane, wave);
                    } PH_END
                PH_BEGIN {
                    const attn_body::AttnTensors AT{(const attn_body::bf16*)(z + 3 * CW), (const attn_body::bf16*)(z + 4 * CW), (const attn_body::bf16*)(z + 5 * CW), (attn_body::bf16*)(z + 3 * CW), cl, ctot, (const float*)(ws + WS_KPART), ZP};
                    attn_body::attn_phase<32>((char*)lds_raw, AT, G, vcu, tid);
                    } PH_END
                PH_BEGIN {
                    const Gemm g{z + 4 * CW, (const bfr*)(wl + OFF_MO), M, D, D, ZP, D, 0, 256L * D}; StaticOrder S; S.init(M, D, G, bx);
                    { pg8::Unit u0; if (S.next(0, u0)) { const int pb = (u0.pm * 256 + u0.pn * 64) / 2;
                        mixnorm_phase(z, a.in[7] + (size_t)l * 3 * CW, a.in[9] + l * CW, a.in[10] + l * CW, pb + wave, pb + 32, 8, lane);
                        panel_sync((unsigned*)(ws + WS_PCNT) + (2 * l + 0) * 4096 + 64 * u0.pm); } }
                    const pg8::EpiResid E{xb, D, stats};
                    gemm_phase<pg8::EpiResid, StaticOrder, true, true>(lds, g, S, E, tid); } PH_END
                PH_BEGIN {
                    const Gemm g{xb, (const bfr*)(wl + OFF_XQ), M, D, D, D, D, 0, 256L * D}; StaticOrder S; S.init(M, D, G, bx);
                    const pg8::EpiScaleBf16 E{qx, D, 0.0625f * LOG2E, 0, 0, 1.f, stats, false};
                    gemm_phase<pg8::EpiScaleBf16, StaticOrder, true, true>(lds, g, S, E, tid);
                    asm volatile("s_waitcnt vmcnt(0)" ::: "memory"); __syncthreads(); if (tid == 0) { __builtin_amdgcn_fence(__ATOMIC_ACQUIRE, "agent"); asm volatile("s_waitcnt vmcnt(0)" ::: "memory"); } __syncthreads();
                    const Gemm gs{qx, kmem, M, D, 256, D, D, 256, 256};
                    const pg8::EpiSoftmax Es{Pb, D};
                    gemm_phase<pg8::EpiSoftmax, StaticOrder, false, true>(lds, gs, S, Es, tid);
                    asm volatile("s_waitcnt vmcnt(0)" ::: "memory"); __syncthreads(); if (tid == 0) { __builtin_amdgcn_fence(__ATOMIC_ACQUIRE, "agent"); asm volatile("s_waitcnt vmcnt(0)" ::: "memory"); } __syncthreads();
                    const Gemm go{Pb, vt, M, D, 256, D, 256, 256, 256L * 256};
                    const pg8::EpiScaleBf16 Eo{ox, D, 1.f, 0, 0, 1.f, nullptr, true};
                    gemm_phase<pg8::EpiScaleBf16, StaticOrder, true, true>(lds, go, S, Eo, tid);
                    { pg8::Unit u0; if (S.next(0, u0)) panel_sync((unsigned*)(ws + WS_PCNT) + (2 * l + 1) * 4096 + 64 * u0.pm); }
                    const Gemm gx{ox, (const bfr*)(wl + OFF_XO), M, D, D, D, D, 0, 256L * D};
                    const pg8::EpiResid Ex{xb, D, stats};
                    gemm_phase<pg8::EpiResid, StaticOrder, true, true>(lds, gx, S, Ex, tid); } PH_END
            }
    }
    { constexpr int l = 1; constexpr int f = 0;
            PH_BEGIN {
                const Gemm g{xb, (const bfr*)(wl + (f ? OFF_GU2 : OFF_GU1)), M, NGU, D, D, D, 0, 256L * D}; StaticOrder S; S.init(M, NGU, G, bx);
                const pg8::EpiSwiglu E{act, FF, (const LAS float*)(lds + RSTD_OFF)}; pg8::fill_rstd_table((LAS float*)(lds + RSTD_OFF), stats, S, tid);
                if (f == 0 && bx == 0 && tid < 16) ((float*)(ws + WS_KPART))[tid] = 0.f;
                gemm_phase<pg8::EpiSwiglu, StaticOrder, true, true>(lds, g, S, E, tid);
                { In in;
#pragma unroll
                    for (int i = 0; i < 21; ++i) in.p[i] = a.in[i];
                    convert_in_idle_slot<1 + 2 * l + f>(in, ws, lds, bx, G, wave, lane); __syncthreads(); }
                if (f == 0) {
                    const Gemm gk{memn, (const bfr*)(wl + OFF_XKV), NMEM, D, D, D, D, 0, 256L * D}; StaticOrder Sk; Sk.init(NMEM, D, G, (bx + G - 128 % G) % G);
                    const pg8::EpiScaleBf16 Ek{kmem, D, 1.f, 0, 0, 1.f, nullptr, true};
                    gemm_phase<pg8::EpiScaleBf16, StaticOrder, true, true>(lds, gk, Sk, Ek, tid);
                    const Gemm gv{(const bfr*)(wl + OFF_XKV) + (size_t)D * D, memn, D, NMEM, D, D, D, 0, 256L * D}; StaticOrder Sv; Sv.init(D, NMEM, G, (bx + G - 132 % G) % G);
                    const pg8::EpiScaleBf16 Ev{vt, NMEM, 1.f, 0, 0, 1.f, nullptr, true};
                    gemm_phase<pg8::EpiScaleBf16, StaticOrder, true, true>(lds, gv, Sv, Ev, tid);
                } } PH_END
            PH_BEGIN {
                const Gemm g{act, (const bfr*)(wl + (f ? OFF_D2 : OFF_D1)), M, D, FF, FF, FF, 0, 256L * FF}; StaticOrder S; S.init(M, D, G, bx);
                const pg8::EpiResid E{xb, D, stats};
                gemm_phase<pg8::EpiResid, StaticOrder, true, true>(lds, g, S, E, tid);
                if constexpr (l == DEPTH - 1 && f == 1) {
                    pg8::Unit u0; if (S.next(0, u0)) { panel_sync((unsigned*)(ws + WS_PCNT) + 4 * 4096 + 64 * u0.pm); const int rb = u0.pm * 256 + u0.pn * 64; final_phase(xb, out, a.in[20], rb + wave, 8, rb + 64, lane); } }
                } PH_END
            if (f == 0) {
                PH_BEGIN {
                    const Gemm g{xb, (const bfr*)(wl + OFF_MI), M, ZP, D, D, D, 0, 256L * D}; StaticOrder S; S.init(M, ZP, G, bx);
                    const pg8::EpiMixIn E{z, ZP, attn_body::C2, (float*)(ws + WS_KPART), (const LAS float*)(lds + RSTD_OFF)}; pg8::fill_rstd_table((LAS float*)(lds + RSTD_OFF), stats, S, tid);
                    gemm_phase<pg8::EpiMixIn, StaticOrder, true, true>(lds, g, S, E, tid);
                    fgate_phase(xb, (const float*)(ws + WS_WF) + (size_t)l * NH * D, a.in[8] + l * NH, cl, ctot, (LAS float*)lds, bx, G, tid, lane, wave);
                    } PH_END
                PH_BEGIN {
                    const attn_body::AttnTensors AT{(const attn_body::bf16*)(z + 3 * CW), (const attn_body::bf16*)(z + 4 * CW), (const attn_body::bf16*)(z + 5 * CW), (attn_body::bf16*)(z + 3 * CW), cl, ctot, (const float*)(ws + WS_KPART), ZP};
                    attn_body::attn_phase<32>((char*)lds_raw, AT, G, vcu, tid);
                    } PH_END
                PH_BEGIN {
                    const Gemm g{z + 4 * CW, (const bfr*)(wl + OFF_MO), M, D, D, ZP, D, 0, 256L * D}; StaticOrder S; S.init(M, D, G, bx);
                    { pg8::Unit u0; if (S.next(0, u0)) { const int pb = (u0.pm * 256 + u0.pn * 64) / 2;
                        mixnorm_phase(z, a.in[7] + (size_t)l * 3 * CW, a.in[9] + l * CW, a.in[10] + l * CW, pb + wave, pb + 32, 8, lane);
                        panel_sync((unsigned*)(ws + WS_PCNT) + (2 * l + 0) * 4096 + 64 * u0.pm); } }
                    const pg8::EpiResid E{xb, D, stats};
                    gemm_phase<pg8::EpiResid, StaticOrder, true, true>(lds, g, S, E, tid); } PH_END
                PH_BEGIN {
                    const Gemm g{xb, (const bfr*)(wl + OFF_XQ), M, D, D, D, D, 0, 256L * D}; StaticOrder S; S.init(M, D, G, bx);
                    const pg8::EpiScaleBf16 E{qx, D, 0.0625f * LOG2E, 0, 0, 1.f, stats, false};
                    gemm_phase<pg8::EpiScaleBf16, StaticOrder, true, true>(lds, g, S, E, tid);
                    asm volatile("s_waitcnt vmcnt(0)" ::: "memory"); __syncthreads(); if (tid == 0) { __builtin_amdgcn_fence(__ATOMIC_ACQUIRE, "agent"); asm volatile("s_waitcnt vmcnt(0)" ::: "memory"); } __syncthreads();
                    const Gemm gs{qx, kmem, M, D, 256, D, D, 256, 256};
                    const pg8::EpiSoftmax Es{Pb, D};
                    gemm_phase<pg8::EpiSoftmax, StaticOrder, false, true>(lds, gs, S, Es, tid);
                    asm volatile("s_waitcnt vmcnt(0)" ::: "memory"); __syncthreads(); if (tid == 0) { __builtin_amdgcn_fence(__ATOMIC_ACQUIRE, "agent"); asm volatile("s_waitcnt vmcnt(0)" ::: "memory"); } __syncthreads();
                    const Gemm go{Pb, vt, M, D, 256, D, 256, 256, 256L * 256};
                    const pg8::EpiScaleBf16 Eo{ox, D, 1.f, 0, 0, 1.f, nullptr, true};
                    gemm_phase<pg8::EpiScaleBf16, StaticOrder, true, true>(lds, go, S, Eo, tid);
                    { pg8::Unit u0; if (S.next(0, u0)) panel_sync((unsigned*)(ws + WS_PCNT) + (2 * l + 1) * 4096 + 64 * u0.pm); }
                    const Gemm gx{ox, (const bfr*)(wl + OFF_XO), M, D, D, D, D, 0, 256L * D};
                    const pg8::EpiResid Ex{xb, D, stats};
                    gemm_phase<pg8::EpiResid, StaticOrder, true, true>(lds, gx, S, Ex, tid); } PH_END
            }
    }
    { constexpr int l = 1; constexpr int f = 1;
            PH_BEGIN {
                const Gemm g{xb, (const bfr*)(wl + (f ? OFF_GU2 : OFF_GU1)), M, NGU, D, D, D, 0, 256L * D}; StaticOrder S; S.init(M, NGU, G, bx);
                const pg8::EpiSwiglu E{act, FF, (const LAS float*)(lds + RSTD_OFF)}; pg8::fill_rstd_table((LAS float*)(lds + RSTD_OFF), stats, S, tid);
                if (f == 0 && bx == 0 && tid < 16) ((float*)(ws + WS_KPART))[tid] = 0.f;
                gemm_phase<pg8::EpiSwiglu, StaticOrder, true, true>(lds, g, S, E, tid);
                { In in;
#pragma unroll
                    for (int i = 0; i < 21; ++i) in.p[i] = a.in[i];
                    convert_in_idle_slot<1 + 2 * l + f>(in, ws, lds, bx, G, wave, lane); __syncthreads(); }
                if (f == 0) {
                    const Gemm gk{memn, (const bfr*)(wl + OFF_XKV), NMEM, D, D, D, D, 0, 256L * D}; StaticOrder Sk; Sk.init(NMEM, D, G, (bx + G - 128 % G) % G);
                    const pg8::EpiScaleBf16 Ek{kmem, D, 1.f, 0, 0, 1.f, nullptr, true};
                    gemm_phase<pg8::EpiScaleBf16, StaticOrder, true, true>(lds, gk, Sk, Ek, tid);
                    const Gemm gv{(const bfr*)(wl + OFF_XKV) + (size_t)D * D, memn, D, NMEM, D, D, D, 0, 256L * D}; StaticOrder Sv; Sv.init(D, NMEM, G, (bx + G - 132 % G) % G);
                    const pg8::EpiScaleBf16 Ev{vt, NMEM, 1.f, 0, 0, 1.f, nullptr, true};
                    gemm_phase<pg8::EpiScaleBf16, StaticOrder, true, true>(lds, gv, Sv, Ev, tid);
                } } PH_END
            PH_BEGIN {
                const Gemm g{act, (const bfr*)(wl + (f ? OFF_D2 : OFF_D1)), M, D, FF, FF, FF, 0, 256L * FF}; StaticOrder S; S.init(M, D, G, bx);
                const pg8::EpiResid E{xb, D, stats};
                gemm_phase<pg8::EpiResid, StaticOrder, true, true>(lds, g, S, E, tid);
                if constexpr (l == DEPTH - 1 && f == 1) {
                    pg8::Unit u0; if (S.next(0, u0)) { panel_sync((unsigned*)(ws + WS_PCNT) + 4 * 4096 + 64 * u0.pm); const int rb = u0.pm * 256 + u0.pn * 64; final_phase(xb, out, a.in[20], rb + wave, 8, rb + 64, lane); } }
                } PH_END
            if (f == 0) {
                PH_BEGIN {
                    const Gemm g{xb, (const bfr*)(wl + OFF_MI), M, ZP, D, D, D, 0, 256L * D}; StaticOrder S; S.init(M, ZP, G, bx);
                    const pg8::EpiMixIn E{z, ZP, attn_body::C2, (float*)(ws + WS_KPART), (const LAS float*)(lds + RSTD_OFF)}; pg8::fill_rstd_table((LAS float*)(lds + RSTD_OFF), stats, S, tid);
                    gemm_phase<pg8::EpiMixIn, StaticOrder, true, true>(lds, g, S, E, tid);
                    fgate_phase(xb, (const float*)(ws + WS_WF) + (size_t)l * NH * D, a.in[8] + l * NH, cl, ctot, (LAS float*)lds, bx, G, tid, lane, wave);
                    } PH_END
                PH_BEGIN {
                    const attn_body::AttnTensors AT{(const attn_body::bf16*)(z + 3 * CW), (const attn_body::bf16*)(z + 4 * CW), (const attn_body::bf16*)(z + 5 * CW), (attn_body::bf16*)(z + 3 * CW), cl, ctot, (const float*)(ws + WS_KPART), ZP};
                    attn_body::attn_phase<32>((char*)lds_raw, AT, G, vcu, tid);
                    } PH_END
                PH_BEGIN {
                    const Gemm g{z + 4 * CW, (const bfr*)(wl + OFF_MO), M, D, D, ZP, D, 0, 256L * D}; StaticOrder S; S.init(M, D, G, bx);
                    { pg8::Unit u0; if (S.next(0, u0)) { const int pb = (u0.pm * 256 + u0.pn * 64) / 2;
                        mixnorm_phase(z, a.in[7] + (size_t)l * 3 * CW, a.in[9] + l * CW, a.in[10] + l * CW, pb + wave, pb + 32, 8, lane);
                        panel_sync((unsigned*)(ws + WS_PCNT) + (2 * l + 0) * 4096 + 64 * u0.pm); } }
                    const pg8::EpiResid E{xb, D, stats};
                    gemm_phase<pg8::EpiResid, StaticOrder, true, true>(lds, g, S, E, tid); } PH_END
                PH_BEGIN {
                    const Gemm g{xb, (const bfr*)(wl + OFF_XQ), M, D, D, D, D, 0, 256L * D}; StaticOrder S; S.init(M, D, G, bx);
                    const pg8::EpiScaleBf16 E{qx, D, 0.0625f * LOG2E, 0, 0, 1.f, stats, false};
                    gemm_phase<pg8::EpiScaleBf16, StaticOrder, true, true>(lds, g, S, E, tid);
                    asm volatile("s_waitcnt vmcnt(0)" ::: "memory"); __syncthreads(); if (tid == 0) { __builtin_amdgcn_fence(__ATOMIC_ACQUIRE, "agent"); asm volatile("s_waitcnt vmcnt(0)" ::: "memory"); } __syncthreads();
                    const Gemm gs{qx, kmem, M, D, 256, D, D, 256, 256};
                    const pg8::EpiSoftmax Es{Pb, D};
                    gemm_phase<pg8::EpiSoftmax, StaticOrder, false, true>(lds, gs, S, Es, tid);
                    asm volatile("s_waitcnt vmcnt(0)" ::: "memory"); __syncthreads(); if (tid == 0) { __builtin_amdgcn_fence(__ATOMIC_ACQUIRE, "agent"); asm volatile("s_waitcnt vmcnt(0)" ::: "memory"); } __syncthreads();
                    const Gemm go{Pb, vt, M, D, 256, D, 256, 256, 256L * 256};
                    const pg8::EpiScaleBf16 Eo{ox, D, 1.f, 0, 0, 1.f, nullptr, true};
                    gemm_phase<pg8::EpiScaleBf16, StaticOrder, true, true>(lds, go, S, Eo, tid);
                    { pg8::Unit u0; if (S.next(0, u0)) panel_sync((unsigned*)(ws + WS_PCNT) + (2 * l + 1) * 4096 + 64 * u0.pm); }
                    const Gemm gx{ox, (const bfr*)(wl + OFF_XO), M, D, D, D, D, 0, 256L * D};
                    const pg8::EpiResid Ex{xb, D, stats};
                    gemm_phase<pg8::EpiResid, StaticOrder, true, true>(lds, gx, S, Ex, tid); } PH_END
            }
    }
#undef PH_BEGIN
#undef PH_END
}

extern "C" void kernel_launch(void* const* d_in, const int* in_sizes, int n_in, void* d_out, int out_size, void* d_ws, size_t ws_size, hipStream_t stream) {
    static int grid = 0;
    if (grid == 0) {
        if (n_in != 21 || out_size != M * D || ws_size < WS_END) { fprintf(stderr, "kernel_launch: unexpected problem (n_in %d, out %d, ws %zu)\n", n_in, out_size, ws_size); grid = -1; return; }
        int dev = 0, cus = 0, per_cu = 0;
        hipGetDevice(&dev); hipDeviceGetAttribute(&cus, hipDeviceAttributeMultiprocessorCount, dev);
        if (hipFuncSetAttribute((const void*)mk_fwd, hipFuncAttributeMaxDynamicSharedMemorySize, LDS_BYTES) != hipSuccess) { fprintf(stderr, "kernel_launch: hipFuncSetAttribute(%d B LDS) failed\n", LDS_BYTES); }
        if (hipOccupancyMaxActiveBlocksPerMultiprocessor(&per_cu, (const void*)mk_fwd, 512, LDS_BYTES) != hipSuccess || per_cu < 1) { fprintf(stderr, "kernel_launch: occupancy query says %d\n", per_cu); per_cu = 1; }
        (void)hipGetLastError();
        grid = cus;
        if (grid != 256) fprintf(stderr, "kernel_launch: %d CUs; built for 256\n", grid);
    }
    if (grid < 0) return;
    Args a{};
    for (int i = 0; i < 21; ++i) a.in[i] = (const float*)d_in[i];
    a.out = (float*)d_out; a.ws = (unsigned char*)d_ws;
#if MK_ONE_LAUNCH
    a.ph_lo = 0; a.ph_hi = NPH;
    if (hipMemsetAsync((char*)d_ws + WS_BAR, 0, 96 * KiB, stream) != hipSuccess) { fprintf(stderr, "kernel_launch: memset of the barrier words failed\n"); return; }
    void* args[] = {&a};
    hipError_t e = hipLaunchCooperativeKernel((const void*)mk_fwd, dim3(grid), dim3(512), args, LDS_BYTES, stream);
    if (e != hipSuccess) fprintf(stderr, "kernel_launch: cooperative launch failed: %s (grid %d)\n", hipGetErrorString(e), grid);
#else
    for (int p = 0; p < NPH; ++p) { a.ph_lo = p; a.ph_hi = p + 1; hipLaunchKernelGGL(mk_fwd, dim3(grid), dim3(512), LDS_BYTES, stream, a); }
#endif
}
```

```cpp
#include <hip/hip_runtime.h>
#include <hip/hip_cooperative_groups.h>
#include <cstdio>
#include <cstdint>
#include <cmath>
typedef unsigned wt_u32x4 __attribute__((ext_vector_type(4)));
__device__ __forceinline__ void store16_wt(void* p, wt_u32x4 v) { asm volatile("global_store_dwordx4 %0, %1, off sc1\n\ts_nop 1" :: "v"(p), "v"(v) : "memory"); }
__device__ __forceinline__ float lane_get(float v, int src_lane) { return __builtin_bit_cast(float, __builtin_amdgcn_ds_bpermute(src_lane << 2, __builtin_bit_cast(int, v))); }
namespace pg8 {
#define PG8_LAS __attribute__((address_space(3)))
typedef unsigned short bf16_t;
typedef short bf16x8 __attribute__((ext_vector_type(8)));
typedef float f32x4 __attribute__((ext_vector_type(4)));
typedef unsigned u32x4 __attribute__((ext_vector_type(4)));
constexpr int BM = 256, BK = 64, HALF = 128, HTB = HALF * BK * 2  , STAGE_BYTES = 8 * HTB, NXCD = 8, WGM = 8;

__host__ __device__ __forceinline__ int lds_byte(int r, int c) { const int st = (r >> 4) * 2 + (c >> 5), rr = r & 15, cc = c & 31, ob = rr * 64 + cc * 2; return st * 1024 + (ob ^ (((ob >> 9) & 1) << 5)); }
__host__ __device__ __forceinline__ void stage_rc(int b, int& R, int& C) { const int st = b / 1024, sb = b % 1024, swz = sb ^ (((sb >> 9) & 1) << 5); R = (st >> 1) * 16 + swz / 64; C = (st & 1) * 32 + (swz % 64) / 2; }
__host__ __device__ __forceinline__ int perm32(int rho) { const int n = rho >> 4, i = rho & 15; return 8 * (i >> 2) + 4 * n + (i & 3); }

struct Unit { int pm, pn; };
struct Gemm { const bf16_t* A; const bf16_t* Bt; int M, N, K; int lda, ldb; long a_pn, b_pn; };

struct StaticOrder {
    int nM, nN, nwg, G, c;
    __host__ __device__ __forceinline__ void init(int M, int N, int G_, int c_) { nM = M / BM; nN = N / BM; nwg = nM * nN; G = G_; c = c_; }
    __host__ __device__ __forceinline__ bool next(int i, Unit& u) const {
        const long L = (long)i * G + c; if (L >= nwg) return false;
        int wgid = (int)L; { const int q = nwg / NXCD, r = nwg % NXCD, xcd = wgid % NXCD, off = wgid / NXCD; wgid = (xcd < r ? xcd * (q + 1) : r * (q + 1) + (xcd - r) * q) + off; }
        const int nig = WGM * nN, gid = wgid / nig, fm = gid * WGM, gsz = (nM - fm) < WGM ? (nM - fm) : WGM;
        u.pm = fm + ((wgid % nig) % gsz); u.pn = (wgid % nig) / gsz; return true;
    }
    __device__ __forceinline__ void a_ready(const Unit&) const {}
    __device__ __forceinline__ void done(const Unit&) const {}
};

__device__ __forceinline__ unsigned cvt_pk_bf16(float lo, float hi) { unsigned r; asm volatile("v_cvt_pk_bf16_f32 %0, %1, %2" : "=v"(r) : "v"(lo), "v"(hi)); return r; }
typedef float f32x2 __attribute__((ext_vector_type(2)));
__device__ __forceinline__ float row_rstd(const float* stats, int row) { const f32x4* sp = (const f32x4*)(stats + (size_t)row * 16); const f32x4 a = sp[0], b = sp[1], c = sp[2], d = sp[3];
    const float s = ((a[0] + a[1]) + (a[2] + a[3])) + ((b[0] + b[1]) + (b[2] + b[3])) + ((c[0] + c[1]) + (c[2] + c[3])) + ((d[0] + d[1]) + (d[2] + d[3])); return rsqrtf(s * (1.0f / 1024.0f) + 1e-6f); }
template <class Sched> __device__ __forceinline__ void fill_rstd_table(PG8_LAS float* rsL, const float* stats, const Sched& S, int tid) {
    Unit u; int n = 0; while (n < 8 && S.next(n, u)) ++n;
    for (int idx = tid; idx < n * 256; idx += 512) { S.next(idx >> 8, u); rsL[idx] = row_rstd(stats, u.pm * BM + (idx & 255)); }
    asm volatile("s_waitcnt lgkmcnt(0)" ::: "memory"); __builtin_amdgcn_s_barrier(); asm volatile("" ::: "memory");
}
struct EpiScaleBf16 {
    static constexpr bool PERM = true, AFTER_DRAIN = false, HAS_INIT = false;
    bf16_t* O; int ldc; float s_all; int pn_lo, pn_hi; float s_rng; const float* stats; bool wt;
    __device__ __forceinline__ void operator()(const f32x4 (&acc)[2][2][4][2], const Unit& u, int wr, int wc, int fr, int fq, int ui) const {
        const int row0 = u.pm * BM + wr * 64 + fr, col0 = u.pn * BM + wc * 32 + 8 * fq;
        const float sc = (u.pn >= pn_lo && u.pn < pn_hi) ? s_rng : s_all;
        float rs[2][4];
#pragma unroll
        for (int ai = 0; ai < 2; ++ai)
#pragma unroll
            for (int m = 0; m < 4; ++m) rs[ai][m] = stats ? row_rstd(stats, row0 + ai * HALF + m * 16) : 1.0f;
#pragma unroll
        for (int ai = 0; ai < 2; ++ai)
#pragma unroll
            for (int m = 0; m < 4; ++m) { bf16_t* rowp = O + (size_t)(row0 + ai * HALF + m * 16) * ldc + col0; const float scr = sc * rs[ai][m];
#pragma unroll
                for (int bj = 0; bj < 2; ++bj) { const f32x4 v0 = acc[ai][bj][m][0] * scr, v1 = acc[ai][bj][m][1] * scr;
                    u32x4 w; w.x = cvt_pk_bf16(v0[0], v0[1]); w.y = cvt_pk_bf16(v0[2], v0[3]); w.z = cvt_pk_bf16(v1[0], v1[1]); w.w = cvt_pk_bf16(v1[2], v1[3]);
                    if (wt) store16_wt(rowp + bj * HALF, w); else *(u32x4*)(rowp + bj * HALF) = w; } }
    }
};
struct EpiMixIn {
    static constexpr bool PERM = true, AFTER_DRAIN = false, HAS_INIT = false;
    bf16_t* O; int ldc; float qscale; float* kpart; const PG8_LAS float* rsL;
    __device__ __forceinline__ void operator()(const f32x4 (&acc)[2][2][4][2], const Unit& u, int wr, int wc, int fr, int fq, int ui) const {
        const int row0 = u.pm * BM + wr * 64 + fr, col0 = u.pn * BM + wc * 32 + 8 * fq;
        const float sc = (u.pn == 6 || u.pn == 7) ? qscale : 1.0f;
        float rs[2][4];
#pragma unroll
        for (int ai = 0; ai < 2; ++ai)
#pragma unroll
            for (int m = 0; m < 4; ++m) rs[ai][m] = rsL[ui * 256 + wr * 64 + fr + ai * HALF + m * 16];
#pragma unroll
        for (int ai = 0; ai < 2; ++ai)
#pragma unroll
            for (int m = 0; m < 4; ++m) { bf16_t* rowp = O + (size_t)(row0 + ai * HALF + m * 16) * ldc + col0; const float scr = sc * rs[ai][m];
#pragma unroll
                for (int bj = 0; bj < 2; ++bj) { const f32x4 v0 = acc[ai][bj][m][0] * scr, v1 = acc[ai][bj][m][1] * scr;
                    u32x4 w; w.x = cvt_pk_bf16(v0[0], v0[1]); w.y = cvt_pk_bf16(v0[2], v0[3]); w.z = cvt_pk_bf16(v1[0], v1[1]); w.w = cvt_pk_bf16(v1[2], v1[3]);
                    store16_wt(rowp + bj * HALF, w); } }
        if (u.pn == 8 || u.pn == 9) { const int lane = fq * 16 + fr;
#pragma unroll
            for (int bj = 0; bj < 2; ++bj) { float mx = 0.f;
#pragma unroll
                for (int ai = 0; ai < 2; ++ai)
#pragma unroll
                    for (int m = 0; m < 4; ++m) { const f32x4 a0 = acc[ai][bj][m][0], a1 = acc[ai][bj][m][1];
                        float p = ((a0[0] * a0[0] + a0[1] * a0[1]) + (a0[2] * a0[2] + a0[3] * a0[3])) + ((a1[0] * a1[0] + a1[1] * a1[1]) + (a1[2] * a1[2] + a1[3] * a1[3]));
                        p *= rs[ai][m] * rs[ai][m]; p += lane_get(p, lane ^ 16); p += lane_get(p, lane ^ 32); mx = fmaxf(mx, p); }
#pragma unroll
                for (int o = 1; o < 16; o <<= 1) mx = fmaxf(mx, lane_get(mx, lane ^ o));
                if (lane == 0) atomicMax((unsigned*)(kpart + ((u.pn - 8) * 4 + 2 * bj + (wc >> 1)) * 2 + (wc & 1)), __float_as_uint(mx)); } }
    }
};
__device__ __forceinline__ f32x4 silu_mul4(f32x4 g, f32x4 u) { const f32x4 t = g * (-1.4426950408889634f); f32x4 e;
    e[0] = __builtin_amdgcn_exp2f(t[0]); e[1] = __builtin_amdgcn_exp2f(t[1]); e[2] = __builtin_amdgcn_exp2f(t[2]); e[3] = __builtin_amdgcn_exp2f(t[3]);
    const f32x4 d = e + 1.0f; f32x4 r; r[0] = __builtin_amdgcn_rcpf(d[0]); r[1] = __builtin_amdgcn_rcpf(d[1]); r[2] = __builtin_amdgcn_rcpf(d[2]); r[3] = __builtin_amdgcn_rcpf(d[3]);
    return (g * r) * u; }
struct EpiSwiglu {
    static constexpr bool PERM = true, AFTER_DRAIN = false, HAS_INIT = false;
    bf16_t* O; int ldc; const PG8_LAS float* rsL;
    __device__ __forceinline__ void operator()(const f32x4 (&acc)[2][2][4][2], const Unit& u, int wr, int wc, int fr, int fq, int ui) const {
        const int row0 = u.pm * BM + wr * 64 + fr, col0 = u.pn * HALF + wc * 32 + 8 * fq; const PG8_LAS float* rsu = rsL + ui * 256 + wr * 64 + fr;
        float rs[2][4];
#pragma unroll
        for (int ai = 0; ai < 2; ++ai)
#pragma unroll
            for (int m = 0; m < 4; ++m) rs[ai][m] = rsu[ai * HALF + m * 16];
#pragma unroll
        for (int ai = 0; ai < 2; ++ai)
#pragma unroll
            for (int m = 0; m < 4; ++m) { bf16_t* rowp = O + (size_t)(row0 + ai * HALF + m * 16) * ldc + col0;
                const float rsv = rs[ai][m];
                const f32x4 g0 = acc[ai][0][m][0] * rsv, g1 = acc[ai][0][m][1] * rsv, u0 = acc[ai][1][m][0] * rsv, u1 = acc[ai][1][m][1] * rsv;
                const f32x4 o0 = silu_mul4(g0, u0), o1 = silu_mul4(g1, u1);
                u32x4 w; w.x = cvt_pk_bf16(o0[0], o0[1]); w.y = cvt_pk_bf16(o0[2], o0[3]); w.z = cvt_pk_bf16(o1[0], o1[1]); w.w = cvt_pk_bf16(o1[2], o1[3]);
                store16_wt(rowp, w); }
    }
};
struct EpiResid {
    static constexpr bool PERM = true, AFTER_DRAIN = false, HAS_INIT = true;
    bf16_t* XB; int ldc; float* stats;
    __device__ __forceinline__ void init(f32x4 (&acc)[2][2][4][2], const Unit& u, int wr, int wc, int fr, int fq) const {
        const bf16_t* const XB = this->XB; const int ldc = this->ldc; const int row0 = u.pm * BM + wr * 64 + fr, col0 = u.pn * BM + wc * 32 + 8 * fq;
        u32x4 raw[2][2][4];
#pragma unroll
        for (int ai = 0; ai < 2; ++ai)
#pragma unroll
            for (int m = 0; m < 4; ++m)
#pragma unroll
                for (int bj = 0; bj < 2; ++bj) raw[ai][bj][m] = *(const u32x4*)(XB + (size_t)(row0 + ai * HALF + m * 16) * ldc + col0 + bj * HALF);
#pragma unroll
        for (int ai = 0; ai < 2; ++ai)
#pragma unroll
            for (int m = 0; m < 4; ++m)
#pragma unroll
                for (int bj = 0; bj < 2; ++bj) { const u32x4 w = raw[ai][bj][m];
                    acc[ai][bj][m][0] = (f32x4){__builtin_bit_cast(float, w.x << 16), __builtin_bit_cast(float, w.x & 0xffff0000u), __builtin_bit_cast(float, w.y << 16), __builtin_bit_cast(float, w.y & 0xffff0000u)};
                    acc[ai][bj][m][1] = (f32x4){__builtin_bit_cast(float, w.z << 16), __builtin_bit_cast(float, w.z & 0xffff0000u), __builtin_bit_cast(float, w.w << 16), __builtin_bit_cast(float, w.w & 0xffff0000u)}; }
    }
    __device__ __forceinline__ void operator()(const f32x4 (&acc)[2][2][4][2], const Unit& u, int wr, int wc, int fr, int fq, int ui) const {
        bf16_t* const XB = this->XB; float* const stats = this->stats; const int ldc = this->ldc;
        const int row0 = u.pm * BM + wr * 64 + fr, col0 = u.pn * BM + wc * 32 + 8 * fq, lane = fq * 16 + fr;
#pragma unroll
        for (int ai = 0; ai < 2; ++ai)
#pragma unroll
            for (int m = 0; m < 4; ++m) { const int row = row0 + ai * HALF + m * 16; bf16_t* rowb = XB + (size_t)row * ldc + col0; float ss = 0.f;
#pragma unroll
                for (int bj = 0; bj < 2; ++bj) { const f32x4 x0 = acc[ai][bj][m][0], x1 = acc[ai][bj][m][1];
                    ss += ((x0[0] * x0[0] + x0[1] * x0[1]) + (x0[2] * x0[2] + x0[3] * x0[3])) + ((x1[0] * x1[0] + x1[1] * x1[1]) + (x1[2] * x1[2] + x1[3] * x1[3]));
                    u32x4 w; w.x = cvt_pk_bf16(x0[0], x0[1]); w.y = cvt_pk_bf16(x0[2], x0[3]); w.z = cvt_pk_bf16(x1[0], x1[1]); w.w = cvt_pk_bf16(x1[2], x1[3]); store16_wt(rowb + bj * HALF, w); }
                ss += lane_get(ss, lane ^ 16); ss += lane_get(ss, lane ^ 32);
                if (fq == 0) __hip_atomic_store((unsigned*)stats + (size_t)row * 16 + u.pn * 4 + wc, __float_as_uint(ss), __ATOMIC_RELAXED, __HIP_MEMORY_SCOPE_AGENT); }
    }
};
struct EpiSoftmax {
    static constexpr bool PERM = true, AFTER_DRAIN = true, HAS_INIT = false;
    bf16_t* O; int ldc;
    __device__ __forceinline__ void fused(f32x4 (&acc)[2][2][4][2], const Unit& u, int wr, int wc, int fr, int fq, PG8_LAS unsigned char* lds, int wid, int lane) const {
        PG8_LAS float* T1 = (PG8_LAS float*)lds;
        PG8_LAS float* T2 = (PG8_LAS float*)(lds + 4096);
#pragma unroll
        for (int ai = 0; ai < 2; ++ai)
#pragma unroll
            for (int m = 0; m < 4; ++m) { float mx = -INFINITY;
#pragma unroll
                for (int bj = 0; bj < 2; ++bj)
#pragma unroll
                    for (int n = 0; n < 2; ++n) { const f32x4 x = acc[ai][bj][m][n]; mx = fmaxf(mx, fmaxf(fmaxf(x[0], x[1]), fmaxf(x[2], x[3]))); }
                mx = fmaxf(mx, lane_get(mx, lane ^ 16)); mx = fmaxf(mx, lane_get(mx, lane ^ 32));
                if (fq == 0) T1[(ai * HALF + wr * 64 + m * 16 + fr) * 4 + wc] = mx; }
        asm volatile("s_waitcnt lgkmcnt(0)" ::: "memory"); __builtin_amdgcn_s_barrier(); asm volatile("" ::: "memory");
#pragma unroll
        for (int ai = 0; ai < 2; ++ai)
#pragma unroll
            for (int m = 0; m < 4; ++m) { const int r = ai * HALF + wr * 64 + m * 16 + fr; const f32x4 t = *(const PG8_LAS f32x4*)(T1 + r * 4);
                const float mx = fmaxf(fmaxf(t[0], t[1]), fmaxf(t[2], t[3])); float s = 0.f;
#pragma unroll
                for (int bj = 0; bj < 2; ++bj)
#pragma unroll
                    for (int n = 0; n < 2; ++n) { f32x4 x = acc[ai][bj][m][n];
                        x[0] = __builtin_amdgcn_exp2f(x[0] - mx); x[1] = __builtin_amdgcn_exp2f(x[1] - mx); x[2] = __builtin_amdgcn_exp2f(x[2] - mx); x[3] = __builtin_amdgcn_exp2f(x[3] - mx);
                        s += (x[0] + x[1]) + (x[2] + x[3]); acc[ai][bj][m][n] = x; }
                s += lane_get(s, lane ^ 16); s += lane_get(s, lane ^ 32);
                if (fq == 0) T2[r * 4 + wc] = s; }
        asm volatile("s_waitcnt lgkmcnt(0)" ::: "memory"); __builtin_amdgcn_s_barrier(); asm volatile("" ::: "memory");
        const int row0 = u.pm * BM + wr * 64 + fr, col0 = u.pn * BM + wc * 32 + 8 * fq;
#pragma unroll
        for (int ai = 0; ai < 2; ++ai)
#pragma unroll
            for (int m = 0; m < 4; ++m) { const int r = ai * HALF + wr * 64 + m * 16 + fr; const f32x4 t = *(const PG8_LAS f32x4*)(T2 + r * 4);
                const float inv = 1.0f / ((t[0] + t[1]) + (t[2] + t[3])); bf16_t* rowp = O + (size_t)(row0 + ai * HALF + m * 16) * ldc + col0;
#pragma unroll
                for (int bj = 0; bj < 2; ++bj) { const f32x4 v0 = acc[ai][bj][m][0] * inv, v1 = acc[ai][bj][m][1] * inv;
                    u32x4 w; w.x = cvt_pk_bf16(v0[0], v0[1]); w.y = cvt_pk_bf16(v0[2], v0[3]); w.z = cvt_pk_bf16(v1[0], v1[1]); w.w = cvt_pk_bf16(v1[2], v1[3]);
                    *(u32x4*)(rowp + bj * HALF) = w; } }
    }
};

template <class Epi, class Sched, bool ALIGN_EPI = false, bool SP2 = false>
__device__ __forceinline__ void gemm_phase(PG8_LAS unsigned char* lds, const Gemm g, const Sched S, const Epi E, const int tid) {
    const int wid = __builtin_amdgcn_readfirstlane(tid >> 6), lane = tid & 63, wr = wid >> 2, wc = wid & 3, fr = lane & 15, fq = lane >> 4;
    const int K = g.K, nt = K / BK;
    unsigned voffA[2], voffB[2];
#pragma unroll
    for (int i = 0; i < 2; ++i) { int R, C; stage_rc(tid * 16 + i * 8192, R, C); const int Rb = Epi::PERM ? ((R & ~31) + perm32(R & 31)) : R;
        voffA[i] = (unsigned)(R * g.lda + C) * 2u; voffB[i] = (unsigned)(Rb * g.ldb + C) * 2u; }
    const size_t kstep = (size_t)(BK * 2);
    const size_t hstepA = (size_t)HALF * g.lda * 2, hstepB = (size_t)HALF * g.ldb * 2;
    const size_t tstepA = 2 * hstepA, apn = (size_t)g.a_pn * 2, bpn = (size_t)g.b_pn * 2;
    const unsigned ldsw = (unsigned)wid * 1024u;
    const int aoff = lds_byte(wr * 64 + fr, fq * 8), boff = lds_byte(wc * 32 + fr, fq * 8);
#define PG8_SA(b, h) (((b) * 2 + (h)) * HTB)
#define PG8_SB(b, h) ((4 + (b) * 2 + (h)) * HTB)
#define PG8_STAGE(bufoff, gbase, voff) do { _Pragma("unroll") for (int _i = 0; _i < 2; ++_i) \
        __builtin_amdgcn_global_load_lds((const unsigned*)((const char*)(gbase) + (voff)[_i]), (PG8_LAS unsigned*)(lds + (bufoff) + ldsw + _i * 8192), 16, 0, 0); } while (0)
#define PG8_LDA(dst, b, h) do { _Pragma("unroll") for (int m = 0; m < 4; ++m) _Pragma("unroll") for (int k = 0; k < 2; ++k) dst[m][k] = *(const PG8_LAS bf16x8*)(lds + PG8_SA(b, h) + aoff + m * 2048 + k * 1024); } while (0)
#define PG8_LDB(dst, b, h) do { _Pragma("unroll") for (int n = 0; n < 2; ++n) _Pragma("unroll") for (int k = 0; k < 2; ++k) dst[n][k] = *(const PG8_LAS bf16x8*)(lds + PG8_SB(b, h) + boff + n * 2048 + k * 1024); } while (0)
#define PG8_MMA(ai, bj, At, Bt) do { __builtin_amdgcn_s_setprio(1); _Pragma("unroll") for (int m = 0; m < 4; ++m) _Pragma("unroll") for (int n = 0; n < 2; ++n) _Pragma("unroll") for (int k = 0; k < 2; ++k) \
        acc[ai][bj][m][n] = __builtin_amdgcn_mfma_f32_16x16x32_bf16(Bt[n][k], At[m][k], acc[ai][bj][m][n], 0, 0, 0); __builtin_amdgcn_s_setprio(0); } while (0)
#define PG8_WAIT_V(n) asm volatile("s_waitcnt vmcnt(" #n ")" ::: "memory")
#define PG8_WAIT_L(n) asm volatile("s_waitcnt lgkmcnt(" #n ")" ::: "memory")
#define PG8_BAR __builtin_amdgcn_s_barrier()
#define PG8_SCHED __builtin_amdgcn_sched_barrier(0)
    Unit cur, nxt; int ui = 0;
    if (!S.next(0, cur)) return;
    f32x4 acc[2][2][4][2];
    if constexpr (Epi::HAS_INIT) E.init(acc, cur, wr, wc, fr, fq);
    else {
#pragma unroll
    for (int a = 0; a < 2; ++a)
#pragma unroll
        for (int b = 0; b < 2; ++b)
#pragma unroll
            for (int m = 0; m < 4; ++m)
#pragma unroll
                for (int n = 0; n < 2; ++n) acc[a][b][m][n] = (f32x4){0.f, 0.f, 0.f, 0.f};
    }
    bf16x8 At[4][2], B0[2][2], B1[2][2];
    const char* cA = (const char*)g.A + (size_t)cur.pm * tstepA + (size_t)cur.pn * apn; const char* cB = (const char*)g.Bt + (size_t)cur.pn * bpn;
    S.a_ready(cur);
    if constexpr (SP2) {
        PG8_STAGE(PG8_SB(0, 0), cB, voffB); PG8_STAGE(PG8_SB(0, 1), cB + hstepB, voffB); PG8_STAGE(PG8_SA(0, 0), cA, voffA); PG8_STAGE(PG8_SA(0, 1), cA + hstepA, voffA);
        if (wr == 1) PG8_BAR;
        PG8_WAIT_V(2); PG8_BAR;
        PG8_STAGE(PG8_SB(1, 0), cB + kstep, voffB); PG8_STAGE(PG8_SA(1, 0), cA + kstep, voffA); PG8_STAGE(PG8_SB(1, 1), cB + hstepB + kstep, voffB);
        PG8_WAIT_V(6); PG8_BAR;
    } else {
        PG8_STAGE(PG8_SB(0, 0), cB, voffB); PG8_STAGE(PG8_SA(0, 0), cA, voffA); PG8_STAGE(PG8_SB(0, 1), cB + hstepB, voffB); PG8_STAGE(PG8_SA(0, 1), cA + hstepA, voffA);
        if (wr == 1) PG8_BAR;
        PG8_WAIT_V(4); PG8_BAR;
        PG8_STAGE(PG8_SB(1, 0), cB + kstep, voffB); PG8_STAGE(PG8_SA(1, 0), cA + kstep, voffA); PG8_STAGE(PG8_SB(1, 1), cB + hstepB + kstep, voffB);
        PG8_WAIT_V(6); PG8_BAR;
    }
    for (;;) {
        const bool has_next = S.next(ui + 1, nxt);
        const char* nA = has_next ? (const char*)g.A + (size_t)nxt.pm * tstepA + (size_t)nxt.pn * apn : cA; const char* nB = has_next ? (const char*)g.Bt + (size_t)nxt.pn * bpn : cB;
        for (int t = 0; t < nt; t += 2) {
            const bool last = (t == nt - 2);
            const char* a1 = cA + (size_t)(t + 1) * kstep;
            const char* a2 = last ? nA : cA + (size_t)(t + 2) * kstep; const char* b2 = last ? nB : cB + (size_t)(t + 2) * kstep;
            const char* a3 = a2 + kstep; const char* b3 = b2 + kstep;
            if (last && has_next) S.a_ready(nxt);
            if constexpr (SP2) {
            PG8_LDB(B0, 0, 0); PG8_LDB(B1, 0, 1); PG8_SCHED; PG8_LDA(At, 0, 0); PG8_STAGE(PG8_SA(1, 1), a1 + hstepA, voffA);
            PG8_WAIT_V(8); PG8_WAIT_L(0); PG8_BAR; PG8_MMA(0, 0, At, B0); PG8_MMA(0, 1, At, B1); PG8_BAR; PG8_SCHED;
            PG8_LDA(At, 0, 1); PG8_STAGE(PG8_SB(0, 0), b2, voffB); PG8_STAGE(PG8_SB(0, 1), b2 + hstepB, voffB); PG8_STAGE(PG8_SA(0, 0), a2, voffA);
            PG8_WAIT_V(8); PG8_WAIT_L(0); PG8_BAR; PG8_MMA(1, 0, At, B0); PG8_MMA(1, 1, At, B1); PG8_BAR; PG8_SCHED;
            PG8_LDB(B0, 1, 0); PG8_LDB(B1, 1, 1); PG8_SCHED; PG8_LDA(At, 1, 0); PG8_STAGE(PG8_SA(0, 1), a2 + hstepA, voffA);
            PG8_WAIT_V(8); PG8_WAIT_L(0); PG8_BAR; PG8_MMA(0, 0, At, B0); PG8_MMA(0, 1, At, B1); PG8_BAR; PG8_SCHED;
            PG8_LDA(At, 1, 1); PG8_STAGE(PG8_SB(1, 0), b3, voffB); PG8_STAGE(PG8_SB(1, 1), b3 + hstepB, voffB); PG8_STAGE(PG8_SA(1, 0), a3, voffA);
            PG8_WAIT_V(8); PG8_WAIT_L(0); PG8_BAR; PG8_MMA(1, 0, At, B0); PG8_MMA(1, 1, At, B1); PG8_BAR; PG8_SCHED;
            } else {
            PG8_LDB(B0, 0, 0); PG8_SCHED; PG8_LDA(At, 0, 0); PG8_STAGE(PG8_SA(1, 1), a1 + hstepA, voffA);
            PG8_WAIT_L(8); PG8_BAR; PG8_WAIT_L(0); PG8_MMA(0, 0, At, B0); PG8_BAR; PG8_SCHED;
            PG8_LDB(B1, 0, 1); PG8_STAGE(PG8_SB(0, 0), b2, voffB);
            PG8_BAR; PG8_WAIT_L(0); PG8_MMA(0, 1, At, B1); PG8_BAR;
            PG8_LDA(At, 0, 1); PG8_STAGE(PG8_SA(0, 0), a2, voffA);
            PG8_BAR; PG8_WAIT_L(0); PG8_MMA(1, 0, At, B0); PG8_BAR; PG8_SCHED;
            PG8_STAGE(PG8_SB(0, 1), b2 + hstepB, voffB);
            PG8_WAIT_V(6); PG8_BAR; PG8_MMA(1, 1, At, B1); PG8_BAR;
            PG8_LDB(B0, 1, 0); PG8_SCHED; PG8_LDA(At, 1, 0); PG8_STAGE(PG8_SA(0, 1), a2 + hstepA, voffA);
            PG8_WAIT_L(8); PG8_BAR; PG8_WAIT_L(0); PG8_MMA(0, 0, At, B0); PG8_BAR; PG8_SCHED;
            PG8_LDB(B1, 1, 1); PG8_STAGE(PG8_SB(1, 0), b3, voffB);
            PG8_BAR; PG8_WAIT_L(0); PG8_MMA(0, 1, At, B1); PG8_BAR;
            PG8_LDA(At, 1, 1); PG8_STAGE(PG8_SA(1, 0), a3, voffA);
            PG8_BAR; PG8_WAIT_L(0); PG8_MMA(1, 0, At, B0); PG8_BAR; PG8_SCHED;
            PG8_STAGE(PG8_SB(1, 1), b3 + hstepB, voffB);
            PG8_WAIT_V(6); PG8_BAR; PG8_MMA(1, 1, At, B1); PG8_BAR;
            }
        }
        if constexpr (ALIGN_EPI) { if (wr == 0) PG8_BAR; }
        if constexpr (!Epi::AFTER_DRAIN) { E(acc, cur, wr, wc, fr, fq, ui); S.done(cur); }
        if (!has_next) break;
        if constexpr (Epi::HAS_INIT) E.init(acc, nxt, wr, wc, fr, fq);
        else {
#pragma unroll
        for (int a = 0; a < 2; ++a)
#pragma unroll
            for (int b = 0; b < 2; ++b)
#pragma unroll
                for (int m = 0; m < 4; ++m)
#pragma unroll
                    for (int n = 0; n < 2; ++n) acc[a][b][m][n] = (f32x4){0.f, 0.f, 0.f, 0.f};
        }
        cur = nxt; cA = nA; cB = nB; ++ui;
        if constexpr (ALIGN_EPI) { if (wr == 1) PG8_BAR; }
    }
    PG8_WAIT_V(0);
    if constexpr (!ALIGN_EPI) { if (wr == 0) PG8_BAR; }
    PG8_BAR;
    if constexpr (Epi::AFTER_DRAIN) { E.fused(acc, cur, wr, wc, fr, fq, lds, wid, lane); S.done(cur); }
#undef PG8_SA
#undef PG8_SB
#undef PG8_STAGE
#undef PG8_LDA
#undef PG8_LDB
#undef PG8_MMA
#undef PG8_WAIT_V
#undef PG8_WAIT_L
#undef PG8_BAR
#undef PG8_SCHED
}
}

#include <hip/hip_bf16.h>
#include <cmath>
namespace attn_body {
using bf16=__hip_bfloat16;
using bf16x8=__attribute__((ext_vector_type(8)))short;
using s16x4=__attribute__((ext_vector_type(4)))short;
using f32x16=__attribute__((ext_vector_type(16)))float;
using u32x4=__attribute__((ext_vector_type(4)))unsigned;
using f32x4v=__attribute__((ext_vector_type(4)))float;
constexpr int BATCH=1,NHEAD=8,SEQ=16384,D=64,DM=3072;
constexpr int NW=8,QBLK=32,QB=QBLK*NW,KVBLK=64,NQB=SEQ/QB;
constexpr int ATTN_PITCH=DM, ATTN_UNIT_ROWS=QB;
__device__ __forceinline__ int crow(int r,int hi){return (r&3)+8*(r>>2)+4*hi;}
#define SBAR() __builtin_amdgcn_sched_barrier(0)
__device__ __forceinline__ void cmask(f32x16&p0,f32x16&p1,int jb,int qrel,int hi){
  const float NEG=-INFINITY; int kb=64*jb+4*hi;
  #pragma unroll
  for(int r=0;r<16;++r){int kv=kb+(r&3)+8*(r>>2); if(kv>qrel)p0[r]=NEG; if(kv+32>qrel)p1[r]=NEG;}
}

constexpr int NSLOT=3, SLOTB=8192;
constexpr int LDS_K=0, LDS_V=NSLOT*SLOTB, LDS_WS=2*NSLOT*SLOTB, LDS_OST=LDS_WS+NW*64*4, LDS_BIAS=LDS_OST+NW*4096, LDS_PRE=LDS_BIAS+SEQ*4, LDS_BYTES=LDS_PRE+1024;
constexpr float C2=0.125f*1.4426950408889634f;
__device__ __forceinline__ void glds16(const void*gsrc,unsigned lds_dst){unsigned keep;
  asm volatile("s_mov_b32 %0, m0\n\ts_mov_b32 m0, %2\n\ts_nop 0\n\tglobal_load_lds_dwordx4 %1, off\n\ts_mov_b32 m0, %0":"=&s"(keep):"v"(gsrc),"s"(lds_dst):"memory");}
__device__ __forceinline__ float max3f(float a,float b,float c){float r;asm("v_max3_f32 %0, %1, %2, %3":"=v"(r):"v"(a),"v"(b),"v"(c));return r;}
__device__ __forceinline__ float max2f(float a,float b){float r;asm("v_max_f32_e32 %0, %1, %2":"=v"(r):"v"(a),"v"(b));return r;}
__device__ __forceinline__ float fadd_s(float a,float b){float r;asm("v_add_f32_e32 %0, %1, %2":"=v"(r):"v"(a),"v"(b));return r;}
__device__ __forceinline__ float fsub_s(float a,float b){float r;asm("v_sub_f32_e32 %0, %1, %2":"=v"(r):"v"(a),"v"(b));return r;}
typedef float f32x2_t __attribute__((ext_vector_type(2))); typedef __bf16 bf16x2_t __attribute__((ext_vector_type(2)));
__device__ __forceinline__ unsigned cvtpk_s(float lo,float hi){f32x2_t v={lo,hi};bf16x2_t b=__builtin_convertvector(v,bf16x2_t);return __builtin_bit_cast(unsigned,b);}
#define WAIT_BAR(N) asm volatile("s_waitcnt vmcnt(" #N ") lgkmcnt(0)\n\ts_barrier":::"memory")

__device__ __forceinline__ void qkt(f32x16&p0,f32x16&p1,const char*Kslot,const bf16x8*qr,int r32,int hi){
  const char*kb=Kslot+hi*1024+r32*16;
  #pragma unroll
  for(int d0=0;d0<4;++d0){
    const bf16x8 b0=*reinterpret_cast<const bf16x8*>(kb+d0*2048);
    const bf16x8 b1=*reinterpret_cast<const bf16x8*>(kb+d0*2048+512);
    {p0=__builtin_amdgcn_mfma_f32_32x32x16_bf16(b0,qr[d0],p0,0,0,0);p1=__builtin_amdgcn_mfma_f32_32x32x16_bf16(b1,qr[d0],p1,0,0,0);}}
}
typedef __attribute__((address_space(3))) const char* lds_cptr;
typedef short v4i16_t __attribute__((ext_vector_type(4)));
__device__ __forceinline__ void kload8(bf16x8*kf,lds_cptr kp){
  kf[0]=*(const __attribute__((address_space(3))) bf16x8*)(kp);      kf[1]=*(const __attribute__((address_space(3))) bf16x8*)(kp+512);
  kf[2]=*(const __attribute__((address_space(3))) bf16x8*)(kp+2048); kf[3]=*(const __attribute__((address_space(3))) bf16x8*)(kp+2560);
  kf[4]=*(const __attribute__((address_space(3))) bf16x8*)(kp+4096); kf[5]=*(const __attribute__((address_space(3))) bf16x8*)(kp+4608);
  kf[6]=*(const __attribute__((address_space(3))) bf16x8*)(kp+6144); kf[7]=*(const __attribute__((address_space(3))) bf16x8*)(kp+6656);
}
__device__ __forceinline__ void kload2(bf16x8*kf,lds_cptr kp,int j){ kf[2*j]=*(const __attribute__((address_space(3))) bf16x8*)(kp+j*2048); kf[2*j+1]=*(const __attribute__((address_space(3))) bf16x8*)(kp+j*2048+512); }
__device__ __forceinline__ s16x4 vtr(lds_cptr p){ return __builtin_bit_cast(s16x4,__builtin_amdgcn_ds_read_tr16_b64_v4i16((__attribute__((address_space(3))) v4i16_t*)p)); }
__device__ __forceinline__ float rowmax(const f32x16&p0,const f32x16&p1){
  float a=max3f(p0[0],p0[1],p1[0]),b=max3f(p0[2],p0[3],p1[1]);a=max3f(a,p1[2],p1[3]);
  #pragma unroll
  for(int r=4;r<16;r+=4){a=max3f(a,p0[r],p0[r+1]);b=max3f(b,p0[r+2],p0[r+3]);a=max3f(a,p1[r],p1[r+1]);b=max3f(b,p1[r+2],p1[r+3]);}
  const float m=max2f(a,b);
  auto rr=__builtin_amdgcn_permlane32_swap(__float_as_uint(m),__float_as_uint(m),false,false);
  return max2f(__uint_as_float(rr[0]),__uint_as_float(rr[1]));
}
__device__ __forceinline__ void pv(f32x16*o,int vb,bf16x8 pa0,bf16x8 pa1,bf16x8 pa2,bf16x8 pa3){
  #pragma unroll
  for(int d0=0;d0<2;++d0){s16x4 lo[4],hi[4];
    #pragma unroll
    for(int ks=0;ks<4;++ks){
      asm volatile("ds_read_b64_tr_b16 %0,%1 offset:%c2":"=&v"(lo[ks]):"v"(vb),"i"(d0*4096+ks*1024):"memory");
      asm volatile("ds_read_b64_tr_b16 %0,%1 offset:%c2":"=&v"(hi[ks]):"v"(vb),"i"(d0*4096+ks*1024+512):"memory");}
    asm volatile("s_waitcnt lgkmcnt(0)":::"memory");SBAR();
    #define PK(k) (bf16x8){lo[k][0],lo[k][1],lo[k][2],lo[k][3],hi[k][0],hi[k][1],hi[k][2],hi[k][3]}
    o[d0]=__builtin_amdgcn_mfma_f32_32x32x16_bf16(pa0,PK(0),o[d0],0,0,0);
    o[d0]=__builtin_amdgcn_mfma_f32_32x32x16_bf16(pa1,PK(1),o[d0],0,0,0);
    o[d0]=__builtin_amdgcn_mfma_f32_32x32x16_bf16(pa2,PK(2),o[d0],0,0,0);
    o[d0]=__builtin_amdgcn_mfma_f32_32x32x16_bf16(pa3,PK(3),o[d0],0,0,0);
    #undef PK
  }
}

#ifndef ATTN_STORE16
#define ATTN_STORE16(p,v) store16_wt((p),(v))
#endif
template<int THRL> __device__ __forceinline__ void attn_unit(int b,int h,int qb,const bf16*Q,const bf16*__restrict__ K,const bf16*__restrict__ V,bf16*O,const float*__restrict__ cl,const float*__restrict__ ctot,const float*__restrict__ kpart,char*shm,const int tid,const int odm){
  const int lane=tid&63,r32=lane&31,hi=lane>>5; const int wid=__builtin_amdgcn_readfirstlane(tid>>6);
  const long rowbase=(long)b*SEQ; const int q0=qb*QB; const int NTF=(q0+QB)/KVBLK;
  const bf16*Qw=Q+(rowbase+q0+wid*QBLK)*DM+h*D;
  const unsigned lds0=(unsigned)(uintptr_t)shm;
  float*wsf=(float*)(shm+LDS_WS)+wid*64;
  const char*Kbase=shm+LDS_K; bf16x8 kf[8];
  const lds_cptr shm3=(lds_cptr)shm; const lds_cptr kp0=shm3+LDS_K+hi*1024+r32*16; const lds_cptr vp0=shm3+LDS_V+((lane>>4)&1)*32+(lane&3)*8+(4*hi+((lane&15)>>2))*64;
  bf16x8 qr[4];
  #pragma unroll
  for(int d0=0;d0<4;++d0)qr[d0]=*reinterpret_cast<const bf16x8*>(&Qw[(long)r32*DM+d0*16+hi*8]);
  typedef __attribute__((address_space(3))) float lds_f; typedef __attribute__((address_space(3))) f32x4v lds_f4;
  lds_f* preL=(lds_f*)(shm3+LDS_PRE); lds_f4* bias4=(lds_f4*)(shm3+LDS_BIAS); lds_f* wsq=(lds_f*)(shm3+LDS_WS);
  int ln_=lane; asm volatile("":"+v"(ln_));
  if(wid==0){ const f32x4v tq=*(const f32x4v*)(ctot+4*lane); const float s0=tq[0],s1=s0+tq[1],s2=s1+tq[2],s3=s2+tq[3]; float inc=s3;
    _Pragma("unroll") for(int of=1;of<64;of<<=1){ const float vv=lane_get(inc,ln_-of); if(ln_>=of)inc+=vv; }
    const float exc=inc-s3; preL[4*lane]=exc; preL[4*lane+1]=exc+s0; preL[4*lane+2]=exc+s1; preL[4*lane+3]=exc+s2; }
  { float qs=0.f;
    _Pragma("unroll") for(int d0=0;d0<4;++d0) _Pragma("unroll") for(int e=0;e<8;++e){ const float qf=__builtin_bit_cast(float,((unsigned)(unsigned short)qr[d0][e])<<16); qs+=qf*qf; }
    { auto rr=__builtin_amdgcn_permlane32_swap(__float_as_uint(qs),__float_as_uint(qs),false,false); qs=__uint_as_float(rr[0])+__uint_as_float(rr[1]); }
    _Pragma("unroll") for(int of=1;of<32;of<<=1) qs=fmaxf(qs,lane_get(qs,ln_^of));
    if(lane==0) wsq[wid*64]=qs; }
  asm volatile("s_waitcnt lgkmcnt(0)\n\ts_barrier":::"memory");
  int t0=0;
  { float qm=0.f; _Pragma("unroll") for(int w=0;w<NW;++w) qm=fmaxf(qm,wsq[w*64]);
    const float km=kpart[2*h]+kpart[2*h+1];
    const float QK=sqrtf(qm*km)*1.02f+0.01f;
    const float thr=-preL[4*qb]*1.4426950408889634f-2.f*QK-40.f;
    for(int base=0;base<NTF-4;base+=64){ const int tau=base+lane; const bool sk=(tau<NTF-4)&&(-preL[tau+1]*1.4426950408889634f<thr); t0+=__builtin_popcountll(__builtin_amdgcn_ballot_w64(sk)); }
    t0=__builtin_amdgcn_readfirstlane(t0)&~1; }
  const int NT=NTF-t0;
  const bf16*Kh=K+(rowbase+(long)t0*KVBLK)*DM+h*D,*Vh=V+(rowbase+(long)t0*KVBLK)*DM+h*D;
  const bf16*ksrc=Kh+(long)lane*DM+wid*8;
  const bf16*vsrc=Vh+(long)(16*(wid&3)+(lane>>2))*DM+(wid>>2)*32+(lane&3)*8;
  const unsigned kdst=lds0+LDS_K+wid*1024, vdst=lds0+LDS_V+wid*1024;
  #define DMA_K(t,slot) glds16(ksrc+(long)(t)*KVBLK*DM,(unsigned)__builtin_amdgcn_readfirstlane(kdst+(slot)))
  #define DMA_V(t,slot) glds16(vsrc+(long)(t)*KVBLK*DM,(unsigned)__builtin_amdgcn_readfirstlane(vdst+(slot)))
  DMA_K(0,0);DMA_V(0,0);DMA_K(1,SLOTB);
  float mhat=0.f,l_reg=0.f;f32x16 o[2];o[0]=f32x16{};o[1]=f32x16{};
  for(int i=tid;i<NT*16;i+=NW*64){ const f32x4v c=*(const f32x4v*)(cl+4*(t0*16+i)); const float pp=preL[t0+(i>>4)]; bias4[i]=(c+pp)*(-1.4426950408889634f); }

  const int qrel=wid*QBLK+r32;
  #define CMASK(P0,P1,t) do{int jb_=(t)-(NT-4); if(jb_>=0)cmask(P0,P1,jb_,qrel,hi);}while(0)
  #define LOADB1(C0,t,o8) do{ const lds_f4* bp_=bias4+(t)*16+hi+(o8); _Pragma("unroll") for(int j_=0;j_<4;++j_){ const f32x4v b0_=bp_[2*j_]; \
      _Pragma("unroll") for(int i_=0;i_<4;++i_){ C0[4*j_+i_]=b0_[i_]-mhat; } } }while(0)
  #define LOADB(C0,C1,t) do{ LOADB1(C0,t,0); LOADB1(C1,t,8); }while(0)
  bool resc=false;
  #define START(P0,P1) do{ const float rm=rowmax(P0,P1); resc=false; \
    { const float dl=rm; mhat=fadd_s(mhat,dl); \
      _Pragma("unroll") for(int r=0;r<16;++r){P0[r]=fsub_s(P0[r],dl);P1[r]=fsub_s(P1[r],dl);} } \
    _Pragma("unroll") for(int r=0;r<16;++r)P0[r]=__builtin_amdgcn_exp2f(P0[r]); }while(0)
  #define RESC() do{ if(resc){ asm volatile("s_waitcnt lgkmcnt(0)":::"memory"); \
      _Pragma("unroll") for(int d_=0;d_<2;++d_) _Pragma("unroll") for(int r=0;r<16;++r)o[d_][r]*=wsf[crow(r,hi)]; } }while(0)
  f32x16 pA0,pA1,pB0,pB1;
  int sl_prev=0,sl_cur=0,sl_next=SLOTB;
  #define ROT() do{sl_prev=sl_cur;sl_cur=sl_next;sl_next=(sl_next==(NSLOT-1)*SLOTB)?0:sl_next+SLOTB;}while(0)
  DMA_K(2,2*SLOTB);
  WAIT_BAR(3);
  LOADB(pA0,pA1,0);
  qkt(pA0,pA1,Kbase,qr,r32,hi);asm volatile("s_nop 15\n\ts_nop 7":"+v"(pA0),"+v"(pA1));CMASK(pA0,pA1,0);
  START(pA0,pA1);
  _Pragma("unroll") for(int r=0;r<16;++r)pA1[r]=__builtin_amdgcn_exp2f(pA1[r]);
  WAIT_BAR(0);
  DMA_K(3,0);DMA_V(1,SLOTB);
  ROT();
  kload8(kf,kp0+sl_cur);
  WAIT_BAR(2);
  s16x4 vlo[8],vhi[8]; u32x4 pw0,pw1,pw2,pw3;
  #define PKW(P,B) cvtpk_s(P[B],P[B+1])
  #define PAF(k) __builtin_bit_cast(bf16x8,pw##k)
  #define VFR(i) (bf16x8){vlo[i][0],vlo[i][1],vlo[i][2],vlo[i][3],vhi[i][0],vhi[i][1],vhi[i][2],vhi[i][3]}
  #define PIN(x) asm volatile("":"+v"(x))
  #define MX3(a,b,c) __builtin_fmaxf(__builtin_fmaxf((a),(b)),(c))
  #define GAPA(MF,A0,A1,A2,A3,W0,W1,PW) do{ MF; sacc+=A0; sacc+=A1; sacc+=A2; sacc+=A3; PIN(sacc); W0; W1; PIN(PW); SBAR(); }while(0)
  #define EX(v) __builtin_amdgcn_exp2f(v)
  #define GAPB(MF,X,B) do{ MF; X[B]=EX(X[B]); X[B+1]=EX(X[B+1]); X[B+2]=EX(X[B+2]); X[B+3]=EX(X[B+3]); PIN(X); SBAR(); }while(0)
  #define VRD(i) do{ vlo[i]=vtr(vp_+(((i)>>2)*4096+((i)&3)*1024)); vhi[i]=vtr(vp_+(((i)>>2)*4096+((i)&3)*1024+512)); }while(0)
  #define KRD(G,j) do{ if(G){ kload2(kf,kp0+sl_next,j); SBAR(); } }while(0)
  #define STEP(C0,C1,P0,P1,t,GK,GV,GL) do{ SBAR(); \
    LOADB1(C0,t,0); SBAR(); \
    const lds_cptr vp_=vp0+sl_prev; \
    VRD(0); SBAR(); float sacc=(P0[0]+P0[1]); \
    GAPA(C0=__builtin_amdgcn_mfma_f32_32x32x16_bf16(kf[0],qr[0],C0,0,0,0), P0[2],P0[3],P0[4],P0[5],     pw0[0]=PKW(P0,0), pw0[1]=PKW(P0,2), pw0); \
    LOADB1(C1,t,8); SBAR(); VRD(4); SBAR(); GAPA(C1=__builtin_amdgcn_mfma_f32_32x32x16_bf16(kf[1],qr[0],C1,0,0,0), P0[6],P0[7],P0[8],P0[9],     pw0[2]=PKW(P0,4), pw0[3]=PKW(P0,6), pw0); \
    VRD(1); SBAR(); GAPA(C0=__builtin_amdgcn_mfma_f32_32x32x16_bf16(kf[2],qr[1],C0,0,0,0),   P0[10],P0[11],P0[12],P0[13], pw1[0]=PKW(P0,8), pw1[1]=PKW(P0,10), pw1); \
    VRD(5); SBAR(); GAPA(C1=__builtin_amdgcn_mfma_f32_32x32x16_bf16(kf[3],qr[1],C1,0,0,0),   P0[14],P0[15],P1[0],P1[1],   pw1[2]=PKW(P0,12),pw1[3]=PKW(P0,14), pw1); \
    VRD(2); SBAR(); GAPA(C0=__builtin_amdgcn_mfma_f32_32x32x16_bf16(kf[4],qr[2],C0,0,0,0),   P1[2],P1[3],P1[4],P1[5],     pw2[0]=PKW(P1,0), pw2[1]=PKW(P1,2), pw2); \
    VRD(6); SBAR(); GAPA(C1=__builtin_amdgcn_mfma_f32_32x32x16_bf16(kf[5],qr[2],C1,0,0,0),   P1[6],P1[7],P1[8],P1[9],     pw2[2]=PKW(P1,4), pw2[3]=PKW(P1,6), pw2); \
    VRD(3); SBAR(); GAPA(C0=__builtin_amdgcn_mfma_f32_32x32x16_bf16(kf[6],qr[3],C0,0,0,0),   P1[10],P1[11],P1[12],P1[13], pw3[0]=PKW(P1,8), pw3[1]=PKW(P1,10), pw3); \
    VRD(7); SBAR(); GAPA(C1=__builtin_amdgcn_mfma_f32_32x32x16_bf16(kf[7],qr[3],C1,0,0,0),   P1[14],P1[15],0.f,0.f,       pw3[2]=PKW(P1,12),pw3[3]=PKW(P1,14), pw3); \
    l_reg+=sacc; \
    if(GK){DMA_K((t)+3,sl_cur);} if(GV){DMA_V((t)+1,sl_next);} \
    CMASK(C0,C1,t); \
    { float a=MX3(C0[0],C0[1],C1[0]),b=MX3(C0[2],C0[3],C1[1]); a=MX3(a,C1[2],C1[3]); \
      _Pragma("unroll") for(int r=4;r<16;r+=4){a=MX3(a,C0[r],C0[r+1]);b=MX3(b,C0[r+2],C0[r+3]);a=MX3(a,C1[r],C1[r+1]);b=MX3(b,C1[r+2],C1[r+3]);} \
      float rm=__builtin_fmaxf(a,b); { auto rr=__builtin_amdgcn_permlane32_swap(__float_as_uint(rm),__float_as_uint(rm),false,false); rm=__builtin_fmaxf(__uint_as_float(rr[0]),__uint_as_float(rr[1])); } \
      resc=false; \
      if(__builtin_expect(__any(rm>(float)THRL),0)){ const float dl=__builtin_fmaxf(rm,0.f); mhat+=dl; \
        _Pragma("unroll") for(int r=0;r<16;++r){C0[r]-=dl;C1[r]-=dl;} \
        const float f=__builtin_amdgcn_exp2f(-dl); l_reg*=f; if(hi==0)wsf[r32]=f; resc=true; } } \
    SBAR(); \
    GAPB(o[0]=__builtin_amdgcn_mfma_f32_32x32x16_bf16(PAF(0),VFR(0),o[0],0,0,0), C0,0); \
    GAPB(o[1]=__builtin_amdgcn_mfma_f32_32x32x16_bf16(PAF(0),VFR(4),o[1],0,0,0), C0,4); \
    KRD(GL,0); GAPB(o[0]=__builtin_amdgcn_mfma_f32_32x32x16_bf16(PAF(1),VFR(1),o[0],0,0,0), C0,8); \
    KRD(GL,1); GAPB(o[1]=__builtin_amdgcn_mfma_f32_32x32x16_bf16(PAF(1),VFR(5),o[1],0,0,0), C0,12); \
    KRD(GL,2); GAPB(o[0]=__builtin_amdgcn_mfma_f32_32x32x16_bf16(PAF(2),VFR(2),o[0],0,0,0), C1,0); \
    KRD(GL,3); GAPB(o[1]=__builtin_amdgcn_mfma_f32_32x32x16_bf16(PAF(2),VFR(6),o[1],0,0,0), C1,4); \
    GAPB(o[0]=__builtin_amdgcn_mfma_f32_32x32x16_bf16(PAF(3),VFR(3),o[0],0,0,0), C1,8); \
    GAPB(o[1]=__builtin_amdgcn_mfma_f32_32x32x16_bf16(PAF(3),VFR(7),o[1],0,0,0), C1,12); \
    }while(0)
  int t=1;
  #undef CMASK
  #define CMASK(P0,P1,t) do{}while(0)
  for(;t+5<NT;t+=2){
    STEP(pB0,pB1,pA0,pA1,t,true,true,true);     WAIT_BAR(2); RESC(); ROT();
    STEP(pA0,pA1,pB0,pB1,t+1,true,true,true);   WAIT_BAR(2); RESC(); ROT();
  }
  #undef CMASK
  #define CMASK(P0,P1,t) do{int jb_=(t)-(NT-4); if(jb_>=0)cmask(P0,P1,jb_,qrel,hi);}while(0)
  #define ENDW(tt) do{ if((tt)+3<NT){WAIT_BAR(2);} else if((tt)+2<NT){WAIT_BAR(1);} else {WAIT_BAR(0);} }while(0)
  for(;t+1<NT;t+=2){
    STEP(pB0,pB1,pA0,pA1,t,(t+3<NT),(t+1<NT),(t+1<NT));       ENDW(t);   RESC(); ROT();
    STEP(pA0,pA1,pB0,pB1,t+1,(t+4<NT),(t+2<NT),(t+2<NT));     ENDW(t+1); RESC(); ROT();
  }
  STEP(pB0,pB1,pA0,pA1,NT-1,false,false,false); RESC();
  { float sacc=pB0[0]+pB0[1]; _Pragma("unroll") for(int r=2;r<16;++r)sacc+=pB0[r]; _Pragma("unroll") for(int r=0;r<16;++r)sacc+=pB1[r]; l_reg+=sacc;
    pw0=(u32x4){PKW(pB0,0),PKW(pB0,2),PKW(pB0,4),PKW(pB0,6)};pw1=(u32x4){PKW(pB0,8),PKW(pB0,10),PKW(pB0,12),PKW(pB0,14)};pw2=(u32x4){PKW(pB1,0),PKW(pB1,2),PKW(pB1,4),PKW(pB1,6)};pw3=(u32x4){PKW(pB1,8),PKW(pB1,10),PKW(pB1,12),PKW(pB1,14)};
    SBAR(); pv(o,(int)(unsigned)(uintptr_t)vp0+sl_cur,PAF(0),PAF(1),PAF(2),PAF(3)); }
  #undef PKW
  #undef PAF
  #undef VFR
  #undef PIN
  #undef MX3
  #undef GAPA
  #undef GAPB
  #undef EX
  #undef VRD
  #undef KRD
  #undef STEP
  #undef ENDW
  {auto rr=__builtin_amdgcn_permlane32_swap(__float_as_uint(l_reg),__float_as_uint(l_reg),false,false);l_reg=__uint_as_float(rr[0])+__uint_as_float(rr[1]);}
  if(hi==0)wsf[32+r32]=l_reg;asm volatile("s_waitcnt lgkmcnt(0)":::"memory");
  float rli[16];
  #pragma unroll
  for(int r=0;r<16;++r)rli[r]=__builtin_amdgcn_rcpf(wsf[32+crow(r,hi)]);
  bf16*Ow=O+(rowbase+q0+wid*QBLK)*(long)odm+h*D;
  { bf16*stg=(bf16*)(shm+LDS_OST)+wid*2048;
    #pragma unroll
    for(int r=0;r<16;++r){const int orow=crow(r,hi);
      #pragma unroll
      for(int d0=0;d0<2;++d0)stg[orow*64+d0*32+r32]=__float2bfloat16(o[d0][r]*rli[r]);}
    asm volatile("s_waitcnt lgkmcnt(0)":::"memory");
    #pragma unroll
    for(int i=0;i<4;++i){const int row=i*8+(lane>>3),ch=lane&7; const u32x4 v=*(const u32x4*)(stg+row*64+ch*8); ATTN_STORE16(Ow+(long)row*odm+ch*8,v);} }
  asm volatile("s_waitcnt lgkmcnt(0)\n\ts_barrier":::"memory");
  #undef DMA_K
  #undef DMA_V
  #undef CMASK
  #undef LOADB
  #undef LOADB1
  #undef START
  #undef RESC
  #undef ROT
}
constexpr int ATTN_LDS_BYTES=LDS_BYTES;
struct AttnTensors { const bf16* Q; const bf16* K; const bf16* V; bf16* O; const float* cl; const float* ctot; const float* kpart; int odm; };
template<int THRL> __device__ __forceinline__ void attn_phase(char*lds,const AttnTensors&T,int G,int vcu,int tid){
  constexpr int NP=NHEAD*NQB/2;
  for(int L=vcu;L<2*NP;L+=G){ const int p=L%NP, s=p%(NQB/2), qb=(L<NP)?(NQB-1-s):s, h=(L<NP)?p/(NQB/2):((p/(NQB/2)+NHEAD/2)%NHEAD);
    attn_unit<THRL>(0,h,qb,T.Q,T.K,T.V,T.O,T.cl+(long)h*SEQ,T.ctot+(long)h*(SEQ/64),T.kpart,lds,tid,T.odm); }
}
#undef SBAR
#undef WAIT_BAR
}

namespace cg = cooperative_groups;
#define LAS __attribute__((address_space(3)))
typedef unsigned short bfr;
typedef unsigned v4u __attribute__((ext_vector_type(4)));
typedef float f32x4 __attribute__((ext_vector_type(4)));
constexpr int M = 16384, D = 1024, FF = 2816, NGU = 2 * FF, ZP = 3072, INC = 3080, NMEM = 256, NH = 8, CW = 512, DEPTH = 2;
constexpr float EPS = 1e-6f, LOG2E = 1.4426950408889634f;
constexpr size_t KiB = 1024, MiB = 1u << 20;
constexpr size_t WS_MEMN = 0, WS_KMEM = 512 * KiB, WS_VT = 1024 * KiB, WS_MEMKV_L = 1 * MiB;
constexpr size_t WS_CL = 3 * MiB, WS_CTOT = 3 * MiB + 512 * KiB, WS_WF = 3 * MiB + 768 * KiB, WS_KPART = 3 * MiB + 576 * KiB, WS_BAR = 3 * MiB + 640 * KiB, WS_PCNT = 3 * MiB + 656 * KiB,     WS_STATS = 4 * MiB;
constexpr size_t WS_W = 8 * MiB, W_LAYER = 49 * MiB;
constexpr size_t OFF_GU1 = 0, OFF_D1 = 11 * MiB, OFF_MI = 16 * MiB + 512 * KiB, OFF_MO = 22 * MiB + 512 * KiB, OFF_XQ = 24 * MiB + 512 * KiB, OFF_XKV = 26 * MiB + 512 * KiB,
                 OFF_XO = 30 * MiB + 512 * KiB, OFF_GU2 = 32 * MiB + 512 * KiB, OFF_D2 = 43 * MiB + 512 * KiB;
static_assert(OFF_D2 + (size_t)D * FF * 2 == W_LAYER && OFF_D1 == (size_t)NGU * D * 2, "weight map");
constexpr size_t WS_XB = 106 * MiB, WS_BIG = 138 * MiB, WS_END = 234 * MiB;
constexpr int RSTD_OFF = 139264;
constexpr int LDS_MISC = 155648 - 64;
constexpr int LDS_BYTES = 155648;
static_assert(attn_body::LDS_BYTES <= LDS_MISC && pg8::STAGE_BYTES <= LDS_MISC, "LDS map");
static_assert(attn_body::LDS_BYTES <= LDS_BYTES && pg8::STAGE_BYTES <= LDS_BYTES, "LDS map");

__device__ __forceinline__ float wave_sum(float v, int lane) {
#pragma unroll
    for (int o = 1; o < 64; o <<= 1) v += lane_get(v, lane ^ o);
    return v;
}
__device__ __forceinline__ unsigned f2bf(float f) { unsigned u = __builtin_bit_cast(unsigned, f); return (u + 0x7fffu + ((u >> 16) & 1u)) >> 16; }
__device__ __forceinline__ unsigned pk2(float lo, float hi) { return f2bf(lo) | (f2bf(hi) << 16); }
__device__ __forceinline__ float bf_lo(unsigned u) { return __builtin_bit_cast(float, u << 16); }
__device__ __forceinline__ float bf_hi(unsigned u) { return __builtin_bit_cast(float, u & 0xffff0000u); }

constexpr int TR_SCR_BYTES = 17408;
__device__ __forceinline__ void p0_transpose_item(const float* W, int srcN, int K, int ndst, bfr* WT, LAS float* scr, int item, int lane, const float* g, int mode, float wsc = 1.0f) {
    const int nblk = ndst / 64, kb = item / nblk, nb = item % nblk, k0 = 64 * kb, n0 = 64 * nb;
    int sc = n0; if (mode == 1) { const int tile = n0 >> 8, loc = n0 & 255; sc = (loc < 128) ? (tile * 128 + loc) : (FF + tile * 128 + loc - 128); }
    const float* src = W + (size_t)k0 * srcN + sc + lane;
    float v[64];
#pragma unroll
    for (int kk = 0; kk < 64; ++kk) v[kk] = src[(size_t)kk * srcN];
    if (g) {
#pragma unroll
        for (int kk = 0; kk < 64; ++kk) v[kk] *= g[k0 + kk] * wsc; }
    else if (wsc != 1.0f) {
#pragma unroll
        for (int kk = 0; kk < 64; ++kk) v[kk] *= wsc; }
#pragma unroll
    for (int kk = 0; kk < 64; ++kk) scr[kk * 65 + lane] = v[kk];
    asm volatile("s_waitcnt lgkmcnt(0)" ::: "memory");
    const int c = lane & 7;
#pragma unroll
    for (int j = 0; j < 8; ++j) { const int n = (lane >> 3) + 8 * j; const LAS float* s = scr + (8 * c) * 65 + n;
        v4u o; o.x = pk2(s[0 * 65], s[1 * 65]); o.y = pk2(s[2 * 65], s[3 * 65]); o.z = pk2(s[4 * 65], s[5 * 65]); o.w = pk2(s[6 * 65], s[7 * 65]);
        store16_wt(WT + (size_t)(n0 + n) * K + k0 + 8 * c, o); }
    asm volatile("s_waitcnt lgkmcnt(0)" ::: "memory");
}
struct In { const float* p[21]; };
constexpr int I_GU = (D / 64) * (NGU / 64), I_DN = (FF / 64) * (D / 64), I_MI = (D / 64) * (ZP / 64), I_SQ = (D / 64) * (D / 64), I_KV = (D / 64) * (2 * D / 64);
constexpr int PER_LAYER = 2 * I_GU + 2 * I_DN + I_MI + 3 * I_SQ + I_KV;
__device__ __forceinline__ void convert_mat_item(const In& in, unsigned char* ws, int l, int mat, int r, LAS float* scr, int lane) {
    unsigned char* wl = ws + WS_W + (size_t)l * W_LAYER;
    switch (mat) {
    case 0: p0_transpose_item(in.p[3] + (size_t)l * D * NGU, NGU, D, NGU, (bfr*)(wl + OFF_GU1), scr, r, lane, in.p[2] + l * D, 1); break;
    case 1: p0_transpose_item(in.p[4] + (size_t)l * FF * D, D, FF, D, (bfr*)(wl + OFF_D1), scr, r, lane, nullptr, 0, 0.5f); break;
    case 2: p0_transpose_item(in.p[6] + (size_t)l * D * INC, INC, D, ZP, (bfr*)(wl + OFF_MI), scr, r, lane, in.p[5] + l * D, 0); break;
    case 3: p0_transpose_item(in.p[11] + (size_t)l * D * D, D, D, D, (bfr*)(wl + OFF_MO), scr, r, lane, nullptr, 0); break;
    case 4: p0_transpose_item(in.p[14] + (size_t)l * D * D, D, D, D, (bfr*)(wl + OFF_XQ), scr, r, lane, in.p[12] + l * D, 0); break;
    case 5: p0_transpose_item(in.p[15] + (size_t)l * D * 2 * D, 2 * D, D, 2 * D, (bfr*)(wl + OFF_XKV), scr, r, lane, in.p[13] + l * D, 0); break;
    case 6: p0_transpose_item(in.p[16] + (size_t)l * D * D, D, D, D, (bfr*)(wl + OFF_XO), scr, r, lane, nullptr, 0); break;
    case 7: p0_transpose_item(in.p[18] + (size_t)l * D * NGU, NGU, D, NGU, (bfr*)(wl + OFF_GU2), scr, r, lane, in.p[17] + l * D, 1); break;
    default: p0_transpose_item(in.p[19] + (size_t)l * FF * D, D, FF, D, (bfr*)(wl + OFF_D2), scr, r, lane, nullptr, 0, 0.5f); break;
    }
}
template <int STAGE> __device__ __forceinline__ constexpr int stage_items() {
    return STAGE == 0 ? I_GU + I_KV : STAGE == 1 ? I_DN + I_MI + 3 * I_SQ + I_GU : STAGE == 2 ? 2 * I_DN + I_GU + I_KV : STAGE == 3 ? I_MI + 3 * I_SQ + I_GU : I_DN;
}
#define CV_TRY(L_, MAT_, CNT_) if (k < (CNT_)) { convert_mat_item(in, ws, L_, MAT_, k, scr, lane); return; } k -= (CNT_);
template <int STAGE> __device__ __forceinline__ void convert_stage_item(const In& in, unsigned char* ws, int k, LAS float* scr, int lane) {
    if constexpr (STAGE == 0) { CV_TRY(0, 0, I_GU) CV_TRY(0, 5, I_KV) }
    else if constexpr (STAGE == 1) { CV_TRY(0, 1, I_DN) CV_TRY(0, 2, I_MI) CV_TRY(0, 3, I_SQ) CV_TRY(0, 4, I_SQ) CV_TRY(0, 6, I_SQ) CV_TRY(0, 7, I_GU) }
    else if constexpr (STAGE == 2) { CV_TRY(0, 8, I_DN) CV_TRY(1, 0, I_GU) CV_TRY(1, 5, I_KV) CV_TRY(1, 1, I_DN) }
    else if constexpr (STAGE == 3) { CV_TRY(1, 2, I_MI) CV_TRY(1, 3, I_SQ) CV_TRY(1, 4, I_SQ) CV_TRY(1, 6, I_SQ) CV_TRY(1, 7, I_GU) }
    else { CV_TRY(1, 8, I_DN) }
}
#undef CV_TRY
static_assert(stage_items<0>() + stage_items<1>() + stage_items<2>() + stage_items<3>() + stage_items<4>() == 2 * PER_LAYER, "conversion schedule covers every item once");
template <int STAGE> __device__ __forceinline__ void convert_in_idle_slot(const In& in, unsigned char* ws, LAS unsigned char* lds, int bx, int G, int wave, int lane) {
    constexpr int NU = (M / 256) * (NGU / 256);
    const int r = NU % G, idx = ((r != 0) ? bx - r : bx) - 8, nl = ((r != 0) ? G - r : G) - 8;
    if (idx < 0 || nl <= 0) return;
    LAS float* scr = (LAS float*)(lds + wave * TR_SCR_BYTES);
    for (int it = idx * 8 + wave; it < stage_items<STAGE>(); it += nl * 8) convert_stage_item<STAGE>(in, ws, it, scr, lane);
}
__device__ __forceinline__ void prologue_phase(const In& in, float* out, unsigned char* ws, LAS unsigned char* lds, int gw, int NGW, int wave, int lane) {
    LAS float* scr = (LAS float*)(lds + wave * TR_SCR_BYTES);
    for (int it = gw; it < stage_items<0>(); it += NGW) convert_stage_item<0>(in, ws, it, scr, lane);
    float* wf = (float*)(ws + WS_WF);
    for (int i = gw * 64 + lane; i < DEPTH * NH * D; i += NGW * 64) { const int l = i / (NH * D), h = (i / D) % NH, k = i % D; wf[i] = in.p[5][l * D + k] * in.p[6][((size_t)l * D + k) * INC + ZP + h]; }
    for (int m = gw; m < NMEM; m += NGW) { const f32x4* xr = (const f32x4*)(in.p[1] + (size_t)m * D) + lane; f32x4 v[4]; float s = 0.f;
#pragma unroll
        for (int j = 0; j < 4; ++j) { v[j] = xr[64 * j]; s += (v[j].x * v[j].x + v[j].y * v[j].y) + (v[j].z * v[j].z + v[j].w * v[j].w); }
        const float rstd = rsqrtf(wave_sum(s, lane) * (1.f / D) + EPS); unsigned long long* o8 = (unsigned long long*)((bfr*)(ws + WS_MEMN) + (size_t)m * D) + lane;
#pragma unroll
        for (int j = 0; j < 4; ++j) o8[64 * j] = (unsigned long long)pk2(v[j].x * rstd, v[j].y * rstd) | ((unsigned long long)pk2(v[j].z * rstd, v[j].w * rstd) << 32); }
    for (int m0 = gw; m0 < M; m0 += 4 * NGW) { f32x4 v[4][4]; float s[4];
#pragma unroll
        for (int u = 0; u < 4; ++u) { const int m = m0 + u * NGW; const f32x4* xr = (const f32x4*)(in.p[0] + (size_t)(m < M ? m : m0) * D) + lane;
#pragma unroll
            for (int j = 0; j < 4; ++j) v[u][j] = xr[64 * j]; }
#pragma unroll
        for (int u = 0; u < 4; ++u) { const int m = m0 + u * NGW; s[u] = 0.f; unsigned long long* o8 = (unsigned long long*)((bfr*)(ws + WS_XB) + (size_t)(m < M ? m : m0) * D) + lane;
#pragma unroll
            for (int j = 0; j < 4; ++j) { s[u] += (v[u][j].x * v[u][j].x + v[u][j].y * v[u][j].y) + (v[u][j].z * v[u][j].z + v[u][j].w * v[u][j].w);
                if (m < M) o8[64 * j] = (unsigned long long)pk2(v[u][j].x, v[u][j].y) | ((unsigned long long)pk2(v[u][j].z, v[u][j].w) << 32); } }
#pragma unroll
        for (int o = 1; o < 64; o <<= 1) {
#pragma unroll
            for (int u = 0; u < 4; ++u) s[u] += lane_get(s[u], lane ^ o); }
#pragma unroll
        for (int u = 0; u < 4; ++u) { const int m = m0 + u * NGW; if (m < M && lane < 16) ((float*)(ws + WS_STATS))[(size_t)m * 16 + lane] = lane == 0 ? s[u] : 0.f; } }
}
__device__ __forceinline__ void norm_phase(const float* x, bfr* xb, int gw, int NGW, int lane, float* zero16) {
    if (zero16 && gw == 0 && lane < 16) zero16[lane] = 0.f;
    for (int m = gw; m < M; m += NGW) { const f32x4* xr = (const f32x4*)(x + (size_t)m * D) + lane; f32x4 v[4]; float s = 0.f;
#pragma unroll
        for (int j = 0; j < 4; ++j) { v[j] = xr[64 * j]; s += (v[j].x * v[j].x + v[j].y * v[j].y) + (v[j].z * v[j].z + v[j].w * v[j].w); }
        const float rstd = rsqrtf(wave_sum(s, lane) * (1.f / D) + EPS); unsigned long long* o8 = (unsigned long long*)(xb + (size_t)m * D) + lane;
#pragma unroll
        for (int j = 0; j < 4; ++j) o8[64 * j] = (unsigned long long)pk2(v[j].x * rstd, v[j].y * rstd) | ((unsigned long long)pk2(v[j].z * rstd, v[j].w * rstd) << 32); }
}
__device__ __forceinline__ void final_phase(const bfr* xbs, float* x, const float* g, int gw, int NGW, int lane) {
    const f32x4* gr = (const f32x4*)g + lane; f32x4 gv[4];
#pragma unroll
    for (int j = 0; j < 4; ++j) gv[j] = gr[64 * j];
    for (int m0 = gw; m0 < M; m0 += 4 * NGW) { f32x4 v[4][4]; float s[4];
#pragma unroll
        for (int u = 0; u < 4; ++u) { const int m = m0 + u * NGW; typedef unsigned u32x2 __attribute__((ext_vector_type(2))); const u32x2* xr = (const u32x2*)(xbs + (size_t)(m < M ? m : m0) * D) + lane;
#pragma unroll
            for (int j = 0; j < 4; ++j) { const u32x2 w = xr[64 * j]; v[u][j] = (f32x4){bf_lo(w.x), bf_hi(w.x), bf_lo(w.y), bf_hi(w.y)}; } }
#pragma unroll
        for (int u = 0; u < 4; ++u) { s[u] = 0.f;
#pragma unroll
            for (int j = 0; j < 4; ++j) s[u] += (v[u][j].x * v[u][j].x + v[u][j].y * v[u][j].y) + (v[u][j].z * v[u][j].z + v[u][j].w * v[u][j].w); }
#pragma unroll
        for (int o = 1; o < 64; o <<= 1) {
#pragma unroll
            for (int u = 0; u < 4; ++u) s[u] += lane_get(s[u], lane ^ o); }
#pragma unroll
        for (int u = 0; u < 4; ++u) { const int m = m0 + u * NGW; if (m < M) { const float rstd = rsqrtf(s[u] * (1.f / D) + EPS); f32x4* xr = (f32x4*)(x + (size_t)m * D) + lane;
#pragma unroll
            for (int j = 0; j < 4; ++j) xr[64 * j] = v[u][j] * rstd * gv[j]; } }
    }
}
__device__ __forceinline__ void fgate_phase(const bfr* x, const float* wf, const float* bfg, float* cl, float* ctot, LAS float* scr, int bx, int G, int tid, int lane, int wave) {
    for (int chunk = bx; chunk < M / 64; chunk += G) {
#pragma unroll 1
        for (int j = 0; j < 8; j += 2) { const int row = chunk * 64 + wave * 8 + j; typedef unsigned u32x2 __attribute__((ext_vector_type(2))); const u32x2* xa = (const u32x2*)(x + (size_t)row * D) + lane; const u32x2* xb2 = xa + D / 4; f32x4 va[4], vb[4]; float r[18]; int zo = 0; asm volatile("" : "+v"(zo));
#pragma unroll
            for (int jj = 0; jj < 4; ++jj) { const u32x2 wa = xa[64 * jj], wb = xb2[64 * jj]; va[jj] = (f32x4){bf_lo(wa.x), bf_hi(wa.x), bf_lo(wa.y), bf_hi(wa.y)}; vb[jj] = (f32x4){bf_lo(wb.x), bf_hi(wb.x), bf_lo(wb.y), bf_hi(wb.y)}; }
            r[16] = 0.f; r[17] = 0.f;
#pragma unroll
            for (int jj = 0; jj < 4; ++jj) { r[16] += (va[jj].x * va[jj].x + va[jj].y * va[jj].y) + (va[jj].z * va[jj].z + va[jj].w * va[jj].w); r[17] += (vb[jj].x * vb[jj].x + vb[jj].y * vb[jj].y) + (vb[jj].z * vb[jj].z + vb[jj].w * vb[jj].w); }
#pragma unroll
            for (int h = 0; h < NH; ++h) { const f32x4* wr = (const f32x4*)(wf + h * D) + lane + zo; float da = 0.f, db = 0.f;
#pragma unroll
                for (int jj = 0; jj < 4; ++jj) { const f32x4 w = wr[64 * jj]; da += (va[jj].x * w.x + va[jj].y * w.y) + (va[jj].z * w.z + va[jj].w * w.w); db += (vb[jj].x * w.x + vb[jj].y * w.y) + (vb[jj].z * w.z + vb[jj].w * w.w); }
                r[h] = da; r[8 + h] = db; }
#pragma unroll
            for (int o = 1; o < 64; o <<= 1) {
#pragma unroll
                for (int q = 0; q < 18; ++q) r[q] += lane_get(r[q], lane ^ o); }
            const float rsa = rsqrtf(r[16] * (1.f / D) + EPS), rsb = rsqrtf(r[17] * (1.f / D) + EPS);
            if (lane < 16) { const int h = lane & 7; float dsel = r[0];
#pragma unroll
                for (int q = 1; q < 16; ++q) dsel = (lane == q) ? r[q] : dsel;
                const float zz = dsel * (lane < 8 ? rsa : rsb) + bfg[h]; const float lf = fminf(zz, 0.f) - 0.6931471805599453f * __builtin_amdgcn_logf(1.0f + __builtin_amdgcn_exp2f(-LOG2E * fabsf(zz)));
                scr[(wave * 8 + j + (lane >> 3)) * 8 + h] = lf; } }
        __syncthreads();
        if (tid < NH) { float run = 0.f; for (int r = 0; r < 64; ++r) { run += scr[r * 8 + tid]; cl[(size_t)tid * M + chunk * 64 + r] = run; } ctot[tid * (M / 64) + chunk] = run; }
        __syncthreads();
    }
}
__device__ __forceinline__ void mixnorm_phase(bfr* z, const float* wconv, const float* gc, const float* ga, int p0, int pend, int pstep, int lane) {
    const int c8 = lane * 8; float w0[8], w1[8], w2[8], gcv[8], gav[8];
#pragma unroll
    for (int i = 0; i < 8; ++i) { w0[i] = wconv[c8 + i]; w1[i] = wconv[CW + c8 + i]; w2[i] = wconv[2 * CW + c8 + i]; gcv[i] = gc[c8 + i]; gav[i] = ga[c8 + i]; }
    for (int p = p0; p < pend; p += pstep) { const int r0 = 2 * p; bfr* zr = z + (size_t)r0 * ZP; const v4u z4 = {0u, 0u, 0u, 0u};
        const v4u zbA = *(const v4u*)(zr + c8), zbB = *(const v4u*)(zr + ZP + c8), oA = *(const v4u*)(zr + 3 * CW + c8), oB = *(const v4u*)(zr + ZP + 3 * CW + c8);
        const v4u cc0 = *(const v4u*)(zr + CW + c8), vv0 = *(const v4u*)(zr + 2 * CW + c8), cc1 = *(const v4u*)(zr + ZP + CW + c8), vv1 = *(const v4u*)(zr + ZP + 2 * CW + c8);
        const v4u cm1 = r0 >= 2 ? *(const v4u*)(zr - ZP + CW + c8) : z4, vm1 = r0 >= 2 ? *(const v4u*)(zr - ZP + 2 * CW + c8) : z4;
        const v4u cm2 = r0 >= 2 ? *(const v4u*)(zr - 2 * ZP + CW + c8) : z4, vm2 = r0 >= 2 ? *(const v4u*)(zr - 2 * ZP + 2 * CW + c8) : z4;
        float yA[8], yB[8], pA[8], pB[8]; float s4[4] = {0.f, 0.f, 0.f, 0.f};
#pragma unroll
        for (int q = 0; q < 4; ++q) {
            { const float um2 = bf_lo(cm2[q]) * bf_lo(vm2[q]), um1 = bf_lo(cm1[q]) * bf_lo(vm1[q]), u0 = bf_lo(cc0[q]) * bf_lo(vv0[q]), u1 = bf_lo(cc1[q]) * bf_lo(vv1[q]);
              const float a = bf_lo(zbA[q]) * (w0[2 * q] * um2 + w1[2 * q] * um1 + w2[2 * q] * u0), b = bf_lo(zbB[q]) * (w0[2 * q] * um1 + w1[2 * q] * u0 + w2[2 * q] * u1);
              yA[2 * q] = a; yB[2 * q] = b; s4[0] += a * a; s4[1] += b * b; const float e = bf_lo(oA[q]), f = bf_lo(oB[q]); pA[2 * q] = e; pB[2 * q] = f; s4[2] += e * e; s4[3] += f * f; }
            { const float um2 = bf_hi(cm2[q]) * bf_hi(vm2[q]), um1 = bf_hi(cm1[q]) * bf_hi(vm1[q]), u0 = bf_hi(cc0[q]) * bf_hi(vv0[q]), u1 = bf_hi(cc1[q]) * bf_hi(vv1[q]);
              const float a = bf_hi(zbA[q]) * (w0[2 * q + 1] * um2 + w1[2 * q + 1] * um1 + w2[2 * q + 1] * u0), b = bf_hi(zbB[q]) * (w0[2 * q + 1] * um1 + w1[2 * q + 1] * u0 + w2[2 * q + 1] * u1);
              yA[2 * q + 1] = a; yB[2 * q + 1] = b; s4[0] += a * a; s4[1] += b * b; const float e = bf_hi(oA[q]), f = bf_hi(oB[q]); pA[2 * q + 1] = e; pB[2 * q + 1] = f; s4[2] += e * e; s4[3] += f * f; } }
#pragma unroll
        for (int o = 1; o < 64; o <<= 1) {
#pragma unroll
            for (int u = 0; u < 4; ++u) s4[u] += lane_get(s4[u], lane ^ o); }
        const float rcA = rsqrtf(s4[0] * (1.f / CW) + EPS), rcB = rsqrtf(s4[1] * (1.f / CW) + EPS), raA = rsqrtf(s4[2] * (1.f / CW) + EPS), raB = rsqrtf(s4[3] * (1.f / CW) + EPS);
        v4u ocA, ocB, oaA, oaB;
#pragma unroll
        for (int q = 0; q < 4; ++q) { ocA[q] = pk2(yA[2 * q] * rcA * gcv[2 * q], yA[2 * q + 1] * rcA * gcv[2 * q + 1]); ocB[q] = pk2(yB[2 * q] * rcB * gcv[2 * q], yB[2 * q + 1] * rcB * gcv[2 * q + 1]);
            oaA[q] = pk2(pA[2 * q] * raA * gav[2 * q], pA[2 * q + 1] * raA * gav[2 * q + 1]); oaB[q] = pk2(pB[2 * q] * raB * gav[2 * q], pB[2 * q + 1] * raB * gav[2 * q + 1]); }
        store16_wt(zr + 4 * CW + c8, ocA); store16_wt(zr + 5 * CW + c8, oaA); store16_wt(zr + ZP + 4 * CW + c8, ocB); store16_wt(zr + ZP + 5 * CW + c8, oaB); }
}

#define XB_TMO      128
#define XB_XCNT(j)  (256  + 64 * (j))
#define XB_XSUB(j)  (1280 + 64 * (j))
#define XB_XGEN(j)  (2304 + 64 * (j))
#define XB_TOP      3328
#define XB_TOPGEN   3392
#define XCD_BAR_WORDS 3456
#define XB_SPIN_CAP (1u << 18)

__device__ __forceinline__ unsigned xb_ld(unsigned* p)              { return __hip_atomic_load(p, __ATOMIC_RELAXED, __HIP_MEMORY_SCOPE_AGENT); }
__device__ __forceinline__ unsigned xb_add(unsigned* p, unsigned v) { return __hip_atomic_fetch_add(p, v, __ATOMIC_RELAXED, __HIP_MEMORY_SCOPE_AGENT); }
__device__ __forceinline__ unsigned xb_xcc_id() { return (unsigned)__builtin_amdgcn_s_getreg((3 << 11) | 20) & 0xFu; }
#define XB_SPIN(cond, bar) do { unsigned _sp = 0; while (cond) { __builtin_amdgcn_s_sleep(1); \
    if ((++_sp & 255u) == 0u) { if (xb_ld(&(bar)[XB_TMO])) break; if (_sp > XB_SPIN_CAP) { atomicAdd(&(bar)[XB_TMO], 1u); break; } } } } while (0)

struct XcdBarrier {
    unsigned* bar; unsigned x;
    volatile LAS unsigned* st;
};

__device__ __forceinline__ XcdBarrier xcd_barrier_post(unsigned* bar, volatile LAS unsigned* st) {
    XcdBarrier b; b.bar = bar; b.x = xb_xcc_id(); b.st = st;
    if (threadIdx.x == 0) (void)xb_add(&bar[XB_XCNT(b.x)], 1u);
    return b;
}
__device__ __forceinline__ void xcd_barrier_complete(unsigned* bar, unsigned x, unsigned& nloc, unsigned& nx) {
    const unsigned G = gridDim.x * gridDim.y * gridDim.z;
    unsigned sum, cnt, mine, sp = 0u;
    for (;;) {
        sum = 0u; cnt = 0u; mine = 0u;
#pragma unroll
        for (unsigned j = 0; j < 16; ++j) { const unsigned c = xb_ld(&bar[XB_XCNT(j)]); sum += c; cnt += (c > 0u) ? 1u : 0u; mine = (j == x) ? c : mine; }
        if (sum == G) break;
        __builtin_amdgcn_s_sleep(1);
        if ((++sp & 255u) == 0u) { if (xb_ld(&bar[XB_TMO])) break; if (sp > XB_SPIN_CAP) { atomicAdd(&bar[XB_TMO], 1u); break; } }
    }
    nloc = mine > 0u ? mine : 1u; nx = cnt > 0u ? cnt : 1u;
}

__device__ __forceinline__ void xcd_barrier(const XcdBarrier& b) {
    asm volatile("s_waitcnt vmcnt(0)" ::: "memory");
    __syncthreads();
    if (threadIdx.x == 0) {
        unsigned* bar = b.bar;
        __builtin_amdgcn_s_waitcnt(0);
        unsigned nloc = b.st[0], nx = b.st[1];
        if (nloc == 0u) { xcd_barrier_complete(bar, b.x, nloc, nx); b.st[0] = nloc; b.st[1] = nx; }
        const unsigned old = xb_add(&bar[XB_XSUB(b.x)], 1u);
        const unsigned gen = old / nloc;
        if (old + 1u == (gen + 1u) * nloc) {
            __builtin_amdgcn_fence(__ATOMIC_RELEASE, "agent");
            asm volatile("s_waitcnt vmcnt(0)" ::: "memory");
            const unsigned og = xb_add(&bar[XB_TOP], 1u);
            const unsigned tg = og / nx;
            if (og + 1u == (tg + 1u) * nx) xb_add(&bar[XB_TOPGEN], 1u);
            else XB_SPIN(xb_ld(&bar[XB_TOPGEN]) == tg, bar);
            __builtin_amdgcn_fence(__ATOMIC_ACQUIRE, "agent");
            xb_add(&bar[XB_XGEN(b.x)], 1u);
            asm volatile("s_waitcnt vmcnt(0)" ::: "memory");
        } else {
            XB_SPIN(xb_ld(&bar[XB_XGEN(b.x)]) == gen, bar);
            __builtin_amdgcn_fence(__ATOMIC_ACQUIRE, "agent");
            asm volatile("s_waitcnt vmcnt(0)" ::: "memory");
        }
    }
    __syncthreads();
}

__device__ __forceinline__ int opaque_s(int v, int z) { return __builtin_amdgcn_readfirstlane(v + z); }
template <class T> __device__ __forceinline__ T* opaque_p(T* p, int z) { return (T*)((unsigned char*)p + (size_t)(unsigned)__builtin_amdgcn_readfirstlane(z)); }
__device__ __forceinline__ void panel_sync(unsigned* w) {
    asm volatile("s_waitcnt vmcnt(0)" ::: "memory"); __syncthreads();
    if (threadIdx.x == 0) { __hip_atomic_fetch_add(w, 1u, __ATOMIC_RELAXED, __HIP_MEMORY_SCOPE_AGENT); unsigned sp = 0;
        while (__hip_atomic_load(w, __ATOMIC_RELAXED, __HIP_MEMORY_SCOPE_AGENT) < 4u) { __builtin_amdgcn_s_sleep(1); if (++sp > (1u << 22)) break; }
        __builtin_amdgcn_fence(__ATOMIC_ACQUIRE, "agent"); asm volatile("s_waitcnt vmcnt(0)" ::: "memory"); }
    __syncthreads();
}
struct Args { const float* in[21]; float* out; unsigned char* ws; int ph_lo, ph_hi; };
constexpr int NPH = 1 + DEPTH * 8 + 1;
#ifndef MK_ONE_LAUNCH
#define MK_ONE_LAUNCH 1
#endif
__global__ void __launch_bounds__(512, 2) mk_fwd(Args a) {
    extern __shared__ __attribute__((aligned(16))) unsigned char lds_raw[];
    LAS unsigned char* lds = (LAS unsigned char*)lds_raw;
    const int lo = a.ph_lo, hi = a.ph_hi; int ph = 0;
    if (threadIdx.x < 16) ((LAS unsigned*)(lds + LDS_MISC))[threadIdx.x] = 0u;
    __syncthreads();
    XcdBarrier xbar; xbar.bar = nullptr; xbar.x = 0; xbar.st = nullptr;
    if (hi - lo > 1) xbar = xcd_barrier_post((unsigned*)(a.ws + WS_BAR), (volatile LAS unsigned*)(lds + LDS_MISC));
    if (hi < 0) cg::this_grid().sync();
#define PH_BEGIN if (ph >= lo && ph < hi) { int tid = threadIdx.x, zz_ = 0; asm volatile("" : "+v"(tid), "+v"(zz_)); \
    unsigned char* const ws = opaque_p(a.ws, zz_); float* const out = opaque_p(a.out, zz_); const int G = opaque_s((int)gridDim.x, zz_), bx = opaque_s((int)blockIdx.x, zz_); \
    const int lane = tid & 63, wave = __builtin_amdgcn_readfirstlane(tid >> 6), vcu = (G % 8 == 0) ? (bx % 8) * (G / 8) + bx / 8 : bx, gw = bx * 8 + wave, NGW = G * 8; \
    (void)lane; (void)vcu; (void)gw; (void)NGW; \
    bfr* const xb = (bfr*)(ws + WS_XB); bfr* const big = (bfr*)(ws + WS_BIG); bfr* const memn = (bfr*)(ws + WS_MEMN); \
    bfr* const act = big; bfr* const z = big; bfr* const qx = big; bfr* const Pb = big + (size_t)M * D; bfr* const ox = big + 2 * (size_t)M * D; \
    float* const cl = (float*)(ws + WS_CL); float* const ctot = (float*)(ws + WS_CTOT); float* const stats = (float*)(ws + WS_STATS); (void)stats; \
    const unsigned char* const wl = ws + WS_W + (size_t)l * W_LAYER; bfr* const kmem = (bfr*)(ws + WS_KMEM + (size_t)l * WS_MEMKV_L); bfr* const vt = (bfr*)(ws + WS_VT + (size_t)l * WS_MEMKV_L); \
    (void)xb; (void)memn; (void)act; (void)z; (void)qx; (void)Pb; (void)ox; (void)cl; (void)ctot; (void)wl; (void)kmem; (void)vt;
#define PH_END   if (ph + 1 < hi) xcd_barrier(xbar); } ++ph;
    using pg8::Gemm; using pg8::StaticOrder; using pg8::gemm_phase;

    { const int l = 0; PH_BEGIN { In in;
#pragma unroll
        for (int i = 0; i < 21; ++i) in.p[i] = a.in[i];
        prologue_phase(in, out, ws, lds, gw, NGW, wave, lane); } PH_END }

    { constexpr int l = 0; constexpr int f = 0;
            PH_BEGIN {
                const Gemm g{xb, (const bfr*)(wl + (f ? OFF_GU2 : OFF_GU1)), M, NGU, D, D, D, 0, 256L * D}; StaticOrder S; S.init(M, NGU, G, bx);
                const pg8::EpiSwiglu E{act, FF, (const LAS float*)(lds + RSTD_OFF)}; pg8::fill_rstd_table((LAS float*)(lds + RSTD_OFF), stats, S, tid);
                if (f == 0 && bx == 0 && tid < 16) ((float*)(ws + WS_KPART))[tid] = 0.f;
                gemm_phase<pg8::EpiSwiglu, StaticOrder, true, true>(lds, g, S, E, tid);
                { In in;
#pragma unroll
                    for (int i = 0; i < 21; ++i) in.p[i] = a.in[i];
                    convert_in_idle_slot<1 + 2 * l + f>(in, ws, lds, bx, G, wave, lane); __syncthreads(); }
                if (f == 0) {
                    const Gemm gk{memn, (const bfr*)(wl + OFF_XKV), NMEM, D, D, D, D, 0, 256L * D}; StaticOrder Sk; Sk.init(NMEM, D, G, (bx + G - 128 % G) % G);
                    const pg8::EpiScaleBf16 Ek{kmem, D, 1.f, 0, 0, 1.f, nullptr, true};
                    gemm_phase<pg8::EpiScaleBf16, StaticOrder, true, true>(lds, gk, Sk, Ek, tid);
                    const Gemm gv{(const bfr*)(wl + OFF_XKV) + (size_t)D * D, memn, D, NMEM, D, D, D, 0, 256L * D}; StaticOrder Sv; Sv.init(D, NMEM, G, (bx + G - 132 % G) % G);
                    const pg8::EpiScaleBf16 Ev{vt, NMEM, 1.f, 0, 0, 1.f, nullptr, true};
                    gemm_phase<pg8::EpiScaleBf16, StaticOrder, true, true>(lds, gv, Sv, Ev, tid);
                } } PH_END
            PH_BEGIN {
                const Gemm g{act, (const bfr*)(wl + (f ? OFF_D2 : OFF_D1)), M, D, FF, FF, FF, 0, 256L * FF}; StaticOrder S; S.init(M, D, G, bx);
                const pg8::EpiResid E{xb, D, stats};
                gemm_phase<pg8::EpiResid, StaticOrder, true, true>(lds, g, S, E, tid); } PH_END
            if (f == 0) {
                PH_BEGIN {
                    const Gemm g{xb, (const bfr*)(wl + OFF_MI), M, ZP, D, D, D, 0, 256L * D}; StaticOrder S; S.init(M, ZP, G, bx);
                    const pg8::EpiMixIn E{z, ZP, attn_body::C2, (float*)(ws + WS_KPART), (const LAS float*)(lds + RSTD_OFF)}; pg8::fill_rstd_table((LAS float*)(lds + RSTD_OFF), stats, S, tid);
                    gemm_phase<pg8::EpiMixIn, StaticOrder, true, true>(lds, g, S, E, tid);
                    fgate_phase(xb, (const float*)(ws + WS_WF) + (size_t)l * NH * D, a.in[8] + l * NH, cl, ctot, (LAS float*)lds, bx, G, tid, lane, wave);
                    } PH_END
                PH_BEGIN {
                    const attn_body::AttnTensors AT{(const attn_body::bf16*)(z + 3 * CW), (const attn_body::bf16*)(z + 4 * CW), (const attn_body::bf16*)(z + 5 * CW), (attn_body::bf16*)(z + 3 * CW), cl, ctot, (const float*)(ws + WS_KPART), ZP};
                    attn_body::attn_phase<32>((char*)lds_raw, AT, G, vcu, tid);
                    } PH_END
                PH_BEGIN {
                    const Gemm g{z + 4 * CW, (const bfr*)(wl + OFF_MO), M, D, D, ZP, D, 0, 256L * D}; StaticOrder S; S.init(M, D, G, bx);
                    { pg8::Unit u0; if (S.next(0, u0)) { const int pb = (u0.pm * 256 + u0.pn * 64) / 2;
                        mixnorm_phase(z, a.in[7] + (size_t)l * 3 * CW, a.in[9] + l * CW, a.in[10] + l * CW, pb + wave, pb + 32, 8, lane);
                        panel_sync((unsigned*)(ws + WS_PCNT) + (2 * l + 0) * 4096 + 64 * u0.pm); } }
                    const pg8::EpiResid E{xb, D, stats};
                    gemm_phase<pg8::EpiResid, StaticOrder, true, true>(lds, g, S, E, tid); } PH_END
                PH_BEGIN {
                    const Gemm g{xb, (const bfr*)(wl + OFF_XQ), M, D, D, D, D, 0, 256L * D}; StaticOrder S; S.init(M, D, G, bx);
                    const pg8::EpiScaleBf16 E{qx, D, 0.0625f * LOG2E, 0, 0, 1.f, stats, false};
                    gemm_phase<pg8::EpiScaleBf16, StaticOrder, true, true>(lds, g, S, E, tid);
                    asm volatile("s_waitcnt vmcnt(0)" ::: "memory"); __builtin_amdgcn_fence(__ATOMIC_RELEASE, "workgroup"); __syncthreads(); __builtin_amdgcn_fence(__ATOMIC_ACQUIRE, "workgroup");
                    const Gemm gs{qx, kmem, M, D, 256, D, D, 256, 256};
                    const pg8::EpiSoftmax Es{Pb, D};
                    gemm_phase<pg8::EpiSoftmax, StaticOrder, false, true>(lds, gs, S, Es, tid);
                    asm volatile("s_waitcnt vmcnt(0)" ::: "memory"); __builtin_amdgcn_fence(__ATOMIC_RELEASE, "workgroup"); __syncthreads(); __builtin_amdgcn_fence(__ATOMIC_ACQUIRE, "workgroup");
                    const Gemm go{Pb, vt, M, D, 256, D, 256, 256, 256L * 256};
                    const pg8::EpiScaleBf16 Eo{ox, D, 1.f, 0, 0, 1.f, nullptr, true};
                    gemm_phase<pg8::EpiScaleBf16, StaticOrder, true, true>(lds, go, S, Eo, tid);
                    { pg8::Unit u0; if (S.next(0, u0)) panel_sync((unsigned*)(ws + WS_PCNT) + (2 * l + 1) * 4096 + 64 * u0.pm); }
                    const Gemm gx{ox, (const bfr*)(wl + OFF_XO), M, D, D, D, D, 0, 256L * D};
                    const pg8::EpiResid Ex{xb, D, stats};
                    gemm_phase<pg8::EpiResid, StaticOrder, true, true>(lds, gx, S, Ex, tid); } PH_END
            }
    }
    { constexpr int l = 0; constexpr int f = 1;
            PH_BEGIN {
                const Gemm g{xb, (const bfr*)(wl + (f ? OFF_GU2 : OFF_GU1)), M, NGU, D, D, D, 0, 256L * D}; StaticOrder S; S.init(M, NGU, G, bx);
                const pg8::EpiSwiglu E{act, FF, (const LAS float*)(lds + RSTD_OFF)}; pg8::fill_rstd_table((LAS float*)(lds + RSTD_OFF), stats, S, tid);
                if (f == 0 && bx == 0 && tid < 16) ((float*)(ws + WS_KPART))[tid] = 0.f;
                gemm_phase<pg8::EpiSwiglu, StaticOrder, true, true>(lds, g, S, E, tid);
                { In in;
#pragma unroll
                    for (int i = 0; i < 21; ++i) in.p[i] = a.in[i];
                    convert_in_idle_slot<1 + 2 * l + f>(in, ws, lds, bx, G, wave, lane); __syncthreads(); }
                if (f == 0) {
                    const Gemm gk{memn, (const bfr*)(wl + OFF_XKV), NMEM, D, D, D, D, 0, 256L * D}; StaticOrder Sk; Sk.init(NMEM, D, G, (bx + G - 128 % G) % G);
                    const pg8::EpiScaleBf16 Ek{kmem, D, 1.f, 0, 0, 1.f, nullptr, true};
                    gemm_phase<pg8::EpiScaleBf16, StaticOrder, true, true>(lds, gk, Sk, Ek, tid);
                    const Gemm gv{(const bfr*)(wl + OFF_XKV) + (size_t)D * D, memn, D, NMEM, D, D, D, 0, 256L * D}; StaticOrder Sv; Sv.init(D, NMEM, G, (bx + G - 132 % G) % G);
                    const pg8::EpiScaleBf16 Ev{vt, NMEM, 1.f, 0, 0, 1.f, nullptr, true};
                    gemm_phase<pg8::EpiScaleBf16, StaticOrder, true, true>(lds, gv, Sv, Ev, tid);
                } } PH_END
            PH_BEGIN {
                const Gemm g{act, (const bfr*)(wl + (f ? OFF_D2 : OFF_D1)), M, D, FF, FF, FF, 0, 256L * FF}; StaticOrder S; S.init(M, D, G, bx);
                const pg8::EpiResid E{xb, D, stats};
                gemm_phase<pg8::EpiResid, StaticOrder, true, true>(lds, g, S, E, tid); } PH_END
            if (f == 0) {
                PH_BEGIN {
                    const Gemm g{xb, (const bfr*)(wl + OFF_MI), M, ZP, D, D, D, 0, 256L * D}; StaticOrder S; S.init(M, ZP, G, bx);
                    const pg8::EpiMixIn E{z, ZP, attn_body::C2, (float*)(ws + WS_KPART), (const LAS float*)(lds + RSTD_OFF)}; pg8::fill_rstd_table((LAS float*)(lds + RSTD_OFF), stats, S, tid);
                    gemm_phase<pg8::EpiMixIn, StaticOrder, true, true>(lds, g, S, E, tid);
                    fgate_phase(xb, (const float*)(ws + WS_WF) + (size_t)l * NH * D, a.in[8] + l * NH, cl, ctot, (LAS float*)lds, bx, G, tid, lane, wave);
                    } PH_END
                PH_BEGIN {
                    const attn_body::AttnTensors AT{(const attn_body::bf16*)(z + 3 * CW), (const attn_body::bf16*)(z + 4 * CW), (const attn_body::bf16*)(z + 5 * CW), (attn_body::bf16*)(z + 3 * CW), cl, ctot, (const float*)(ws + WS_KPART), ZP};
                    attn_body::attn_phase<32>((char*)lds_raw, AT, G, vcu, tid);
                    } PH_END
                PH_BEGIN {
                    const Gemm g{z + 4 * CW, (const bfr*)(wl + OFF_MO), M, D, D, ZP, D, 0, 256L * D}; StaticOrder S; S.init(M, D, G, bx);
                    { pg8::Unit u0; if (S.next(0, u0)) { const int pb = (u0.pm * 256 + u0.pn * 64) / 2;
                        mixnorm_phase(z, a.in[7] + (size_t)l * 3 * CW, a.in[9] + l * CW, a.in[10] + l * CW, pb + wave, pb + 32, 8, lane);
                        panel_sync((unsigned*)(ws + WS_PCNT) + (2 * l + 0) * 4096 + 64 * u0.pm); } }
                    const pg8::EpiResid E{xb, D, stats};
                    gemm_phase<pg8::EpiResid, StaticOrder, true, true>(lds, g, S, E, tid); } PH_END
                PH_BEGIN {
                    const Gemm g{xb, (const bfr*)(wl + OFF_XQ), M, D, D, D, D, 0, 256L * D}; StaticOrder S; S.init(M, D, G, bx);
                    const pg8::EpiScaleBf16 E{qx, D, 0.0625f * LOG2E, 0, 0, 1.f, stats, false};
                    gemm_phase<pg8::EpiScaleBf16, StaticOrder, true, true>(lds, g, S, E, tid);
                    asm volatile("s_waitcnt vmcnt(0)" ::: "memory"); __builtin_amdgcn_fence(__ATOMIC_RELEASE, "workgroup"); __syncthreads(); __builtin_amdgcn_fence(__ATOMIC_ACQUIRE, "workgroup");
                    const Gemm gs{qx, kmem, M, D, 256, D, D, 256, 256};
                    const pg8::EpiSoftmax Es{Pb, D};
                    gemm_phase<pg8::EpiSoftmax, StaticOrder, false, true>(lds, gs, S, Es, tid);
                    asm volatile("s_waitcnt vmcnt(0)" ::: "memory"); __builtin_amdgcn_fence(__ATOMIC_RELEASE, "workgroup"); __syncthreads(); __builtin_amdgcn_fence(__ATOMIC_ACQUIRE, "workgroup");
                    const Gemm go{Pb, vt, M, D, 256, D, 256, 256, 256L * 256};
                    const pg8::EpiScaleBf16 Eo{ox, D, 1.f, 0, 0, 1.f, nullptr, true};
                    gemm_phase<pg8::EpiScaleBf16, StaticOrder, true, true>(lds, go, S, Eo, tid);
                    { pg8::Unit u0; if (S.next(0, u0)) panel_sync((unsigned*)(ws + WS_PCNT) + (2 * l + 1) * 4096 + 64 * u0.pm); }
                    const Gemm gx{ox, (const bfr*)(wl + OFF_XO), M, D, D, D, D, 0, 256L * D};
                    const pg8::EpiResid Ex{xb, D, stats};
                    gemm_phase<pg8::EpiResid, StaticOrder, true, true>(lds, gx, S, Ex, tid); } PH_END
            }
    }
    { constexpr int l = 1; constexpr int f = 0;
            PH_BEGIN {
                const Gemm g{xb, (const bfr*)(wl + (f ? OFF_GU2 : OFF_GU1)), M, NGU, D, D, D, 0, 256L * D}; StaticOrder S; S.init(M, NGU, G, bx);
                const pg8::EpiSwiglu E{act, FF, (const LAS float*)(lds + RSTD_OFF)}; pg8::fill_rstd_table((LAS float*)(lds + RSTD_OFF), stats, S, tid);
                if (f == 0 && bx == 0 && tid < 16) ((float*)(ws + WS_KPART))[tid] = 0.f;
                gemm_phase<pg8::EpiSwiglu, StaticOrder, true, true>(lds, g, S, E, tid);
                { In in;
#pragma unroll
                    for (int i = 0; i < 21; ++i) in.p[i] = a.in[i];
                    convert_in_idle_slot<1 + 2 * l + f>(in, ws, lds, bx, G, wave, lane); __syncthreads(); }
                if (f == 0) {
                    const Gemm gk{memn, (const bfr*)(wl + OFF_XKV), NMEM, D, D, D, D, 0, 256L * D}; StaticOrder Sk; Sk.init(NMEM, D, G, (bx + G - 128 % G) % G);
                    const pg8::EpiScaleBf16 Ek{kmem, D, 1.f, 0, 0, 1.f, nullptr, true};
                    gemm_phase<pg8::EpiScaleBf16, StaticOrder, true, true>(lds, gk, Sk, Ek, tid);
                    const Gemm gv{(const bfr*)(wl + OFF_XKV) + (size_t)D * D, memn, D, NMEM, D, D, D, 0, 256L * D}; StaticOrder Sv; Sv.init(D, NMEM, G, (bx + G - 132 % G) % G);
                    const pg8::EpiScaleBf16 Ev{vt, NMEM, 1.f, 0, 0, 1.f, nullptr, true};
                    gemm_phase<pg8::EpiScaleBf16, StaticOrder, true, true>(lds, gv, Sv, Ev, tid);
                } } PH_END
            PH_BEGIN {
                const Gemm g{act, (const bfr*)(wl + (f ? OFF_D2 : OFF_D1)), M, D, FF, FF, FF, 0, 256L * FF}; StaticOrder S; S.init(M, D, G, bx);
                const pg8::EpiResid E{xb, D, stats};
                gemm_phase<pg8::EpiResid, StaticOrder, true, true>(lds, g, S, E, tid); } PH_END
            if (f == 0) {
                PH_BEGIN {
                    const Gemm g{xb, (const bfr*)(wl + OFF_MI), M, ZP, D, D, D, 0, 256L * D}; StaticOrder S; S.init(M, ZP, G, bx);
                    const pg8::EpiMixIn E{z, ZP, attn_body::C2, (float*)(ws + WS_KPART), (const LAS float*)(lds + RSTD_OFF)}; pg8::fill_rstd_table((LAS float*)(lds + RSTD_OFF), stats, S, tid);
                    gemm_phase<pg8::EpiMixIn, StaticOrder, true, true>(lds, g, S, E, tid);
                    fgate_phase(xb, (const float*)(ws + WS_WF) + (size_t)l * NH * D, a.in[8] + l * NH, cl, ctot, (LAS float*)lds, bx, G, tid, lane, wave);
                    } PH_END
                PH_BEGIN {
                    const attn_body::AttnTensors AT{(const attn_body::bf16*)(z + 3 * CW), (const attn_body::bf16*)(z + 4 * CW), (const attn_body::bf16*)(z + 5 * CW), (attn_body::bf16*)(z + 3 * CW), cl, ctot, (const float*)(ws + WS_KPART), ZP};
                    attn_body::attn_phase<32>((char*)lds_raw, AT, G, vcu, tid);
                    } PH_END
                PH_BEGIN {
                    const Gemm g{z + 4 * CW, (const bfr*)(wl + OFF_MO), M, D, D, ZP, D, 0, 256L * D}; StaticOrder S; S.init(M, D, G, bx);
                    { pg8::Unit u0; if (S.next(0, u0)) { const int pb = (u0.pm * 256 + u0.pn * 64) / 2;
                        mixnorm_phase(z, a.in[7] + (size_t)l * 3 * CW, a.in[9] + l * CW, a.in[10] + l * CW, pb + wave, pb + 32, 8, lane);
                        panel_sync((unsigned*)(ws + WS_PCNT) + (2 * l + 0) * 4096 + 64 * u0.pm); } }
                    const pg8::EpiResid E{xb, D, stats};
                    gemm_phase<pg8::EpiResid, StaticOrder, true, true>(lds, g, S, E, tid); } PH_END
                PH_BEGIN {
                    const Gemm g{xb, (const bfr*)(wl + OFF_XQ), M, D, D, D, D, 0, 256L * D}; StaticOrder S; S.init(M, D, G, bx);
                    const pg8::EpiScaleBf16 E{qx, D, 0.0625f * LOG2E, 0, 0, 1.f, stats, false};
                    gemm_phase<pg8::EpiScaleBf16, StaticOrder, true, true>(lds, g, S, E, tid);
                    asm volatile("s_waitcnt vmcnt(0)" ::: "memory"); __builtin_amdgcn_fence(__ATOMIC_RELEASE, "workgroup"); __syncthreads(); __builtin_amdgcn_fence(__ATOMIC_ACQUIRE, "workgroup");
                    const Gemm gs{qx, kmem, M, D, 256, D, D, 256, 256};
                    const pg8::EpiSoftmax Es{Pb, D};
                    gemm_phase<pg8::EpiSoftmax, StaticOrder, false, true>(lds, gs, S, Es, tid);
                    asm volatile("s_waitcnt vmcnt(0)" ::: "memory"); __builtin_amdgcn_fence(__ATOMIC_RELEASE, "workgroup"); __syncthreads(); __builtin_amdgcn_fence(__ATOMIC_ACQUIRE, "workgroup");
                    const Gemm go{Pb, vt, M, D, 256, D, 256, 256, 256L * 256};
                    const pg8::EpiScaleBf16 Eo{ox, D, 1.f, 0, 0, 1.f, nullptr, true};
                    gemm_phase<pg8::EpiScaleBf16, StaticOrder, true, true>(lds, go, S, Eo, tid);
                    { pg8::Unit u0; if (S.next(0, u0)) panel_sync((unsigned*)(ws + WS_PCNT) + (2 * l + 1) * 4096 + 64 * u0.pm); }
                    const Gemm gx{ox, (const bfr*)(wl + OFF_XO), M, D, D, D, D, 0, 256L * D};
                    const pg8::EpiResid Ex{xb, D, stats};
                    gemm_phase<pg8::EpiResid, StaticOrder, true, true>(lds, gx, S, Ex, tid); } PH_END
            }
    }
    { constexpr int l = 1; constexpr int f = 1;
            PH_BEGIN {
                const Gemm g{xb, (const bfr*)(wl + (f ? OFF_GU2 : OFF_GU1)), M, NGU, D, D, D, 0, 256L * D}; StaticOrder S; S.init(M, NGU, G, bx);
                const pg8::EpiSwiglu E{act, FF, (const LAS float*)(lds + RSTD_OFF)}; pg8::fill_rstd_table((LAS float*)(lds + RSTD_OFF), stats, S, tid);
                if (f == 0 && bx == 0 && tid < 16) ((float*)(ws + WS_KPART))[tid] = 0.f;
                gemm_phase<pg8::EpiSwiglu, StaticOrder, true, true>(lds, g, S, E, tid);
                { In in;
#pragma unroll
                    for (int i = 0; i < 21; ++i) in.p[i] = a.in[i];
                    convert_in_idle_slot<1 + 2 * l + f>(in, ws, lds, bx, G, wave, lane); __syncthreads(); }
                if (f == 0) {
                    const Gemm gk{memn, (const bfr*)(wl + OFF_XKV), NMEM, D, D, D, D, 0, 256L * D}; StaticOrder Sk; Sk.init(NMEM, D, G, (bx + G - 128 % G) % G);
                    const pg8::EpiScaleBf16 Ek{kmem, D, 1.f, 0, 0, 1.f, nullptr, true};
                    gemm_phase<pg8::EpiScaleBf16, StaticOrder, true, true>(lds, gk, Sk, Ek, tid);
                    const Gemm gv{(const bfr*)(wl + OFF_XKV) + (size_t)D * D, memn, D, NMEM, D, D, D, 0, 256L * D}; StaticOrder Sv; Sv.init(D, NMEM, G, (bx + G - 132 % G) % G);
                    const pg8::EpiScaleBf16 Ev{vt, NMEM, 1.f, 0, 0, 1.f, nullptr, true};
                    gemm_phase<pg8::EpiScaleBf16, StaticOrder, true, true>(lds, gv, Sv, Ev, tid);
                } } PH_END
            PH_BEGIN {
                const Gemm g{act, (const bfr*)(wl + (f ? OFF_D2 : OFF_D1)), M, D, FF, FF, FF, 0, 256L * FF}; StaticOrder S; S.init(M, D, G, bx);
                const pg8::EpiResid E{xb, D, stats};
                gemm_phase<pg8::EpiResid, StaticOrder, true, true>(lds, g, S, E, tid); } PH_END
            if (f == 0) {
                PH_BEGIN {
                    const Gemm g{xb, (const bfr*)(wl + OFF_MI), M, ZP, D, D, D, 0, 256L * D}; StaticOrder S; S.init(M, ZP, G, bx);
                    const pg8::EpiMixIn E{z, ZP, attn_body::C2, (float*)(ws + WS_KPART), (const LAS float*)(lds + RSTD_OFF)}; pg8::fill_rstd_table((LAS float*)(lds + RSTD_OFF), stats, S, tid);
                    gemm_phase<pg8::EpiMixIn, StaticOrder, true, true>(lds, g, S, E, tid);
                    fgate_phase(xb, (const float*)(ws + WS_WF) + (size_t)l * NH * D, a.in[8] + l * NH, cl, ctot, (LAS float*)lds, bx, G, tid, lane, wave);
                    } PH_END
                PH_BEGIN {
                    const attn_body::AttnTensors AT{(const attn_body::bf16*)(z + 3 * CW), (const attn_body::bf16*)(z + 4 * CW), (const attn_body::bf16*)(z + 5 * CW), (attn_body::bf16*)(z + 3 * CW), cl, ctot, (const float*)(ws + WS_KPART), ZP};
                    attn_body::attn_phase<32>((char*)lds_raw, AT, G, vcu, tid);
                    } PH_END
                PH_BEGIN {
                    const Gemm g{z + 4 * CW, (const bfr*)(wl + OFF_MO), M, D, D, ZP, D, 0, 256L * D}; StaticOrder S; S.init(M, D, G, bx);
                    { pg8::Unit u0; if (S.next(0, u0)) { const int pb = (u0.pm * 256 + u0.pn * 64) / 2;
                        mixnorm_phase(z, a.in[7] + (size_t)l * 3 * CW, a.in[9] + l * CW, a.in[10] + l * CW, pb + wave, pb + 32, 8, lane);
                        panel_sync((unsigned*)(ws + WS_PCNT) + (2 * l + 0) * 4096 + 64 * u0.pm); } }
                    const pg8::EpiResid E{xb, D, stats};
                    gemm_phase<pg8::EpiResid, StaticOrder, true, true>(lds, g, S, E, tid); } PH_END
                PH_BEGIN {
                    const Gemm g{xb, (const bfr*)(wl + OFF_XQ), M, D, D, D, D, 0, 256L * D}; StaticOrder S; S.init(M, D, G, bx);
                    const pg8::EpiScaleBf16 E{qx, D, 0.0625f * LOG2E, 0, 0, 1.f, stats, false};
                    gemm_phase<pg8::EpiScaleBf16, StaticOrder, true, true>(lds, g, S, E, tid);
                    asm volatile("s_waitcnt vmcnt(0)" ::: "memory"); __builtin_amdgcn_fence(__ATOMIC_RELEASE, "workgroup"); __syncthreads(); __builtin_amdgcn_fence(__ATOMIC_ACQUIRE, "workgroup");
                    const Gemm gs{qx, kmem, M, D, 256, D, D, 256, 256};
                    const pg8::EpiSoftmax Es{Pb, D};
                    gemm_phase<pg8::EpiSoftmax, StaticOrder, false, true>(lds, gs, S, Es, tid);
                    asm volatile("s_waitcnt vmcnt(0)" ::: "memory"); __builtin_amdgcn_fence(__ATOMIC_RELEASE, "workgroup"); __syncthreads(); __builtin_amdgcn_fence(__ATOMIC_ACQUIRE, "workgroup");
                    const Gemm go{Pb, vt, M, D, 256, D, 256, 256, 256L * 256};
                    const pg8::EpiScaleBf16 Eo{ox, D, 1.f, 0, 0, 1.f, nullptr, true};
                    gemm_phase<pg8::EpiScaleBf16, StaticOrder, true, true>(lds, go, S, Eo, tid);
                    { pg8::Unit u0; if (S.next(0, u0)) panel_sync((unsigned*)(ws + WS_PCNT) + (2 * l + 1) * 4096 + 64 * u0.pm); }
                    const Gemm gx{ox, (const bfr*)(wl + OFF_XO), M, D, D, D, D, 0, 256L * D};
                    const pg8::EpiResid Ex{xb, D, stats};
                    gemm_phase<pg8::EpiResid, StaticOrder, true, true>(lds, gx, S, Ex, tid); } PH_END
            }
    }
    { const int l = 0; PH_BEGIN final_phase(xb, out, a.in[20], gw, NGW, lane); PH_END }
#undef PH_BEGIN
#undef PH_END
}

extern "C" void kernel_launch(void* const* d_in, const int* in_sizes, int n_in, void* d_out, int out_size, void* d_ws, size_t ws_size, hipStream_t stream) {
    static int grid = 0;
    if (grid == 0) {
        if (n_in != 21 || out_size != M * D || ws_size < WS_END) { fprintf(stderr, "kernel_launch: unexpected problem (n_in %d, out %d, ws %zu)\n", n_in, out_size, ws_size); grid = -1; return; }
        int dev = 0, cus = 0, per_cu = 0;
        hipGetDevice(&dev); hipDeviceGetAttribute(&cus, hipDeviceAttributeMultiprocessorCount, dev);
        if (hipFuncSetAttribute((const void*)mk_fwd, hipFuncAttributeMaxDynamicSharedMemorySize, LDS_BYTES) != hipSuccess) { fprintf(stderr, "kernel_launch: hipFuncSetAttribute(%d B LDS) failed\n", LDS_BYTES); }
        if (hipOccupancyMaxActiveBlocksPerMultiprocessor(&per_cu, (const void*)mk_fwd, 512, LDS_BYTES) != hipSuccess || per_cu < 1) { fprintf(stderr, "kernel_launch: occupancy query says %d\n", per_cu); per_cu = 1; }
        (void)hipGetLastError();
        grid = cus;
        if (grid != 256) fprintf(stderr, "kernel_launch: %d CUs; built for 256\n", grid);
    }
    if (grid < 0) return;
    Args a{};
    for (int i = 0; i < 21; ++i) a.in[i] = (const float*)d_in[i];
    a.out = (float*)d_out; a.ws = (unsigned char*)d_ws;
#if MK_ONE_LAUNCH
    a.ph_lo = 0; a.ph_hi = NPH;
    if (hipMemsetAsync((char*)d_ws + WS_BAR, 0, 80 * KiB, stream) != hipSuccess) { fprintf(stderr, "kernel_launch: memset of the barrier words failed\n"); return; }
    void* args[] = {&a};
    hipError_t e = hipLaunchCooperativeKernel((const void*)mk_fwd, dim3(grid), dim3(512), args, LDS_BYTES, stream);
    if (e != hipSuccess) fprintf(stderr, "kernel_launch: cooperative launch failed: %s (grid %d)\n", hipGetErrorString(e), grid);
#else
    for (int p = 0; p < NPH; ++p) { a.ph_lo = p; a.ph_hi = p + 1; hipLaunchKernelGGL(mk_fwd, dim3(grid), dim3(512), LDS_BYTES, stream, a); }
#endif
}
```

```cpp
#include <hip/hip_runtime.h>
#include <hip/hip_cooperative_groups.h>
#include <cstdio>
#include <cstdint>
#include <cmath>
typedef unsigned wt_u32x4 __attribute__((ext_vector_type(4)));
__device__ __forceinline__ void store16_wt(void* p, wt_u32x4 v) { asm volatile("global_store_dwordx4 %0, %1, off sc1\n\ts_nop 1" :: "v"(p), "v"(v) : "memory"); }
__device__ __forceinline__ float lane_get(float v, int src_lane) { return __builtin_bit_cast(float, __builtin_amdgcn_ds_bpermute(src_lane << 2, __builtin_bit_cast(int, v))); }
namespace pg8 {
#define PG8_LAS __attribute__((address_space(3)))
typedef unsigned short bf16_t;
typedef short bf16x8 __attribute__((ext_vector_type(8)));
typedef float f32x4 __attribute__((ext_vector_type(4)));
typedef unsigned u32x4 __attribute__((ext_vector_type(4)));
constexpr int BM = 256, BK = 64, HALF = 128, HTB = HALF * BK * 2  , STAGE_BYTES = 8 * HTB, NXCD = 8, WGM = 8;

__host__ __device__ __forceinline__ int lds_byte(int r, int c) { const int st = (r >> 4) * 2 + (c >> 5), rr = r & 15, cc = c & 31, ob = rr * 64 + cc * 2; return st * 1024 + (ob ^ (((ob >> 9) & 1) << 5)); }
__host__ __device__ __forceinline__ void stage_rc(int b, int& R, int& C) { const int st = b / 1024, sb = b % 1024, swz = sb ^ (((sb >> 9) & 1) << 5); R = (st >> 1) * 16 + swz / 64; C = (st & 1) * 32 + (swz % 64) / 2; }
__host__ __device__ __forceinline__ int perm32(int rho) { const int n = rho >> 4, i = rho & 15; return 8 * (i >> 2) + 4 * n + (i & 3); }

struct Unit { int pm, pn; };
struct Gemm { const bf16_t* A; const bf16_t* Bt; int M, N, K; int lda, ldb; long a_pn, b_pn; };

struct StaticOrder {
    int nM, nN, nwg, G, c;
    __host__ __device__ __forceinline__ void init(int M, int N, int G_, int c_) { nM = M / BM; nN = N / BM; nwg = nM * nN; G = G_; c = c_; }
    __host__ __device__ __forceinline__ bool next(int i, Unit& u) const {
        const long L = (long)i * G + c; if (L >= nwg) return false;
        int wgid = (int)L; { const int q = nwg / NXCD, r = nwg % NXCD, xcd = wgid % NXCD, off = wgid / NXCD; wgid = (xcd < r ? xcd * (q + 1) : r * (q + 1) + (xcd - r) * q) + off; }
        const int nig = WGM * nN, gid = wgid / nig, fm = gid * WGM, gsz = (nM - fm) < WGM ? (nM - fm) : WGM;
        u.pm = fm + ((wgid % nig) % gsz); u.pn = (wgid % nig) / gsz; return true;
    }
    __device__ __forceinline__ void a_ready(const Unit&) const {}
    __device__ __forceinline__ void done(const Unit&) const {}
};

__device__ __forceinline__ unsigned cvt_pk_bf16(float lo, float hi) { unsigned r; asm volatile("v_cvt_pk_bf16_f32 %0, %1, %2" : "=v"(r) : "v"(lo), "v"(hi)); return r; }
typedef float f32x2 __attribute__((ext_vector_type(2)));
__device__ __forceinline__ float row_rstd(const float* stats, int row) { const f32x4* sp = (const f32x4*)(stats + (size_t)row * 16); const f32x4 a = sp[0], b = sp[1], c = sp[2], d = sp[3];
    const float s = ((a[0] + a[1]) + (a[2] + a[3])) + ((b[0] + b[1]) + (b[2] + b[3])) + ((c[0] + c[1]) + (c[2] + c[3])) + ((d[0] + d[1]) + (d[2] + d[3])); return rsqrtf(s * (1.0f / 1024.0f) + 1e-6f); }
template <class Sched> __device__ __forceinline__ void fill_rstd_table(PG8_LAS float* rsL, const float* stats, const Sched& S, int tid) {
    Unit u; int n = 0; while (n < 8 && S.next(n, u)) ++n;
    for (int idx = tid; idx < n * 256; idx += 512) { S.next(idx >> 8, u); rsL[idx] = row_rstd(stats, u.pm * BM + (idx & 255)); }
    asm volatile("s_waitcnt lgkmcnt(0)" ::: "memory"); __builtin_amdgcn_s_barrier(); asm volatile("" ::: "memory");
}
struct EpiScaleBf16 {
    static constexpr bool PERM = true, AFTER_DRAIN = false, HAS_INIT = false;
    bf16_t* O; int ldc; float s_all; int pn_lo, pn_hi; float s_rng; const float* stats; bool wt;
    __device__ __forceinline__ void operator()(const f32x4 (&acc)[2][2][4][2], const Unit& u, int wr, int wc, int fr, int fq, int ui) const {
        const int row0 = u.pm * BM + wr * 64 + fr, col0 = u.pn * BM + wc * 32 + 8 * fq;
        const float sc = (u.pn >= pn_lo && u.pn < pn_hi) ? s_rng : s_all;
        float rs[2][4];
#pragma unroll
        for (int ai = 0; ai < 2; ++ai)
#pragma unroll
            for (int m = 0; m < 4; ++m) rs[ai][m] = stats ? row_rstd(stats, row0 + ai * HALF + m * 16) : 1.0f;
#pragma unroll
        for (int ai = 0; ai < 2; ++ai)
#pragma unroll
            for (int m = 0; m < 4; ++m) { bf16_t* rowp = O + (size_t)(row0 + ai * HALF + m * 16) * ldc + col0; const float scr = sc * rs[ai][m];
#pragma unroll
                for (int bj = 0; bj < 2; ++bj) { const f32x4 v0 = acc[ai][bj][m][0] * scr, v1 = acc[ai][bj][m][1] * scr;
                    u32x4 w; w.x = cvt_pk_bf16(v0[0], v0[1]); w.y = cvt_pk_bf16(v0[2], v0[3]); w.z = cvt_pk_bf16(v1[0], v1[1]); w.w = cvt_pk_bf16(v1[2], v1[3]);
                    if (wt) store16_wt(rowp + bj * HALF, w); else *(u32x4*)(rowp + bj * HALF) = w; } }
    }
};
struct EpiMixIn {
    static constexpr bool PERM = true, AFTER_DRAIN = false, HAS_INIT = false;
    bf16_t* O; int ldc; float qscale; float* kpart; const PG8_LAS float* rsL;
    __device__ __forceinline__ void operator()(const f32x4 (&acc)[2][2][4][2], const Unit& u, int wr, int wc, int fr, int fq, int ui) const {
        const int row0 = u.pm * BM + wr * 64 + fr, col0 = u.pn * BM + wc * 32 + 8 * fq;
        const float sc = (u.pn == 6 || u.pn == 7) ? qscale : 1.0f;
        float rs[2][4];
#pragma unroll
        for (int ai = 0; ai < 2; ++ai)
#pragma unroll
            for (int m = 0; m < 4; ++m) rs[ai][m] = rsL[ui * 256 + wr * 64 + fr + ai * HALF + m * 16];
#pragma unroll
        for (int ai = 0; ai < 2; ++ai)
#pragma unroll
            for (int m = 0; m < 4; ++m) { bf16_t* rowp = O + (size_t)(row0 + ai * HALF + m * 16) * ldc + col0; const float scr = sc * rs[ai][m];
#pragma unroll
                for (int bj = 0; bj < 2; ++bj) { const f32x4 v0 = acc[ai][bj][m][0] * scr, v1 = acc[ai][bj][m][1] * scr;
                    u32x4 w; w.x = cvt_pk_bf16(v0[0], v0[1]); w.y = cvt_pk_bf16(v0[2], v0[3]); w.z = cvt_pk_bf16(v1[0], v1[1]); w.w = cvt_pk_bf16(v1[2], v1[3]);
                    store16_wt(rowp + bj * HALF, w); } }
        if (u.pn == 8 || u.pn == 9) { const int lane = fq * 16 + fr;
#pragma unroll
            for (int bj = 0; bj < 2; ++bj) { float mx = 0.f;
#pragma unroll
                for (int ai = 0; ai < 2; ++ai)
#pragma unroll
                    for (int m = 0; m < 4; ++m) { const f32x4 a0 = acc[ai][bj][m][0], a1 = acc[ai][bj][m][1];
                        float p = ((a0[0] * a0[0] + a0[1] * a0[1]) + (a0[2] * a0[2] + a0[3] * a0[3])) + ((a1[0] * a1[0] + a1[1] * a1[1]) + (a1[2] * a1[2] + a1[3] * a1[3]));
                        p *= rs[ai][m] * rs[ai][m]; p += lane_get(p, lane ^ 16); p += lane_get(p, lane ^ 32); mx = fmaxf(mx, p); }
#pragma unroll
                for (int o = 1; o < 16; o <<= 1) mx = fmaxf(mx, lane_get(mx, lane ^ o));
                if (lane == 0) atomicMax((unsigned*)(kpart + ((u.pn - 8) * 4 + 2 * bj + (wc >> 1)) * 2 + (wc & 1)), __float_as_uint(mx)); } }
    }
};
__device__ __forceinline__ f32x4 silu_mul4(f32x4 g, f32x4 u) { const f32x4 t = g * (-1.4426950408889634f); f32x4 e;
    e[0] = __builtin_amdgcn_exp2f(t[0]); e[1] = __builtin_amdgcn_exp2f(t[1]); e[2] = __builtin_amdgcn_exp2f(t[2]); e[3] = __builtin_amdgcn_exp2f(t[3]);
    const f32x4 d = e + 1.0f; f32x4 r; r[0] = __builtin_amdgcn_rcpf(d[0]); r[1] = __builtin_amdgcn_rcpf(d[1]); r[2] = __builtin_amdgcn_rcpf(d[2]); r[3] = __builtin_amdgcn_rcpf(d[3]);
    return (g * r) * u; }
struct EpiSwiglu {
    static constexpr bool PERM = true, AFTER_DRAIN = false, HAS_INIT = false;
    bf16_t* O; int ldc; const PG8_LAS float* rsL;
    __device__ __forceinline__ void operator()(const f32x4 (&acc)[2][2][4][2], const Unit& u, int wr, int wc, int fr, int fq, int ui) const {
        const int row0 = u.pm * BM + wr * 64 + fr, col0 = u.pn * HALF + wc * 32 + 8 * fq; const PG8_LAS float* rsu = rsL + ui * 256 + wr * 64 + fr;
        float rs[2][4];
#pragma unroll
        for (int ai = 0; ai < 2; ++ai)
#pragma unroll
            for (int m = 0; m < 4; ++m) rs[ai][m] = rsu[ai * HALF + m * 16];
#pragma unroll
        for (int ai = 0; ai < 2; ++ai)
#pragma unroll
            for (int m = 0; m < 4; ++m) { bf16_t* rowp = O + (size_t)(row0 + ai * HALF + m * 16) * ldc + col0;
                const float rsv = rs[ai][m];
                const f32x4 g0 = acc[ai][0][m][0] * rsv, g1 = acc[ai][0][m][1] * rsv, u0 = acc[ai][1][m][0] * rsv, u1 = acc[ai][1][m][1] * rsv;
                const f32x4 o0 = silu_mul4(g0, u0), o1 = silu_mul4(g1, u1);
                u32x4 w; w.x = cvt_pk_bf16(o0[0], o0[1]); w.y = cvt_pk_bf16(o0[2], o0[3]); w.z = cvt_pk_bf16(o1[0], o1[1]); w.w = cvt_pk_bf16(o1[2], o1[3]);
                store16_wt(rowp, w); }
    }
};
struct EpiResid {
    static constexpr bool PERM = true, AFTER_DRAIN = false, HAS_INIT = true;
    bf16_t* XB; int ldc; float* stats;
    __device__ __forceinline__ void init(f32x4 (&acc)[2][2][4][2], const Unit& u, int wr, int wc, int fr, int fq) const {
        const bf16_t* const XB = this->XB; const int ldc = this->ldc; const int row0 = u.pm * BM + wr * 64 + fr, col0 = u.pn * BM + wc * 32 + 8 * fq;
        u32x4 raw[2][2][4];
#pragma unroll
        for (int ai = 0; ai < 2; ++ai)
#pragma unroll
            for (int m = 0; m < 4; ++m)
#pragma unroll
                for (int bj = 0; bj < 2; ++bj) raw[ai][bj][m] = *(const u32x4*)(XB + (size_t)(row0 + ai * HALF + m * 16) * ldc + col0 + bj * HALF);
#pragma unroll
        for (int ai = 0; ai < 2; ++ai)
#pragma unroll
            for (int m = 0; m < 4; ++m)
#pragma unroll
                for (int bj = 0; bj < 2; ++bj) { const u32x4 w = raw[ai][bj][m];
                    acc[ai][bj][m][0] = (f32x4){__builtin_bit_cast(float, w.x << 16), __builtin_bit_cast(float, w.x & 0xffff0000u), __builtin_bit_cast(float, w.y << 16), __builtin_bit_cast(float, w.y & 0xffff0000u)};
                    acc[ai][bj][m][1] = (f32x4){__builtin_bit_cast(float, w.z << 16), __builtin_bit_cast(float, w.z & 0xffff0000u), __builtin_bit_cast(float, w.w << 16), __builtin_bit_cast(float, w.w & 0xffff0000u)}; }
    }
    __device__ __forceinline__ void operator()(const f32x4 (&acc)[2][2][4][2], const Unit& u, int wr, int wc, int fr, int fq, int ui) const {
        bf16_t* const XB = this->XB; float* const stats = this->stats; const int ldc = this->ldc;
        const int row0 = u.pm * BM + wr * 64 + fr, col0 = u.pn * BM + wc * 32 + 8 * fq, lane = fq * 16 + fr;
#pragma unroll
        for (int ai = 0; ai < 2; ++ai)
#pragma unroll
            for (int m = 0; m < 4; ++m) { const int row = row0 + ai * HALF + m * 16; bf16_t* rowb = XB + (size_t)row * ldc + col0; float ss = 0.f;
#pragma unroll
                for (int bj = 0; bj < 2; ++bj) { const f32x4 x0 = acc[ai][bj][m][0], x1 = acc[ai][bj][m][1];
                    ss += ((x0[0] * x0[0] + x0[1] * x0[1]) + (x0[2] * x0[2] + x0[3] * x0[3])) + ((x1[0] * x1[0] + x1[1] * x1[1]) + (x1[2] * x1[2] + x1[3] * x1[3]));
                    u32x4 w; w.x = cvt_pk_bf16(x0[0], x0[1]); w.y = cvt_pk_bf16(x0[2], x0[3]); w.z = cvt_pk_bf16(x1[0], x1[1]); w.w = cvt_pk_bf16(x1[2], x1[3]); store16_wt(rowb + bj * HALF, w); }
                ss += lane_get(ss, lane ^ 16); ss += lane_get(ss, lane ^ 32);
                if (fq == 0) __hip_atomic_store((unsigned*)stats + (size_t)row * 16 + u.pn * 4 + wc, __float_as_uint(ss), __ATOMIC_RELAXED, __HIP_MEMORY_SCOPE_AGENT); }
    }
};
struct EpiSoftmax {
    static constexpr bool PERM = true, AFTER_DRAIN = true, HAS_INIT = false;
    bf16_t* O; int ldc;
    __device__ __forceinline__ void fused(f32x4 (&acc)[2][2][4][2], const Unit& u, int wr, int wc, int fr, int fq, PG8_LAS unsigned char* lds, int wid, int lane) const {
        PG8_LAS float* T1 = (PG8_LAS float*)lds;
        PG8_LAS float* T2 = (PG8_LAS float*)(lds + 4096);
#pragma unroll
        for (int ai = 0; ai < 2; ++ai)
#pragma unroll
            for (int m = 0; m < 4; ++m) { float mx = -INFINITY;
#pragma unroll
                for (int bj = 0; bj < 2; ++bj)
#pragma unroll
                    for (int n = 0; n < 2; ++n) { const f32x4 x = acc[ai][bj][m][n]; mx = fmaxf(mx, fmaxf(fmaxf(x[0], x[1]), fmaxf(x[2], x[3]))); }
                mx = fmaxf(mx, lane_get(mx, lane ^ 16)); mx = fmaxf(mx, lane_get(mx, lane ^ 32));
                if (fq == 0) T1[(ai * HALF + wr * 64 + m * 16 + fr) * 4 + wc] = mx; }
        asm volatile("s_waitcnt lgkmcnt(0)" ::: "memory"); __builtin_amdgcn_s_barrier(); asm volatile("" ::: "memory");
#pragma unroll
        for (int ai = 0; ai < 2; ++ai)
#pragma unroll
            for (int m = 0; m < 4; ++m) { const int r = ai * HALF + wr * 64 + m * 16 + fr; const f32x4 t = *(const PG8_LAS f32x4*)(T1 + r * 4);
                const float mx = fmaxf(fmaxf(t[0], t[1]), fmaxf(t[2], t[3])); float s = 0.f;
#pragma unroll
                for (int bj = 0; bj < 2; ++bj)
#pragma unroll
                    for (int n = 0; n < 2; ++n) { f32x4 x = acc[ai][bj][m][n];
                        x[0] = __builtin_amdgcn_exp2f(x[0] - mx); x[1] = __builtin_amdgcn_exp2f(x[1] - mx); x[2] = __builtin_amdgcn_exp2f(x[2] - mx); x[3] = __builtin_amdgcn_exp2f(x[3] - mx);
                        s += (x[0] + x[1]) + (x[2] + x[3]); acc[ai][bj][m][n] = x; }
                s += lane_get(s, lane ^ 16); s += lane_get(s, lane ^ 32);
                if (fq == 0) T2[r * 4 + wc] = s; }
        asm volatile("s_waitcnt lgkmcnt(0)" ::: "memory"); __builtin_amdgcn_s_barrier(); asm volatile("" ::: "memory");
        const int row0 = u.pm * BM + wr * 64 + fr, col0 = u.pn * BM + wc * 32 + 8 * fq;
#pragma unroll
        for (int ai = 0; ai < 2; ++ai)
#pragma unroll
            for (int m = 0; m < 4; ++m) { const int r = ai * HALF + wr * 64 + m * 16 + fr; const f32x4 t = *(const PG8_LAS f32x4*)(T2 + r * 4);
                const float inv = 1.0f / ((t[0] + t[1]) + (t[2] + t[3])); bf16_t* rowp = O + (size_t)(row0 + ai * HALF + m * 16) * ldc + col0;
#pragma unroll
                for (int bj = 0; bj < 2; ++bj) { const f32x4 v0 = acc[ai][bj][m][0] * inv, v1 = acc[ai][bj][m][1] * inv;
                    u32x4 w; w.x = cvt_pk_bf16(v0[0], v0[1]); w.y = cvt_pk_bf16(v0[2], v0[3]); w.z = cvt_pk_bf16(v1[0], v1[1]); w.w = cvt_pk_bf16(v1[2], v1[3]);
                    *(u32x4*)(rowp + bj * HALF) = w; } }
    }
};

template <class Epi, class Sched, bool ALIGN_EPI = false, bool SP2 = false>
__device__ __forceinline__ void gemm_phase(PG8_LAS unsigned char* lds, const Gemm g, const Sched S, const Epi E, const int tid) {
    const int wid = __builtin_amdgcn_readfirstlane(tid >> 6), lane = tid & 63, wr = wid >> 2, wc = wid & 3, fr = lane & 15, fq = lane >> 4;
    const int K = g.K, nt = K / BK;
    unsigned voffA[2], voffB[2];
#pragma unroll
    for (int i = 0; i < 2; ++i) { int R, C; stage_rc(tid * 16 + i * 8192, R, C); const int Rb = Epi::PERM ? ((R & ~31) + perm32(R & 31)) : R;
        voffA[i] = (unsigned)(R * g.lda + C) * 2u; voffB[i] = (unsigned)(Rb * g.ldb + C) * 2u; }
    const size_t kstep = (size_t)(BK * 2);
    const size_t hstepA = (size_t)HALF * g.lda * 2, hstepB = (size_t)HALF * g.ldb * 2;
    const size_t tstepA = 2 * hstepA, apn = (size_t)g.a_pn * 2, bpn = (size_t)g.b_pn * 2;
    const unsigned ldsw = (unsigned)wid * 1024u;
    const int aoff = lds_byte(wr * 64 + fr, fq * 8), boff = lds_byte(wc * 32 + fr, fq * 8);
#define PG8_SA(b, h) (((b) * 2 + (h)) * HTB)
#define PG8_SB(b, h) ((4 + (b) * 2 + (h)) * HTB)
#define PG8_STAGE(bufoff, gbase, voff) do { _Pragma("unroll") for (int _i = 0; _i < 2; ++_i) \
        __builtin_amdgcn_global_load_lds((const unsigned*)((const char*)(gbase) + (voff)[_i]), (PG8_LAS unsigned*)(lds + (bufoff) + ldsw + _i * 8192), 16, 0, 0); } while (0)
#define PG8_LDA(dst, b, h) do { _Pragma("unroll") for (int m = 0; m < 4; ++m) _Pragma("unroll") for (int k = 0; k < 2; ++k) dst[m][k] = *(const PG8_LAS bf16x8*)(lds + PG8_SA(b, h) + aoff + m * 2048 + k * 1024); } while (0)
#define PG8_LDB(dst, b, h) do { _Pragma("unroll") for (int n = 0; n < 2; ++n) _Pragma("unroll") for (int k = 0; k < 2; ++k) dst[n][k] = *(const PG8_LAS bf16x8*)(lds + PG8_SB(b, h) + boff + n * 2048 + k * 1024); } while (0)
#define PG8_MMA(ai, bj, At, Bt) do { __builtin_amdgcn_s_setprio(1); _Pragma("unroll") for (int m = 0; m < 4; ++m) _Pragma("unroll") for (int n = 0; n < 2; ++n) _Pragma("unroll") for (int k = 0; k < 2; ++k) \
        acc[ai][bj][m][n] = __builtin_amdgcn_mfma_f32_16x16x32_bf16(Bt[n][k], At[m][k], acc[ai][bj][m][n], 0, 0, 0); __builtin_amdgcn_s_setprio(0); } while (0)
#define PG8_WAIT_V(n) asm volatile("s_waitcnt vmcnt(" #n ")" ::: "memory")
#define PG8_WAIT_L(n) asm volatile("s_waitcnt lgkmcnt(" #n ")" ::: "memory")
#define PG8_BAR __builtin_amdgcn_s_barrier()
#define PG8_SCHED __builtin_amdgcn_sched_barrier(0)
    Unit cur, nxt; int ui = 0;
    if (!S.next(0, cur)) return;
    f32x4 acc[2][2][4][2];
    if constexpr (Epi::HAS_INIT) E.init(acc, cur, wr, wc, fr, fq);
    else {
#pragma unroll
    for (int a = 0; a < 2; ++a)
#pragma unroll
        for (int b = 0; b < 2; ++b)
#pragma unroll
            for (int m = 0; m < 4; ++m)
#pragma unroll
                for (int n = 0; n < 2; ++n) acc[a][b][m][n] = (f32x4){0.f, 0.f, 0.f, 0.f};
    }
    bf16x8 At[4][2], B0[2][2], B1[2][2];
    const char* cA = (const char*)g.A + (size_t)cur.pm * tstepA + (size_t)cur.pn * apn; const char* cB = (const char*)g.Bt + (size_t)cur.pn * bpn;
    S.a_ready(cur);
    if constexpr (SP2) {
        PG8_STAGE(PG8_SB(0, 0), cB, voffB); PG8_STAGE(PG8_SB(0, 1), cB + hstepB, voffB); PG8_STAGE(PG8_SA(0, 0), cA, voffA); PG8_STAGE(PG8_SA(0, 1), cA + hstepA, voffA);
        if (wr == 1) PG8_BAR;
        PG8_WAIT_V(2); PG8_BAR;
        PG8_STAGE(PG8_SB(1, 0), cB + kstep, voffB); PG8_STAGE(PG8_SA(1, 0), cA + kstep, voffA); PG8_STAGE(PG8_SB(1, 1), cB + hstepB + kstep, voffB);
        PG8_WAIT_V(6); PG8_BAR;
    } else {
        PG8_STAGE(PG8_SB(0, 0), cB, voffB); PG8_STAGE(PG8_SA(0, 0), cA, voffA); PG8_STAGE(PG8_SB(0, 1), cB + hstepB, voffB); PG8_STAGE(PG8_SA(0, 1), cA + hstepA, voffA);
        if (wr == 1) PG8_BAR;
        PG8_WAIT_V(4); PG8_BAR;
        PG8_STAGE(PG8_SB(1, 0), cB + kstep, voffB); PG8_STAGE(PG8_SA(1, 0), cA + kstep, voffA); PG8_STAGE(PG8_SB(1, 1), cB + hstepB + kstep, voffB);
        PG8_WAIT_V(6); PG8_BAR;
    }
    for (;;) {
        const bool has_next = S.next(ui + 1, nxt);
        const char* nA = has_next ? (const char*)g.A + (size_t)nxt.pm * tstepA + (size_t)nxt.pn * apn : cA; const char* nB = has_next ? (const char*)g.Bt + (size_t)nxt.pn * bpn : cB;
        for (int t = 0; t < nt; t += 2) {
            const bool last = (t == nt - 2);
            const char* a1 = cA + (size_t)(t + 1) * kstep;
            const char* a2 = last ? nA : cA + (size_t)(t + 2) * kstep; const char* b2 = last ? nB : cB + (size_t)(t + 2) * kstep;
            const char* a3 = a2 + kstep; const char* b3 = b2 + kstep;
            if (last && has_next) S.a_ready(nxt);
            if constexpr (SP2) {
            PG8_LDB(B0, 0, 0); PG8_LDB(B1, 0, 1); PG8_SCHED; PG8_LDA(At, 0, 0); PG8_STAGE(PG8_SA(1, 1), a1 + hstepA, voffA);
            PG8_WAIT_V(8); PG8_WAIT_L(0); PG8_BAR; PG8_MMA(0, 0, At, B0); PG8_MMA(0, 1, At, B1); PG8_BAR; PG8_SCHED;
            PG8_LDA(At, 0, 1); PG8_STAGE(PG8_SB(0, 0), b2, voffB); PG8_STAGE(PG8_SB(0, 1), b2 + hstepB, voffB); PG8_STAGE(PG8_SA(0, 0), a2, voffA);
            PG8_WAIT_V(8); PG8_WAIT_L(0); PG8_BAR; PG8_MMA(1, 0, At, B0); PG8_MMA(1, 1, At, B1); PG8_BAR; PG8_SCHED;
            PG8_LDB(B0, 1, 0); PG8_LDB(B1, 1, 1); PG8_SCHED; PG8_LDA(At, 1, 0); PG8_STAGE(PG8_SA(0, 1), a2 + hstepA, voffA);
            PG8_WAIT_V(8); PG8_WAIT_L(0); PG8_BAR; PG8_MMA(0, 0, At, B0); PG8_MMA(0, 1, At, B1); PG8_BAR; PG8_SCHED;
            PG8_LDA(At, 1, 1); PG8_STAGE(PG8_SB(1, 0), b3, voffB); PG8_STAGE(PG8_SB(1, 1), b3 + hstepB, voffB); PG8_STAGE(PG8_SA(1, 0), a3, voffA);
            PG8_WAIT_V(8); PG8_WAIT_L(0); PG8_BAR; PG8_MMA(1, 0, At, B0); PG8_MMA(1, 1, At, B1); PG8_BAR; PG8_SCHED;
            } else {
            PG8_LDB(B0, 0, 0); PG8_SCHED; PG8_LDA(At, 0, 0); PG8_STAGE(PG8_SA(1, 1), a1 + hstepA, voffA);
            PG8_WAIT_L(8); PG8_BAR; PG8_WAIT_L(0); PG8_MMA(0, 0, At, B0); PG8_BAR; PG8_SCHED;
            PG8_LDB(B1, 0, 1); PG8_STAGE(PG8_SB(0, 0), b2, voffB);
            PG8_BAR; PG8_WAIT_L(0); PG8_MMA(0, 1, At, B1); PG8_BAR;
            PG8_LDA(At, 0, 1); PG8_STAGE(PG8_SA(0, 0), a2, voffA);
            PG8_BAR; PG8_WAIT_L(0); PG8_MMA(1, 0, At, B0); PG8_BAR; PG8_SCHED;
            PG8_STAGE(PG8_SB(0, 1), b2 + hstepB, voffB);
            PG8_WAIT_V(6); PG8_BAR; PG8_MMA(1, 1, At, B1); PG8_BAR;
            PG8_LDB(B0, 1, 0); PG8_SCHED; PG8_LDA(At, 1, 0); PG8_STAGE(PG8_SA(0, 1), a2 + hstepA, voffA);
            PG8_WAIT_L(8); PG8_BAR; PG8_WAIT_L(0); PG8_MMA(0, 0, At, B0); PG8_BAR; PG8_SCHED;
            PG8_LDB(B1, 1, 1); PG8_STAGE(PG8_SB(1, 0), b3, voffB);
            PG8_BAR; PG8_WAIT_L(0); PG8_MMA(0, 1, At, B1); PG8_BAR;
            PG8_LDA(At, 1, 1); PG8_STAGE(PG8_SA(1, 0), a3, voffA);
            PG8_BAR; PG8_WAIT_L(0); PG8_MMA(1, 0, At, B0); PG8_BAR; PG8_SCHED;
            PG8_STAGE(PG8_SB(1, 1), b3 + hstepB, voffB);
            PG8_WAIT_V(6); PG8_BAR; PG8_MMA(1, 1, At, B1); PG8_BAR;
            }
        }
        if constexpr (ALIGN_EPI) { if (wr == 0) PG8_BAR; }
        if constexpr (!Epi::AFTER_DRAIN) { E(acc, cur, wr, wc, fr, fq, ui); S.done(cur); }
        if (!has_next) break;
        if constexpr (Epi::HAS_INIT) E.init(acc, nxt, wr, wc, fr, fq);
        else {
#pragma unroll
        for (int a = 0; a < 2; ++a)
#pragma unroll
            for (int b = 0; b < 2; ++b)
#pragma unroll
                for (int m = 0; m < 4; ++m)
#pragma unroll
                    for (int n = 0; n < 2; ++n) acc[a][b][m][n] = (f32x4){0.f, 0.f, 0.f, 0.f};
        }
        cur = nxt; cA = nA; cB = nB; ++ui;
        if constexpr (ALIGN_EPI) { if (wr == 1) PG8_BAR; }
    }
    PG8_WAIT_V(0);
    if constexpr (!ALIGN_EPI) { if (wr == 0) PG8_BAR; }
    PG8_BAR;
    if constexpr (Epi::AFTER_DRAIN) { E.fused(acc, cur, wr, wc, fr, fq, lds, wid, lane); S.done(cur); }
#undef PG8_SA
#undef PG8_SB
#undef PG8_STAGE
#undef PG8_LDA
#undef PG8_LDB
#undef PG8_MMA
#undef PG8_WAIT_V
#undef PG8_WAIT_L
#undef PG8_BAR
#undef PG8_SCHED
}
}

#include <hip/hip_bf16.h>
#include <cmath>
namespace attn_body {
using bf16=__hip_bfloat16;
using bf16x8=__attribute__((ext_vector_type(8)))short;
using s16x4=__attribute__((ext_vector_type(4)))short;
using f32x16=__attribute__((ext_vector_type(16)))float;
using u32x4=__attribute__((ext_vector_type(4)))unsigned;
using f32x4v=__attribute__((ext_vector_type(4)))float;
constexpr int BATCH=1,NHEAD=8,SEQ=16384,D=64,DM=3072;
constexpr int NW=8,QBLK=32,QB=QBLK*NW,KVBLK=64,NQB=SEQ/QB;
constexpr int ATTN_PITCH=DM, ATTN_UNIT_ROWS=QB;
__device__ __forceinline__ int crow(int r,int hi){return (r&3)+8*(r>>2)+4*hi;}
#define SBAR() __builtin_amdgcn_sched_barrier(0)
__device__ __forceinline__ void cmask(f32x16&p0,f32x16&p1,int jb,int qrel,int hi){
  const float NEG=-INFINITY; int kb=64*jb+4*hi;
  #pragma unroll
  for(int r=0;r<16;++r){int kv=kb+(r&3)+8*(r>>2); if(kv>qrel)p0[r]=NEG; if(kv+32>qrel)p1[r]=NEG;}
}

constexpr int NSLOT=3, SLOTB=8192;
constexpr int LDS_K=0, LDS_V=NSLOT*SLOTB, LDS_WS=2*NSLOT*SLOTB, LDS_OST=LDS_WS+NW*64*4, LDS_BIAS=LDS_OST+NW*4096, LDS_PRE=LDS_BIAS+SEQ*4, LDS_BYTES=LDS_PRE+1024;
constexpr float C2=0.125f*1.4426950408889634f;
__device__ __forceinline__ void glds16(const void*gsrc,unsigned lds_dst){unsigned keep;
  asm volatile("s_mov_b32 %0, m0\n\ts_mov_b32 m0, %2\n\ts_nop 0\n\tglobal_load_lds_dwordx4 %1, off\n\ts_mov_b32 m0, %0":"=&s"(keep):"v"(gsrc),"s"(lds_dst):"memory");}
__device__ __forceinline__ float max3f(float a,float b,float c){float r;asm("v_max3_f32 %0, %1, %2, %3":"=v"(r):"v"(a),"v"(b),"v"(c));return r;}
__device__ __forceinline__ float max2f(float a,float b){float r;asm("v_max_f32_e32 %0, %1, %2":"=v"(r):"v"(a),"v"(b));return r;}
__device__ __forceinline__ float fadd_s(float a,float b){float r;asm("v_add_f32_e32 %0, %1, %2":"=v"(r):"v"(a),"v"(b));return r;}
__device__ __forceinline__ float fsub_s(float a,float b){float r;asm("v_sub_f32_e32 %0, %1, %2":"=v"(r):"v"(a),"v"(b));return r;}
typedef float f32x2_t __attribute__((ext_vector_type(2))); typedef __bf16 bf16x2_t __attribute__((ext_vector_type(2)));
__device__ __forceinline__ unsigned cvtpk_s(float lo,float hi){f32x2_t v={lo,hi};bf16x2_t b=__builtin_convertvector(v,bf16x2_t);return __builtin_bit_cast(unsigned,b);}
#define WAIT_BAR(N) asm volatile("s_waitcnt vmcnt(" #N ") lgkmcnt(0)\n\ts_barrier":::"memory")

__device__ __forceinline__ void qkt(f32x16&p0,f32x16&p1,const char*Kslot,const bf16x8*qr,int r32,int hi){
  const char*kb=Kslot+hi*1024+r32*16;
  #pragma unroll
  for(int d0=0;d0<4;++d0){
    const bf16x8 b0=*reinterpret_cast<const bf16x8*>(kb+d0*2048);
    const bf16x8 b1=*reinterpret_cast<const bf16x8*>(kb+d0*2048+512);
    {p0=__builtin_amdgcn_mfma_f32_32x32x16_bf16(b0,qr[d0],p0,0,0,0);p1=__builtin_amdgcn_mfma_f32_32x32x16_bf16(b1,qr[d0],p1,0,0,0);}}
}
typedef __attribute__((address_space(3))) const char* lds_cptr;
typedef short v4i16_t __attribute__((ext_vector_type(4)));
__device__ __forceinline__ void kload8(bf16x8*kf,lds_cptr kp){
  kf[0]=*(const __attribute__((address_space(3))) bf16x8*)(kp);      kf[1]=*(const __attribute__((address_space(3))) bf16x8*)(kp+512);
  kf[2]=*(const __attribute__((address_space(3))) bf16x8*)(kp+2048); kf[3]=*(const __attribute__((address_space(3))) bf16x8*)(kp+2560);
  kf[4]=*(const __attribute__((address_space(3))) bf16x8*)(kp+4096); kf[5]=*(const __attribute__((address_space(3))) bf16x8*)(kp+4608);
  kf[6]=*(const __attribute__((address_space(3))) bf16x8*)(kp+6144); kf[7]=*(const __attribute__((address_space(3))) bf16x8*)(kp+6656);
}
__device__ __forceinline__ void kload2(bf16x8*kf,lds_cptr kp,int j){ kf[2*j]=*(const __attribute__((address_space(3))) bf16x8*)(kp+j*2048); kf[2*j+1]=*(const __attribute__((address_space(3))) bf16x8*)(kp+j*2048+512); }
__device__ __forceinline__ s16x4 vtr(lds_cptr p){ return __builtin_bit_cast(s16x4,__builtin_amdgcn_ds_read_tr16_b64_v4i16((__attribute__((address_space(3))) v4i16_t*)p)); }
__device__ __forceinline__ float rowmax(const f32x16&p0,const f32x16&p1){
  float a=max3f(p0[0],p0[1],p1[0]),b=max3f(p0[2],p0[3],p1[1]);a=max3f(a,p1[2],p1[3]);
  #pragma unroll
  for(int r=4;r<16;r+=4){a=max3f(a,p0[r],p0[r+1]);b=max3f(b,p0[r+2],p0[r+3]);a=max3f(a,p1[r],p1[r+1]);b=max3f(b,p1[r+2],p1[r+3]);}
  const float m=max2f(a,b);
  auto rr=__builtin_amdgcn_permlane32_swap(__float_as_uint(m),__float_as_uint(m),false,false);
  return max2f(__uint_as_float(rr[0]),__uint_as_float(rr[1]));
}
__device__ __forceinline__ void pv(f32x16*o,int vb,bf16x8 pa0,bf16x8 pa1,bf16x8 pa2,bf16x8 pa3){
  #pragma unroll
  for(int d0=0;d0<2;++d0){s16x4 lo[4],hi[4];
    #pragma unroll
    for(int ks=0;ks<4;++ks){
      asm volatile("ds_read_b64_tr_b16 %0,%1 offset:%c2":"=&v"(lo[ks]):"v"(vb),"i"(d0*4096+ks*1024):"memory");
      asm volatile("ds_read_b64_tr_b16 %0,%1 offset:%c2":"=&v"(hi[ks]):"v"(vb),"i"(d0*4096+ks*1024+512):"memory");}
    asm volatile("s_waitcnt lgkmcnt(0)":::"memory");SBAR();
    #define PK(k) (bf16x8){lo[k][0],lo[k][1],lo[k][2],lo[k][3],hi[k][0],hi[k][1],hi[k][2],hi[k][3]}
    o[d0]=__builtin_amdgcn_mfma_f32_32x32x16_bf16(pa0,PK(0),o[d0],0,0,0);
    o[d0]=__builtin_amdgcn_mfma_f32_32x32x16_bf16(pa1,PK(1),o[d0],0,0,0);
    o[d0]=__builtin_amdgcn_mfma_f32_32x32x16_bf16(pa2,PK(2),o[d0],0,0,0);
    o[d0]=__builtin_amdgcn_mfma_f32_32x32x16_bf16(pa3,PK(3),o[d0],0,0,0);
    #undef PK
  }
}

#ifndef ATTN_STORE16
#define ATTN_STORE16(p,v) store16_wt((p),(v))
#endif
template<int THRL> __device__ __forceinline__ void attn_unit(int b,int h,int qb,const bf16*Q,const bf16*__restrict__ K,const bf16*__restrict__ V,bf16*O,const float*__restrict__ cl,const float*__restrict__ ctot,const float*__restrict__ kpart,char*shm,const int tid,const int odm){
  const int lane=tid&63,r32=lane&31,hi=lane>>5; const int wid=__builtin_amdgcn_readfirstlane(tid>>6);
  const long rowbase=(long)b*SEQ; const int q0=qb*QB; const int NTF=(q0+QB)/KVBLK;
  const bf16*Qw=Q+(rowbase+q0+wid*QBLK)*DM+h*D;
  const unsigned lds0=(unsigned)(uintptr_t)shm;
  float*wsf=(float*)(shm+LDS_WS)+wid*64;
  const char*Kbase=shm+LDS_K; bf16x8 kf[8];
  const lds_cptr shm3=(lds_cptr)shm; const lds_cptr kp0=shm3+LDS_K+hi*1024+r32*16; const lds_cptr vp0=shm3+LDS_V+((lane>>4)&1)*32+(lane&3)*8+(4*hi+((lane&15)>>2))*64;
  bf16x8 qr[4];
  #pragma unroll
  for(int d0=0;d0<4;++d0)qr[d0]=*reinterpret_cast<const bf16x8*>(&Qw[(long)r32*DM+d0*16+hi*8]);
  typedef __attribute__((address_space(3))) float lds_f; typedef __attribute__((address_space(3))) f32x4v lds_f4;
  lds_f* preL=(lds_f*)(shm3+LDS_PRE); lds_f4* bias4=(lds_f4*)(shm3+LDS_BIAS); lds_f* wsq=(lds_f*)(shm3+LDS_WS);
  int ln_=lane; asm volatile("":"+v"(ln_));
  if(wid==0){ const f32x4v tq=*(const f32x4v*)(ctot+4*lane); const float s0=tq[0],s1=s0+tq[1],s2=s1+tq[2],s3=s2+tq[3]; float inc=s3;
    _Pragma("unroll") for(int of=1;of<64;of<<=1){ const float vv=lane_get(inc,ln_-of); if(ln_>=of)inc+=vv; }
    const float exc=inc-s3; preL[4*lane]=exc; preL[4*lane+1]=exc+s0; preL[4*lane+2]=exc+s1; preL[4*lane+3]=exc+s2; }
  { float qs=0.f;
    _Pragma("unroll") for(int d0=0;d0<4;++d0) _Pragma("unroll") for(int e=0;e<8;++e){ const float qf=__builtin_bit_cast(float,((unsigned)(unsigned short)qr[d0][e])<<16); qs+=qf*qf; }
    { auto rr=__builtin_amdgcn_permlane32_swap(__float_as_uint(qs),__float_as_uint(qs),false,false); qs=__uint_as_float(rr[0])+__uint_as_float(rr[1]); }
    _Pragma("unroll") for(int of=1;of<32;of<<=1) qs=fmaxf(qs,lane_get(qs,ln_^of));
    if(lane==0) wsq[wid*64]=qs; }
  asm volatile("s_waitcnt lgkmcnt(0)\n\ts_barrier":::"memory");
  int t0=0;
  { float qm=0.f; _Pragma("unroll") for(int w=0;w<NW;++w) qm=fmaxf(qm,wsq[w*64]);
    const float km=kpart[2*h]+kpart[2*h+1];
    const float QK=sqrtf(qm*km)*1.02f+0.01f;
    const float thr=-preL[4*qb]*1.4426950408889634f-2.f*QK-40.f;
    for(int base=0;base<NTF-4;base+=64){ const int tau=base+lane; const bool sk=(tau<NTF-4)&&(-preL[tau+1]*1.4426950408889634f<thr); t0+=__builtin_popcountll(__builtin_amdgcn_ballot_w64(sk)); }
    t0=__builtin_amdgcn_readfirstlane(t0)&~1; }
  const int NT=NTF-t0;
  const bf16*Kh=K+(rowbase+(long)t0*KVBLK)*DM+h*D,*Vh=V+(rowbase+(long)t0*KVBLK)*DM+h*D;
  const bf16*ksrc=Kh+(long)lane*DM+wid*8;
  const bf16*vsrc=Vh+(long)(16*(wid&3)+(lane>>2))*DM+(wid>>2)*32+(lane&3)*8;
  const unsigned kdst=lds0+LDS_K+wid*1024, vdst=lds0+LDS_V+wid*1024;
  #define DMA_K(t,slot) glds16(ksrc+(long)(t)*KVBLK*DM,(unsigned)__builtin_amdgcn_readfirstlane(kdst+(slot)))
  #define DMA_V(t,slot) glds16(vsrc+(long)(t)*KVBLK*DM,(unsigned)__builtin_amdgcn_readfirstlane(vdst+(slot)))
  DMA_K(0,0);DMA_V(0,0);DMA_K(1,SLOTB);
  float mhat=0.f,l_reg=0.f;f32x16 o[2];o[0]=f32x16{};o[1]=f32x16{};
  for(int i=tid;i<NT*16;i+=NW*64){ const f32x4v c=*(const f32x4v*)(cl+4*(t0*16+i)); const float pp=preL[t0+(i>>4)]; bias4[i]=(c+pp)*(-1.4426950408889634f); }

  const int qrel=wid*QBLK+r32;
  #define CMASK(P0,P1,t) do{int jb_=(t)-(NT-4); if(jb_>=0)cmask(P0,P1,jb_,qrel,hi);}while(0)
  #define LOADB1(C0,t,o8) do{ const lds_f4* bp_=bias4+(t)*16+hi+(o8); _Pragma("unroll") for(int j_=0;j_<4;++j_){ const f32x4v b0_=bp_[2*j_]; \
      _Pragma("unroll") for(int i_=0;i_<4;++i_){ C0[4*j_+i_]=b0_[i_]-mhat; } } }while(0)
  #define LOADB(C0,C1,t) do{ LOADB1(C0,t,0); LOADB1(C1,t,8); }while(0)
  bool resc=false;
  #define START(P0,P1) do{ const float rm=rowmax(P0,P1); resc=false; \
    { const float dl=rm; mhat=fadd_s(mhat,dl); \
      _Pragma("unroll") for(int r=0;r<16;++r){P0[r]=fsub_s(P0[r],dl);P1[r]=fsub_s(P1[r],dl);} } \
    _Pragma("unroll") for(int r=0;r<16;++r)P0[r]=__builtin_amdgcn_exp2f(P0[r]); }while(0)
  #define RESC() do{ if(resc){ asm volatile("s_waitcnt lgkmcnt(0)":::"memory"); \
      _Pragma("unroll") for(int d_=0;d_<2;++d_) _Pragma("unroll") for(int r=0;r<16;++r)o[d_][r]*=wsf[crow(r,hi)]; } }while(0)
  f32x16 pA0,pA1,pB0,pB1;
  int sl_prev=0,sl_cur=0,sl_next=SLOTB;
  #define ROT() do{sl_prev=sl_cur;sl_cur=sl_next;sl_next=(sl_next==(NSLOT-1)*SLOTB)?0:sl_next+SLOTB;}while(0)
  DMA_K(2,2*SLOTB);
  WAIT_BAR(3);
  LOADB(pA0,pA1,0);
  qkt(pA0,pA1,Kbase,qr,r32,hi);asm volatile("s_nop 15\n\ts_nop 7":"+v"(pA0),"+v"(pA1));CMASK(pA0,pA1,0);
  START(pA0,pA1);
  _Pragma("unroll") for(int r=0;r<16;++r)pA1[r]=__builtin_amdgcn_exp2f(pA1[r]);
  WAIT_BAR(0);
  DMA_K(3,0);DMA_V(1,SLOTB);
  ROT();
  kload8(kf,kp0+sl_cur);
  WAIT_BAR(2);
  s16x4 vlo[8],vhi[8]; u32x4 pw0,pw1,pw2,pw3;
  #define PKW(P,B) cvtpk_s(P[B],P[B+1])
  #define PAF(k) __builtin_bit_cast(bf16x8,pw##k)
  #define VFR(i) (bf16x8){vlo[i][0],vlo[i][1],vlo[i][2],vlo[i][3],vhi[i][0],vhi[i][1],vhi[i][2],vhi[i][3]}
  #define PIN(x) asm volatile("":"+v"(x))
  #define MX3(a,b,c) __builtin_fmaxf(__builtin_fmaxf((a),(b)),(c))
  #define GAPA(MF,A0,A1,A2,A3,W0,W1,PW) do{ MF; sacc+=A0; sacc+=A1; sacc+=A2; sacc+=A3; PIN(sacc); W0; W1; PIN(PW); SBAR(); }while(0)
  #define EX(v) __builtin_amdgcn_exp2f(v)
  #define GAPB(MF,X,B) do{ MF; X[B]=EX(X[B]); X[B+1]=EX(X[B+1]); X[B+2]=EX(X[B+2]); X[B+3]=EX(X[B+3]); PIN(X); SBAR(); }while(0)
  #define VRD(i) do{ vlo[i]=vtr(vp_+(((i)>>2)*4096+((i)&3)*1024)); vhi[i]=vtr(vp_+(((i)>>2)*4096+((i)&3)*1024+512)); }while(0)
  #define KRD(G,j) do{ if(G){ kload2(kf,kp0+sl_next,j); SBAR(); } }while(0)
  #define STEP(C0,C1,P0,P1,t,GK,GV,GL) do{ SBAR(); \
    LOADB1(C0,t,0); SBAR(); \
    const lds_cptr vp_=vp0+sl_prev; \
    VRD(0); SBAR(); float sacc=(P0[0]+P0[1]); \
    GAPA(C0=__builtin_amdgcn_mfma_f32_32x32x16_bf16(kf[0],qr[0],C0,0,0,0), P0[2],P0[3],P0[4],P0[5],     pw0[0]=PKW(P0,0), pw0[1]=PKW(P0,2), pw0); \
    LOADB1(C1,t,8); SBAR(); VRD(4); SBAR(); GAPA(C1=__builtin_amdgcn_mfma_f32_32x32x16_bf16(kf[1],qr[0],C1,0,0,0), P0[6],P0[7],P0[8],P0[9],     pw0[2]=PKW(P0,4), pw0[3]=PKW(P0,6), pw0); \
    VRD(1); SBAR(); GAPA(C0=__builtin_amdgcn_mfma_f32_32x32x16_bf16(kf[2],qr[1],C0,0,0,0),   P0[10],P0[11],P0[12],P0[13], pw1[0]=PKW(P0,8), pw1[1]=PKW(P0,10), pw1); \
    VRD(5); SBAR(); GAPA(C1=__builtin_amdgcn_mfma_f32_32x32x16_bf16(kf[3],qr[1],C1,0,0,0),   P0[14],P0[15],P1[0],P1[1],   pw1[2]=PKW(P0,12),pw1[3]=PKW(P0,14), pw1); \
    VRD(2); SBAR(); GAPA(C0=__builtin_amdgcn_mfma_f32_32x32x16_bf16(kf[4],qr[2],C0,0,0,0),   P1[2],P1[3],P1[4],P1[5],     pw2[0]=PKW(P1,0), pw2[1]=PKW(P1,2), pw2); \
    VRD(6); SBAR(); GAPA(C1=__builtin_amdgcn_mfma_f32_32x32x16_bf16(kf[5],qr[2],C1,0,0,0),   P1[6],P1[7],P1[8],P1[9],     pw2[2]=PKW(P1,4), pw2[3]=PKW(P1,6), pw2); \
    VRD(3); SBAR(); GAPA(C0=__builtin_amdgcn_mfma_f32_32x32x16_bf16(kf[6],qr[3],C0,0,0,0),   P1[10],P1[11],P1[12],P1[13], pw3[0]=PKW(P1,8), pw3[1]=PKW(P1,10), pw3); \
    VRD(7); SBAR(); GAPA(C1=__builtin_amdgcn_mfma_f32_32x32x16_bf16(kf[7],qr[3],C1,0,0,0),   P1[14],P1[15],0.f,0.f,       pw3[2]=PKW(P1,12),pw3[3]=PKW(P1,14), pw3); \
    l_reg+=sacc; \
    if(GK){DMA_K((t)+3,sl_cur);} if(GV){DMA_V((t)+1,sl_next);} \
    CMASK(C0,C1,t); \
    { float a=MX3(C0[0],C0[1],C1[0]),b=MX3(C0[2],C0[3],C1[1]); a=MX3(a,C1[2],C1[3]); \
      _Pragma("unroll") for(int r=4;r<16;r+=4){a=MX3(a,C0[r],C0[r+1]);b=MX3(b,C0[r+2],C0[r+3]);a=MX3(a,C1[r],C1[r+1]);b=MX3(b,C1[r+2],C1[r+3]);} \
      float rm=__builtin_fmaxf(a,b); { auto rr=__builtin_amdgcn_permlane32_swap(__float_as_uint(rm),__float_as_uint(rm),false,false); rm=__builtin_fmaxf(__uint_as_float(rr[0]),__uint_as_float(rr[1])); } \
      resc=false; \
      if(__builtin_expect(__any(rm>(float)THRL),0)){ const float dl=__builtin_fmaxf(rm,0.f); mhat+=dl; \
        _Pragma("unroll") for(int r=0;r<16;++r){C0[r]-=dl;C1[r]-=dl;} \
        const float f=__builtin_amdgcn_exp2f(-dl); l_reg*=f; if(hi==0)wsf[r32]=f; resc=true; } } \
    SBAR(); \
    GAPB(o[0]=__builtin_amdgcn_mfma_f32_32x32x16_bf16(PAF(0),VFR(0),o[0],0,0,0), C0,0); \
    GAPB(o[1]=__builtin_amdgcn_mfma_f32_32x32x16_bf16(PAF(0),VFR(4),o[1],0,0,0), C0,4); \
    KRD(GL,0); GAPB(o[0]=__builtin_amdgcn_mfma_f32_32x32x16_bf16(PAF(1),VFR(1),o[0],0,0,0), C0,8); \
    KRD(GL,1); GAPB(o[1]=__builtin_amdgcn_mfma_f32_32x32x16_bf16(PAF(1),VFR(5),o[1],0,0,0), C0,12); \
    KRD(GL,2); GAPB(o[0]=__builtin_amdgcn_mfma_f32_32x32x16_bf16(PAF(2),VFR(2),o[0],0,0,0), C1,0); \
    KRD(GL,3); GAPB(o[1]=__builtin_amdgcn_mfma_f32_32x32x16_bf16(PAF(2),VFR(6),o[1],0,0,0), C1,4); \
    GAPB(o[0]=__builtin_amdgcn_mfma_f32_32x32x16_bf16(PAF(3),VFR(3),o[0],0,0,0), C1,8); \
    GAPB(o[1]=__builtin_amdgcn_mfma_f32_32x32x16_bf16(PAF(3),VFR(7),o[1],0,0,0), C1,12); \
    }while(0)
  int t=1;
  #undef CMASK
  #define CMASK(P0,P1,t) do{}while(0)
  for(;t+5<NT;t+=2){
    STEP(pB0,pB1,pA0,pA1,t,true,true,true);     WAIT_BAR(2); RESC(); ROT();
    STEP(pA0,pA1,pB0,pB1,t+1,true,true,true);   WAIT_BAR(2); RESC(); ROT();
  }
  #undef CMASK
  #define CMASK(P0,P1,t) do{int jb_=(t)-(NT-4); if(jb_>=0)cmask(P0,P1,jb_,qrel,hi);}while(0)
  #define ENDW(tt) do{ if((tt)+3<NT){WAIT_BAR(2);} else if((tt)+2<NT){WAIT_BAR(1);} else {WAIT_BAR(0);} }while(0)
  for(;t+1<NT;t+=2){
    STEP(pB0,pB1,pA0,pA1,t,(t+3<NT),(t+1<NT),(t+1<NT));       ENDW(t);   RESC(); ROT();
    STEP(pA0,pA1,pB0,pB1,t+1,(t+4<NT),(t+2<NT),(t+2<NT));     ENDW(t+1); RESC(); ROT();
  }
  STEP(pB0,pB1,pA0,pA1,NT-1,false,false,false); RESC();
  { float sacc=pB0[0]+pB0[1]; _Pragma("unroll") for(int r=2;r<16;++r)sacc+=pB0[r]; _Pragma("unroll") for(int r=0;r<16;++r)sacc+=pB1[r]; l_reg+=sacc;
    pw0=(u32x4){PKW(pB0,0),PKW(pB0,2),PKW(pB0,4),PKW(pB0,6)};pw1=(u32x4){PKW(pB0,8),PKW(pB0,10),PKW(pB0,12),PKW(pB0,14)};pw2=(u32x4){PKW(pB1,0),PKW(pB1,2),PKW(pB1,4),PKW(pB1,6)};pw3=(u32x4){PKW(pB1,8),PKW(pB1,10),PKW(pB1,12),PKW(pB1,14)};
    SBAR(); pv(o,(int)(unsigned)(uintptr_t)vp0+sl_cur,PAF(0),PAF(1),PAF(2),PAF(3)); }
  #undef PKW
  #undef PAF
  #undef VFR
  #undef PIN
  #undef MX3
  #undef GAPA
  #undef GAPB
  #undef EX
  #undef VRD
  #undef KRD
  #undef STEP
  #undef ENDW
  {auto rr=__builtin_amdgcn_permlane32_swap(__float_as_uint(l_reg),__float_as_uint(l_reg),false,false);l_reg=__uint_as_float(rr[0])+__uint_as_float(rr[1]);}
  if(hi==0)wsf[32+r32]=l_reg;asm volatile("s_waitcnt lgkmcnt(0)":::"memory");
  float rli[16];
  #pragma unroll
  for(int r=0;r<16;++r)rli[r]=__builtin_amdgcn_rcpf(wsf[32+crow(r,hi)]);
  bf16*Ow=O+(rowbase+q0+wid*QBLK)*(long)odm+h*D;
  { bf16*stg=(bf16*)(shm+LDS_OST)+wid*2048;
    #pragma unroll
    for(int r=0;r<16;++r){const int orow=crow(r,hi);
      #pragma unroll
      for(int d0=0;d0<2;++d0)stg[orow*64+d0*32+r32]=__float2bfloat16(o[d0][r]*rli[r]);}
    asm volatile("s_waitcnt lgkmcnt(0)":::"memory");
    #pragma unroll
    for(int i=0;i<4;++i){const int row=i*8+(lane>>3),ch=lane&7; const u32x4 v=*(const u32x4*)(stg+row*64+ch*8); ATTN_STORE16(Ow+(long)row*odm+ch*8,v);} }
  asm volatile("s_waitcnt lgkmcnt(0)\n\ts_barrier":::"memory");
  #undef DMA_K
  #undef DMA_V
  #undef CMASK
  #undef LOADB
  #undef LOADB1
  #undef START
  #undef RESC
  #undef ROT
}
constexpr int ATTN_LDS_BYTES=LDS_BYTES;
struct AttnTensors { const bf16* Q; const bf16* K; const bf16* V; bf16* O; const float* cl; const float* ctot; const float* kpart; int odm; };
template<int THRL> __device__ __forceinline__ void attn_phase(char*lds,const AttnTensors&T,int G,int vcu,int tid,int hA,int hB){
  constexpr int NP=NHEAD*NQB/2;
  for(int L=vcu;L<2*NP;L+=G){ const int p=L%NP, s=p%(NQB/2), qb=(L<NP)?(NQB-1-s):s, h=(hA>=0)?((L<NP)?hA:hB):((L<NP)?p/(NQB/2):((p/(NQB/2)+NHEAD/2)%NHEAD));
    attn_unit<THRL>(0,h,qb,T.Q,T.K,T.V,T.O,T.cl+(long)h*SEQ,T.ctot+(long)h*(SEQ/64),T.kpart,lds,tid,T.odm); }
}
#undef SBAR
#undef WAIT_BAR
}

namespace cg = cooperative_groups;
#define LAS __attribute__((address_space(3)))
typedef unsigned short bfr;
typedef unsigned v4u __attribute__((ext_vector_type(4)));
typedef float f32x4 __attribute__((ext_vector_type(4)));
constexpr int M = 16384, D = 1024, FF = 2816, NGU = 2 * FF, ZP = 3072, INC = 3080, NMEM = 256, NH = 8, CW = 512, DEPTH = 2;
constexpr float EPS = 1e-6f, LOG2E = 1.4426950408889634f;
constexpr size_t KiB = 1024, MiB = 1u << 20;
constexpr size_t WS_MEMN = 0, WS_KMEM = 512 * KiB, WS_VT = 1024 * KiB, WS_MEMKV_L = 1 * MiB;
constexpr size_t WS_CL = 3 * MiB, WS_CTOT = 3 * MiB + 512 * KiB, WS_WF = 3 * MiB + 768 * KiB, WS_KPART = 3 * MiB + 576 * KiB, WS_BAR = 3 * MiB + 640 * KiB, WS_PCNT = 3 * MiB + 656 * KiB,     WS_STATS = 4 * MiB;
constexpr size_t WS_W = 8 * MiB, W_LAYER = 49 * MiB;
constexpr size_t OFF_GU1 = 0, OFF_D1 = 11 * MiB, OFF_MI = 16 * MiB + 512 * KiB, OFF_MO = 22 * MiB + 512 * KiB, OFF_XQ = 24 * MiB + 512 * KiB, OFF_XKV = 26 * MiB + 512 * KiB,
                 OFF_XO = 30 * MiB + 512 * KiB, OFF_GU2 = 32 * MiB + 512 * KiB, OFF_D2 = 43 * MiB + 512 * KiB;
static_assert(OFF_D2 + (size_t)D * FF * 2 == W_LAYER && OFF_D1 == (size_t)NGU * D * 2, "weight map");
constexpr size_t WS_XB = 106 * MiB, WS_BIG = 138 * MiB, WS_END = 234 * MiB;
constexpr int RSTD_OFF = 139264;
constexpr int LDS_MISC = 155648 - 64;
constexpr int LDS_BYTES = 155648;
static_assert(attn_body::LDS_BYTES <= LDS_MISC && pg8::STAGE_BYTES <= LDS_MISC, "LDS map");
static_assert(attn_body::LDS_BYTES <= LDS_BYTES && pg8::STAGE_BYTES <= LDS_BYTES, "LDS map");

__device__ __forceinline__ float wave_sum(float v, int lane) {
#pragma unroll
    for (int o = 1; o < 64; o <<= 1) v += lane_get(v, lane ^ o);
    return v;
}
__device__ __forceinline__ unsigned f2bf(float f) { unsigned u = __builtin_bit_cast(unsigned, f); return (u + 0x7fffu + ((u >> 16) & 1u)) >> 16; }
__device__ __forceinline__ unsigned pk2(float lo, float hi) { return f2bf(lo) | (f2bf(hi) << 16); }
__device__ __forceinline__ float bf_lo(unsigned u) { return __builtin_bit_cast(float, u << 16); }
__device__ __forceinline__ float bf_hi(unsigned u) { return __builtin_bit_cast(float, u & 0xffff0000u); }

constexpr int TR_SCR_BYTES = 17408;
__device__ __forceinline__ void p0_transpose_item(const float* W, int srcN, int K, int ndst, bfr* WT, LAS float* scr, int item, int lane, const float* g, int mode, float wsc = 1.0f) {
    const int nblk = ndst / 64, kb = item / nblk, nb = item % nblk, k0 = 64 * kb, n0 = 64 * nb;
    int sc = n0; if (mode == 1) { const int tile = n0 >> 8, loc = n0 & 255; sc = (loc < 128) ? (tile * 128 + loc) : (FF + tile * 128 + loc - 128); }
    const float* src = W + (size_t)k0 * srcN + sc + lane;
    float v[64];
#pragma unroll
    for (int kk = 0; kk < 64; ++kk) v[kk] = src[(size_t)kk * srcN];
    if (g) {
#pragma unroll
        for (int kk = 0; kk < 64; ++kk) v[kk] *= g[k0 + kk] * wsc; }
    else if (wsc != 1.0f) {
#pragma unroll
        for (int kk = 0; kk < 64; ++kk) v[kk] *= wsc; }
#pragma unroll
    for (int kk = 0; kk < 64; ++kk) scr[kk * 65 + lane] = v[kk];
    asm volatile("s_waitcnt lgkmcnt(0)" ::: "memory");
    const int c = lane & 7;
#pragma unroll
    for (int j = 0; j < 8; ++j) { const int n = (lane >> 3) + 8 * j; const LAS float* s = scr + (8 * c) * 65 + n;
        v4u o; o.x = pk2(s[0 * 65], s[1 * 65]); o.y = pk2(s[2 * 65], s[3 * 65]); o.z = pk2(s[4 * 65], s[5 * 65]); o.w = pk2(s[6 * 65], s[7 * 65]);
        store16_wt(WT + (size_t)(n0 + n) * K + k0 + 8 * c, o); }
    asm volatile("s_waitcnt lgkmcnt(0)" ::: "memory");
}
struct In { const float* p[21]; };
constexpr int I_GU = (D / 64) * (NGU / 64), I_DN = (FF / 64) * (D / 64), I_MI = (D / 64) * (ZP / 64), I_SQ = (D / 64) * (D / 64), I_KV = (D / 64) * (2 * D / 64);
constexpr int PER_LAYER = 2 * I_GU + 2 * I_DN + I_MI + 3 * I_SQ + I_KV;
__device__ __forceinline__ void convert_mat_item(const In& in, unsigned char* ws, int l, int mat, int r, LAS float* scr, int lane) {
    unsigned char* wl = ws + WS_W + (size_t)l * W_LAYER;
    switch (mat) {
    case 0: p0_transpose_item(in.p[3] + (size_t)l * D * NGU, NGU, D, NGU, (bfr*)(wl + OFF_GU1), scr, r, lane, in.p[2] + l * D, 1); break;
    case 1: p0_transpose_item(in.p[4] + (size_t)l * FF * D, D, FF, D, (bfr*)(wl + OFF_D1), scr, r, lane, nullptr, 0, 0.5f); break;
    case 2: p0_transpose_item(in.p[6] + (size_t)l * D * INC, INC, D, ZP, (bfr*)(wl + OFF_MI), scr, r, lane, in.p[5] + l * D, 0); break;
    case 3: p0_transpose_item(in.p[11] + (size_t)l * D * D, D, D, D, (bfr*)(wl + OFF_MO), scr, r, lane, nullptr, 0); break;
    case 4: p0_transpose_item(in.p[14] + (size_t)l * D * D, D, D, D, (bfr*)(wl + OFF_XQ), scr, r, lane, in.p[12] + l * D, 0); break;
    case 5: p0_transpose_item(in.p[15] + (size_t)l * D * 2 * D, 2 * D, D, 2 * D, (bfr*)(wl + OFF_XKV), scr, r, lane, in.p[13] + l * D, 0); break;
    case 6: p0_transpose_item(in.p[16] + (size_t)l * D * D, D, D, D, (bfr*)(wl + OFF_XO), scr, r, lane, nullptr, 0); break;
    case 7: p0_transpose_item(in.p[18] + (size_t)l * D * NGU, NGU, D, NGU, (bfr*)(wl + OFF_GU2), scr, r, lane, in.p[17] + l * D, 1); break;
    default: p0_transpose_item(in.p[19] + (size_t)l * FF * D, D, FF, D, (bfr*)(wl + OFF_D2), scr, r, lane, nullptr, 0, 0.5f); break;
    }
}
template <int STAGE> __device__ __forceinline__ constexpr int stage_items() {
    return STAGE == 0 ? I_GU + I_KV : STAGE == 1 ? I_DN + I_MI + 3 * I_SQ + I_GU : STAGE == 2 ? 2 * I_DN + I_GU + I_KV : STAGE == 3 ? I_MI + 3 * I_SQ + I_GU : I_DN;
}
#define CV_TRY(L_, MAT_, CNT_) if (k < (CNT_)) { convert_mat_item(in, ws, L_, MAT_, k, scr, lane); return; } k -= (CNT_);
template <int STAGE> __device__ __forceinline__ void convert_stage_item(const In& in, unsigned char* ws, int k, LAS float* scr, int lane) {
    if constexpr (STAGE == 0) { CV_TRY(0, 0, I_GU) CV_TRY(0, 5, I_KV) }
    else if constexpr (STAGE == 1) { CV_TRY(0, 1, I_DN) CV_TRY(0, 2, I_MI) CV_TRY(0, 3, I_SQ) CV_TRY(0, 4, I_SQ) CV_TRY(0, 6, I_SQ) CV_TRY(0, 7, I_GU) }
    else if constexpr (STAGE == 2) { CV_TRY(0, 8, I_DN) CV_TRY(1, 0, I_GU) CV_TRY(1, 5, I_KV) CV_TRY(1, 1, I_DN) }
    else if constexpr (STAGE == 3) { CV_TRY(1, 2, I_MI) CV_TRY(1, 3, I_SQ) CV_TRY(1, 4, I_SQ) CV_TRY(1, 6, I_SQ) CV_TRY(1, 7, I_GU) }
    else { CV_TRY(1, 8, I_DN) }
}
#undef CV_TRY
static_assert(stage_items<0>() + stage_items<1>() + stage_items<2>() + stage_items<3>() + stage_items<4>() == 2 * PER_LAYER, "conversion schedule covers every item once");
template <int STAGE> __device__ __forceinline__ void convert_in_idle_slot(const In& in, unsigned char* ws, LAS unsigned char* lds, int bx, int G, int wave, int lane) {
    constexpr int NU = (M / 256) * (NGU / 256);
    const int r = NU % G, idx = ((r != 0) ? bx - r : bx) - 8, nl = ((r != 0) ? G - r : G) - 8;
    if (idx < 0 || nl <= 0) return;
    LAS float* scr = (LAS float*)(lds + wave * TR_SCR_BYTES);
    for (int it = idx * 8 + wave; it < stage_items<STAGE>(); it += nl * 8) convert_stage_item<STAGE>(in, ws, it, scr, lane);
}
__device__ __forceinline__ void prologue_phase(const In& in, float* out, unsigned char* ws, LAS unsigned char* lds, int gw, int NGW, int wave, int lane) {
    LAS float* scr = (LAS float*)(lds + wave * TR_SCR_BYTES);
    for (int it = gw; it < stage_items<0>(); it += NGW) convert_stage_item<0>(in, ws, it, scr, lane);
    float* wf = (float*)(ws + WS_WF);
    for (int i = gw * 64 + lane; i < DEPTH * NH * D; i += NGW * 64) { const int l = i / (NH * D), h = (i / D) % NH, k = i % D; wf[i] = in.p[5][l * D + k] * in.p[6][((size_t)l * D + k) * INC + ZP + h]; }
    for (int m = gw; m < NMEM; m += NGW) { const f32x4* xr = (const f32x4*)(in.p[1] + (size_t)m * D) + lane; f32x4 v[4]; float s = 0.f;
#pragma unroll
        for (int j = 0; j < 4; ++j) { v[j] = xr[64 * j]; s += (v[j].x * v[j].x + v[j].y * v[j].y) + (v[j].z * v[j].z + v[j].w * v[j].w); }
        const float rstd = rsqrtf(wave_sum(s, lane) * (1.f / D) + EPS); unsigned long long* o8 = (unsigned long long*)((bfr*)(ws + WS_MEMN) + (size_t)m * D) + lane;
#pragma unroll
        for (int j = 0; j < 4; ++j) o8[64 * j] = (unsigned long long)pk2(v[j].x * rstd, v[j].y * rstd) | ((unsigned long long)pk2(v[j].z * rstd, v[j].w * rstd) << 32); }
    for (int m0 = gw; m0 < M; m0 += 4 * NGW) { f32x4 v[4][4]; float s[4];
#pragma unroll
        for (int u = 0; u < 4; ++u) { const int m = m0 + u * NGW; const f32x4* xr = (const f32x4*)(in.p[0] + (size_t)(m < M ? m : m0) * D) + lane;
#pragma unroll
            for (int j = 0; j < 4; ++j) v[u][j] = xr[64 * j]; }
#pragma unroll
        for (int u = 0; u < 4; ++u) { const int m = m0 + u * NGW; s[u] = 0.f; unsigned long long* o8 = (unsigned long long*)((bfr*)(ws + WS_XB) + (size_t)(m < M ? m : m0) * D) + lane;
#pragma unroll
            for (int j = 0; j < 4; ++j) { s[u] += (v[u][j].x * v[u][j].x + v[u][j].y * v[u][j].y) + (v[u][j].z * v[u][j].z + v[u][j].w * v[u][j].w);
                if (m < M) o8[64 * j] = (unsigned long long)pk2(v[u][j].x, v[u][j].y) | ((unsigned long long)pk2(v[u][j].z, v[u][j].w) << 32); } }
#pragma unroll
        for (int o = 1; o < 64; o <<= 1) {
#pragma unroll
            for (int u = 0; u < 4; ++u) s[u] += lane_get(s[u], lane ^ o); }
#pragma unroll
        for (int u = 0; u < 4; ++u) { const int m = m0 + u * NGW; if (m < M && lane < 16) ((float*)(ws + WS_STATS))[(size_t)m * 16 + lane] = lane == 0 ? s[u] : 0.f; } }
}
__device__ __forceinline__ void norm_phase(const float* x, bfr* xb, int gw, int NGW, int lane, float* zero16) {
    if (zero16 && gw == 0 && lane < 16) zero16[lane] = 0.f;
    for (int m = gw; m < M; m += NGW) { const f32x4* xr = (const f32x4*)(x + (size_t)m * D) + lane; f32x4 v[4]; float s = 0.f;
#pragma unroll
        for (int j = 0; j < 4; ++j) { v[j] = xr[64 * j]; s += (v[j].x * v[j].x + v[j].y * v[j].y) + (v[j].z * v[j].z + v[j].w * v[j].w); }
        const float rstd = rsqrtf(wave_sum(s, lane) * (1.f / D) + EPS); unsigned long long* o8 = (unsigned long long*)(xb + (size_t)m * D) + lane;
#pragma unroll
        for (int j = 0; j < 4; ++j) o8[64 * j] = (unsigned long long)pk2(v[j].x * rstd, v[j].y * rstd) | ((unsigned long long)pk2(v[j].z * rstd, v[j].w * rstd) << 32); }
}
__device__ __forceinline__ void final_phase(const bfr* xbs, float* x, const float* g, int gw, int NGW, int lane) {
    const f32x4* gr = (const f32x4*)g + lane; f32x4 gv[4];
#pragma unroll
    for (int j = 0; j < 4; ++j) gv[j] = gr[64 * j];
    for (int m0 = gw; m0 < M; m0 += 4 * NGW) { f32x4 v[4][4]; float s[4];
#pragma unroll
        for (int u = 0; u < 4; ++u) { const int m = m0 + u * NGW; typedef unsigned u32x2 __attribute__((ext_vector_type(2))); const u32x2* xr = (const u32x2*)(xbs + (size_t)(m < M ? m : m0) * D) + lane;
#pragma unroll
            for (int j = 0; j < 4; ++j) { const u32x2 w = xr[64 * j]; v[u][j] = (f32x4){bf_lo(w.x), bf_hi(w.x), bf_lo(w.y), bf_hi(w.y)}; } }
#pragma unroll
        for (int u = 0; u < 4; ++u) { s[u] = 0.f;
#pragma unroll
            for (int j = 0; j < 4; ++j) s[u] += (v[u][j].x * v[u][j].x + v[u][j].y * v[u][j].y) + (v[u][j].z * v[u][j].z + v[u][j].w * v[u][j].w); }
#pragma unroll
        for (int o = 1; o < 64; o <<= 1) {
#pragma unroll
            for (int u = 0; u < 4; ++u) s[u] += lane_get(s[u], lane ^ o); }
#pragma unroll
        for (int u = 0; u < 4; ++u) { const int m = m0 + u * NGW; if (m < M) { const float rstd = rsqrtf(s[u] * (1.f / D) + EPS); f32x4* xr = (f32x4*)(x + (size_t)m * D) + lane;
#pragma unroll
            for (int j = 0; j < 4; ++j) xr[64 * j] = v[u][j] * rstd * gv[j]; } }
    }
}
__device__ __forceinline__ void fgate_phase(const bfr* x, const float* wf, const float* bfg, float* cl, float* ctot, LAS float* scr, int bx, int G, int tid, int lane, int wave) {
    for (int chunk = bx; chunk < M / 64; chunk += G) {
#pragma unroll 1
        for (int j = 0; j < 8; j += 2) { const int row = chunk * 64 + wave * 8 + j; typedef unsigned u32x2 __attribute__((ext_vector_type(2))); const u32x2* xa = (const u32x2*)(x + (size_t)row * D) + lane; const u32x2* xb2 = xa + D / 4; f32x4 va[4], vb[4]; float r[18]; int zo = 0; asm volatile("" : "+v"(zo));
#pragma unroll
            for (int jj = 0; jj < 4; ++jj) { const u32x2 wa = xa[64 * jj], wb = xb2[64 * jj]; va[jj] = (f32x4){bf_lo(wa.x), bf_hi(wa.x), bf_lo(wa.y), bf_hi(wa.y)}; vb[jj] = (f32x4){bf_lo(wb.x), bf_hi(wb.x), bf_lo(wb.y), bf_hi(wb.y)}; }
            r[16] = 0.f; r[17] = 0.f;
#pragma unroll
            for (int jj = 0; jj < 4; ++jj) { r[16] += (va[jj].x * va[jj].x + va[jj].y * va[jj].y) + (va[jj].z * va[jj].z + va[jj].w * va[jj].w); r[17] += (vb[jj].x * vb[jj].x + vb[jj].y * vb[jj].y) + (vb[jj].z * vb[jj].z + vb[jj].w * vb[jj].w); }
#pragma unroll
            for (int h = 0; h < NH; ++h) { const f32x4* wr = (const f32x4*)(wf + h * D) + lane + zo; float da = 0.f, db = 0.f;
#pragma unroll
                for (int jj = 0; jj < 4; ++jj) { const f32x4 w = wr[64 * jj]; da += (va[jj].x * w.x + va[jj].y * w.y) + (va[jj].z * w.z + va[jj].w * w.w); db += (vb[jj].x * w.x + vb[jj].y * w.y) + (vb[jj].z * w.z + vb[jj].w * w.w); }
                r[h] = da; r[8 + h] = db; }
#pragma unroll
            for (int o = 1; o < 64; o <<= 1) {
#pragma unroll
                for (int q = 0; q < 18; ++q) r[q] += lane_get(r[q], lane ^ o); }
            const float rsa = rsqrtf(r[16] * (1.f / D) + EPS), rsb = rsqrtf(r[17] * (1.f / D) + EPS);
            if (lane < 16) { const int h = lane & 7; float dsel = r[0];
#pragma unroll
                for (int q = 1; q < 16; ++q) dsel = (lane == q) ? r[q] : dsel;
                const float zz = dsel * (lane < 8 ? rsa : rsb) + bfg[h]; const float lf = fminf(zz, 0.f) - 0.6931471805599453f * __builtin_amdgcn_logf(1.0f + __builtin_amdgcn_exp2f(-LOG2E * fabsf(zz)));
                scr[(wave * 8 + j + (lane >> 3)) * 8 + h] = lf; } }
        __syncthreads();
        if (tid < NH) { float run = 0.f; for (int r = 0; r < 64; ++r) { run += scr[r * 8 + tid]; cl[(size_t)tid * M + chunk * 64 + r] = run; } ctot[tid * (M / 64) + chunk] = run; }
        __syncthreads();
    }
}
__device__ __forceinline__ void mixnorm_phase(bfr* z, const float* wconv, const float* gc, const float* ga, int p0, int pend, int pstep, int lane) {
    const int c8 = lane * 8; float w0[8], w1[8], w2[8], gcv[8], gav[8];
#pragma unroll
    for (int i = 0; i < 8; ++i) { w0[i] = wconv[c8 + i]; w1[i] = wconv[CW + c8 + i]; w2[i] = wconv[2 * CW + c8 + i]; gcv[i] = gc[c8 + i]; gav[i] = ga[c8 + i]; }
    for (int p = p0; p < pend; p += pstep) { const int r0 = 2 * p; bfr* zr = z + (size_t)r0 * ZP; const v4u z4 = {0u, 0u, 0u, 0u};
        const v4u zbA = *(const v4u*)(zr + c8), zbB = *(const v4u*)(zr + ZP + c8), oA = *(const v4u*)(zr + 3 * CW + c8), oB = *(const v4u*)(zr + ZP + 3 * CW + c8);
        const v4u cc0 = *(const v4u*)(zr + CW + c8), vv0 = *(const v4u*)(zr + 2 * CW + c8), cc1 = *(const v4u*)(zr + ZP + CW + c8), vv1 = *(const v4u*)(zr + ZP + 2 * CW + c8);
        const v4u cm1 = r0 >= 2 ? *(const v4u*)(zr - ZP + CW + c8) : z4, vm1 = r0 >= 2 ? *(const v4u*)(zr - ZP + 2 * CW + c8) : z4;
        const v4u cm2 = r0 >= 2 ? *(const v4u*)(zr - 2 * ZP + CW + c8) : z4, vm2 = r0 >= 2 ? *(const v4u*)(zr - 2 * ZP + 2 * CW + c8) : z4;
        float yA[8], yB[8], pA[8], pB[8]; float s4[4] = {0.f, 0.f, 0.f, 0.f};
#pragma unroll
        for (int q = 0; q < 4; ++q) {
            { const float um2 = bf_lo(cm2[q]) * bf_lo(vm2[q]), um1 = bf_lo(cm1[q]) * bf_lo(vm1[q]), u0 = bf_lo(cc0[q]) * bf_lo(vv0[q]), u1 = bf_lo(cc1[q]) * bf_lo(vv1[q]);
              const float a = bf_lo(zbA[q]) * (w0[2 * q] * um2 + w1[2 * q] * um1 + w2[2 * q] * u0), b = bf_lo(zbB[q]) * (w0[2 * q] * um1 + w1[2 * q] * u0 + w2[2 * q] * u1);
              yA[2 * q] = a; yB[2 * q] = b; s4[0] += a * a; s4[1] += b * b; const float e = bf_lo(oA[q]), f = bf_lo(oB[q]); pA[2 * q] = e; pB[2 * q] = f; s4[2] += e * e; s4[3] += f * f; }
            { const float um2 = bf_hi(cm2[q]) * bf_hi(vm2[q]), um1 = bf_hi(cm1[q]) * bf_hi(vm1[q]), u0 = bf_hi(cc0[q]) * bf_hi(vv0[q]), u1 = bf_hi(cc1[q]) * bf_hi(vv1[q]);
              const float a = bf_hi(zbA[q]) * (w0[2 * q + 1] * um2 + w1[2 * q + 1] * um1 + w2[2 * q + 1] * u0), b = bf_hi(zbB[q]) * (w0[2 * q + 1] * um1 + w1[2 * q + 1] * u0 + w2[2 * q + 1] * u1);
              yA[2 * q + 1] = a; yB[2 * q + 1] = b; s4[0] += a * a; s4[1] += b * b; const float e = bf_hi(oA[q]), f = bf_hi(oB[q]); pA[2 * q + 1] = e; pB[2 * q + 1] = f; s4[2] += e * e; s4[3] += f * f; } }
#pragma unroll
        for (int o = 1; o < 64; o <<= 1) {
#pragma unroll
            for (int u = 0; u < 4; ++u) s4[u] += lane_get(s4[u], lane ^ o); }
        const float rcA = rsqrtf(s4[0] * (1.f / CW) + EPS), rcB = rsqrtf(s4[1] * (1.f / CW) + EPS), raA = rsqrtf(s4[2] * (1.f / CW) + EPS), raB = rsqrtf(s4[3] * (1.f / CW) + EPS);
        v4u ocA, ocB, oaA, oaB;
#pragma unroll
        for (int q = 0; q < 4; ++q) { ocA[q] = pk2(yA[2 * q] * rcA * gcv[2 * q], yA[2 * q + 1] * rcA * gcv[2 * q + 1]); ocB[q] = pk2(yB[2 * q] * rcB * gcv[2 * q], yB[2 * q + 1] * rcB * gcv[2 * q + 1]);
            oaA[q] = pk2(pA[2 * q] * raA * gav[2 * q], pA[2 * q + 1] * raA * gav[2 * q + 1]); oaB[q] = pk2(pB[2 * q] * raB * gav[2 * q], pB[2 * q + 1] * raB * gav[2 * q + 1]); }
        store16_wt(zr + 4 * CW + c8, ocA); store16_wt(zr + 5 * CW + c8, oaA); store16_wt(zr + ZP + 4 * CW + c8, ocB); store16_wt(zr + ZP + 5 * CW + c8, oaB); }
}

#define XB_TMO      128
#define XB_XCNT(j)  (256  + 64 * (j))
#define XB_XSUB(j)  (1280 + 64 * (j))
#define XB_XGEN(j)  (2304 + 64 * (j))
#define XB_TOP      3328
#define XB_TOPGEN   3392
#define XCD_BAR_WORDS 3456
#define XB_SPIN_CAP (1u << 18)

__device__ __forceinline__ unsigned xb_ld(unsigned* p)              { return __hip_atomic_load(p, __ATOMIC_RELAXED, __HIP_MEMORY_SCOPE_AGENT); }
__device__ __forceinline__ unsigned xb_add(unsigned* p, unsigned v) { return __hip_atomic_fetch_add(p, v, __ATOMIC_RELAXED, __HIP_MEMORY_SCOPE_AGENT); }
__device__ __forceinline__ unsigned xb_xcc_id() { return (unsigned)__builtin_amdgcn_s_getreg((3 << 11) | 20) & 0xFu; }
#define XB_SPIN(cond, bar) do { unsigned _sp = 0; while (cond) { __builtin_amdgcn_s_sleep(1); \
    if ((++_sp & 255u) == 0u) { if (xb_ld(&(bar)[XB_TMO])) break; if (_sp > XB_SPIN_CAP) { atomicAdd(&(bar)[XB_TMO], 1u); break; } } } } while (0)

struct XcdBarrier {
    unsigned* bar; unsigned x;
    volatile LAS unsigned* st;
};

__device__ __forceinline__ XcdBarrier xcd_barrier_post(unsigned* bar, volatile LAS unsigned* st) {
    XcdBarrier b; b.bar = bar; b.x = xb_xcc_id(); b.st = st;
    if (threadIdx.x == 0) (void)xb_add(&bar[XB_XCNT(b.x)], 1u);
    return b;
}
__device__ __forceinline__ void xcd_barrier_complete(unsigned* bar, unsigned x, unsigned& nloc, unsigned& nx) {
    const unsigned G = gridDim.x * gridDim.y * gridDim.z;
    unsigned sum, cnt, mine, sp = 0u;
    for (;;) {
        sum = 0u; cnt = 0u; mine = 0u;
#pragma unroll
        for (unsigned j = 0; j < 16; ++j) { const unsigned c = xb_ld(&bar[XB_XCNT(j)]); sum += c; cnt += (c > 0u) ? 1u : 0u; mine = (j == x) ? c : mine; }
        if (sum == G) break;
        __builtin_amdgcn_s_sleep(1);
        if ((++sp & 255u) == 0u) { if (xb_ld(&bar[XB_TMO])) break; if (sp > XB_SPIN_CAP) { atomicAdd(&bar[XB_TMO], 1u); break; } }
    }
    nloc = mine > 0u ? mine : 1u; nx = cnt > 0u ? cnt : 1u;
}

__device__ __forceinline__ void xcd_barrier(const XcdBarrier& b) {
    asm volatile("s_waitcnt vmcnt(0)" ::: "memory");
    __syncthreads();
    if (threadIdx.x == 0) {
        unsigned* bar = b.bar;
        __builtin_amdgcn_s_waitcnt(0);
        unsigned nloc = b.st[0], nx = b.st[1];
        if (nloc == 0u) { xcd_barrier_complete(bar, b.x, nloc, nx); b.st[0] = nloc; b.st[1] = nx; }
        const unsigned old = xb_add(&bar[XB_XSUB(b.x)], 1u);
        const unsigned gen = old / nloc;
        if (old + 1u == (gen + 1u) * nloc) {
            __builtin_amdgcn_fence(__ATOMIC_RELEASE, "agent");
            asm volatile("s_waitcnt vmcnt(0)" ::: "memory");
            const unsigned og = xb_add(&bar[XB_TOP], 1u);
            const unsigned tg = og / nx;
            if (og + 1u == (tg + 1u) * nx) xb_add(&bar[XB_TOPGEN], 1u);
            else XB_SPIN(xb_ld(&bar[XB_TOPGEN]) == tg, bar);
            __builtin_amdgcn_fence(__ATOMIC_ACQUIRE, "agent");
            xb_add(&bar[XB_XGEN(b.x)], 1u);
            asm volatile("s_waitcnt vmcnt(0)" ::: "memory");
        } else {
            XB_SPIN(xb_ld(&bar[XB_XGEN(b.x)]) == gen, bar);
            __builtin_amdgcn_fence(__ATOMIC_ACQUIRE, "agent");
            asm volatile("s_waitcnt vmcnt(0)" ::: "memory");
        }
    }
    __syncthreads();
}

__device__ __forceinline__ int opaque_s(int v, int z) { return __builtin_amdgcn_readfirstlane(v + z); }
template <class T> __device__ __forceinline__ T* opaque_p(T* p, int z) { return (T*)((unsigned char*)p + (size_t)(unsigned)__builtin_amdgcn_readfirstlane(z)); }
__device__ __forceinline__ void panel_sync(unsigned* w) {
    asm volatile("s_waitcnt vmcnt(0)" ::: "memory"); __syncthreads();
    if (threadIdx.x == 0) { __hip_atomic_fetch_add(w, 1u, __ATOMIC_RELAXED, __HIP_MEMORY_SCOPE_AGENT); unsigned sp = 0;
        while (__hip_atomic_load(w, __ATOMIC_RELAXED, __HIP_MEMORY_SCOPE_AGENT) < 4u) { __builtin_amdgcn_s_sleep(1); if (++sp > (1u << 22)) break; }
        __builtin_amdgcn_fence(__ATOMIC_ACQUIRE, "agent"); asm volatile("s_waitcnt vmcnt(0)" ::: "memory"); }
    __syncthreads();
}
struct Args { const float* in[21]; float* out; unsigned char* ws; int ph_lo, ph_hi; };
constexpr int NPH = 1 + DEPTH * 8 + 1;
#ifndef MK_ONE_LAUNCH
#define MK_ONE_LAUNCH 1
#endif
__global__ void __launch_bounds__(512, 2) mk_fwd(Args a) {
    extern __shared__ __attribute__((aligned(16))) unsigned char lds_raw[];
    LAS unsigned char* lds = (LAS unsigned char*)lds_raw;
    const int lo = a.ph_lo, hi = a.ph_hi; int ph = 0;
    if (threadIdx.x < 16) ((LAS unsigned*)(lds + LDS_MISC))[threadIdx.x] = 0u;
    __syncthreads();
    XcdBarrier xbar; xbar.bar = nullptr; xbar.x = 0; xbar.st = nullptr;
    if (hi - lo > 1) xbar = xcd_barrier_post((unsigned*)(a.ws + WS_BAR), (volatile LAS unsigned*)(lds + LDS_MISC));
    if (hi < 0) cg::this_grid().sync();
#define PH_BEGIN if (ph >= lo && ph < hi) { int tid = threadIdx.x, zz_ = 0; asm volatile("" : "+v"(tid), "+v"(zz_)); \
    unsigned char* const ws = opaque_p(a.ws, zz_); float* const out = opaque_p(a.out, zz_); const int G = opaque_s((int)gridDim.x, zz_), bx = opaque_s((int)blockIdx.x, zz_); \
    const int lane = tid & 63, wave = __builtin_amdgcn_readfirstlane(tid >> 6), vcu = (G % 8 == 0) ? (bx % 8) * (G / 8) + bx / 8 : bx, gw = bx * 8 + wave, NGW = G * 8; \
    (void)lane; (void)vcu; (void)gw; (void)NGW; \
    bfr* const xb = (bfr*)(ws + WS_XB); bfr* const big = (bfr*)(ws + WS_BIG); bfr* const memn = (bfr*)(ws + WS_MEMN); \
    bfr* const act = big; bfr* const z = big; bfr* const qx = big; bfr* const Pb = big + (size_t)M * D; bfr* const ox = big + 2 * (size_t)M * D; \
    float* const cl = (float*)(ws + WS_CL); float* const ctot = (float*)(ws + WS_CTOT); float* const stats = (float*)(ws + WS_STATS); (void)stats; \
    const unsigned char* const wl = ws + WS_W + (size_t)l * W_LAYER; bfr* const kmem = (bfr*)(ws + WS_KMEM + (size_t)l * WS_MEMKV_L); bfr* const vt = (bfr*)(ws + WS_VT + (size_t)l * WS_MEMKV_L); \
    (void)xb; (void)memn; (void)act; (void)z; (void)qx; (void)Pb; (void)ox; (void)cl; (void)ctot; (void)wl; (void)kmem; (void)vt;
#define PH_END   if (ph + 1 < hi) xcd_barrier(xbar); } ++ph;
    using pg8::Gemm; using pg8::StaticOrder; using pg8::gemm_phase;

    { const int l = 0; PH_BEGIN { In in;
#pragma unroll
        for (int i = 0; i < 21; ++i) in.p[i] = a.in[i];
        prologue_phase(in, out, ws, lds, gw, NGW, wave, lane); } PH_END }

    { constexpr int l = 0; constexpr int f = 0;
            PH_BEGIN {
                const Gemm g{xb, (const bfr*)(wl + (f ? OFF_GU2 : OFF_GU1)), M, NGU, D, D, D, 0, 256L * D}; StaticOrder S; S.init(M, NGU, G, bx);
                const pg8::EpiSwiglu E{act, FF, (const LAS float*)(lds + RSTD_OFF)}; pg8::fill_rstd_table((LAS float*)(lds + RSTD_OFF), stats, S, tid);
                if (f == 0 && bx == 0 && tid < 16) ((float*)(ws + WS_KPART))[tid] = 0.f;
                gemm_phase<pg8::EpiSwiglu, StaticOrder, true, true>(lds, g, S, E, tid);
                { In in;
#pragma unroll
                    for (int i = 0; i < 21; ++i) in.p[i] = a.in[i];
                    convert_in_idle_slot<1 + 2 * l + f>(in, ws, lds, bx, G, wave, lane); __syncthreads(); }
                if (f == 0) {
                    const Gemm gk{memn, (const bfr*)(wl + OFF_XKV), NMEM, D, D, D, D, 0, 256L * D}; StaticOrder Sk; Sk.init(NMEM, D, G, (bx + G - 128 % G) % G);
                    const pg8::EpiScaleBf16 Ek{kmem, D, 1.f, 0, 0, 1.f, nullptr, true};
                    gemm_phase<pg8::EpiScaleBf16, StaticOrder, true, true>(lds, gk, Sk, Ek, tid);
                    const Gemm gv{(const bfr*)(wl + OFF_XKV) + (size_t)D * D, memn, D, NMEM, D, D, D, 0, 256L * D}; StaticOrder Sv; Sv.init(D, NMEM, G, (bx + G - 132 % G) % G);
                    const pg8::EpiScaleBf16 Ev{vt, NMEM, 1.f, 0, 0, 1.f, nullptr, true};
                    gemm_phase<pg8::EpiScaleBf16, StaticOrder, true, true>(lds, gv, Sv, Ev, tid);
                } } PH_END
            PH_BEGIN {
                const Gemm g{act, (const bfr*)(wl + (f ? OFF_D2 : OFF_D1)), M, D, FF, FF, FF, 0, 256L * FF}; StaticOrder S; S.init(M, D, G, bx);
                const pg8::EpiResid E{xb, D, stats};
                gemm_phase<pg8::EpiResid, StaticOrder, true, true>(lds, g, S, E, tid); } PH_END
            if (f == 0) {
                PH_BEGIN {
                    const Gemm g{xb, (const bfr*)(wl + OFF_MI), M, ZP, D, D, D, 0, 256L * D}; StaticOrder S; S.init(M, ZP, G, bx);
                    const pg8::EpiMixIn E{z, ZP, attn_body::C2, (float*)(ws + WS_KPART), (const LAS float*)(lds + RSTD_OFF)}; pg8::fill_rstd_table((LAS float*)(lds + RSTD_OFF), stats, S, tid);
                    gemm_phase<pg8::EpiMixIn, StaticOrder, true, true>(lds, g, S, E, tid);
                    fgate_phase(xb, (const float*)(ws + WS_WF) + (size_t)l * NH * D, a.in[8] + l * NH, cl, ctot, (LAS float*)lds, bx, G, tid, lane, wave);
                    } PH_END
                PH_BEGIN {
                    const attn_body::AttnTensors AT{(const attn_body::bf16*)(z + 3 * CW), (const attn_body::bf16*)(z + 4 * CW), (const attn_body::bf16*)(z + 5 * CW), (attn_body::bf16*)(z + 3 * CW), cl, ctot, (const float*)(ws + WS_KPART), ZP};
                    int hA = -1, hB = -1;
                    if (G == 256) { const int hs = vcu >> 5; float bv[NH];
#pragma unroll
                        for (int j = 0; j < NH; ++j) bv[j] = __builtin_bit_cast(float, __builtin_amdgcn_readfirstlane(__builtin_bit_cast(int, a.in[8][l * NH + j])));
#pragma unroll
                        for (int j = 0; j < NH; ++j) { int rank = 0;
#pragma unroll
                            for (int k = 0; k < NH; ++k) rank += ((bv[k] < bv[j]) || (bv[k] == bv[j] && k < j)) ? 1 : 0;
                            if (rank == hs) hA = j; if (rank == NH - 1 - hs) hB = j; }
                        hA = __builtin_amdgcn_readfirstlane(hA); hB = __builtin_amdgcn_readfirstlane(hB); }
                    attn_body::attn_phase<32>((char*)lds_raw, AT, G, vcu, tid, hA, hB);
                    } PH_END
                PH_BEGIN {
                    const Gemm g{z + 4 * CW, (const bfr*)(wl + OFF_MO), M, D, D, ZP, D, 0, 256L * D}; StaticOrder S; S.init(M, D, G, bx);
                    { pg8::Unit u0; if (S.next(0, u0)) { const int pb = (u0.pm * 256 + u0.pn * 64) / 2;
                        mixnorm_phase(z, a.in[7] + (size_t)l * 3 * CW, a.in[9] + l * CW, a.in[10] + l * CW, pb + wave, pb + 32, 8, lane);
                        panel_sync((unsigned*)(ws + WS_PCNT) + (2 * l + 0) * 4096 + 64 * u0.pm); } }
                    const pg8::EpiResid E{xb, D, stats};
                    gemm_phase<pg8::EpiResid, StaticOrder, true, true>(lds, g, S, E, tid); } PH_END
                PH_BEGIN {
                    const Gemm g{xb, (const bfr*)(wl + OFF_XQ), M, D, D, D, D, 0, 256L * D}; StaticOrder S; S.init(M, D, G, bx);
                    const pg8::EpiScaleBf16 E{qx, D, 0.0625f * LOG2E, 0, 0, 1.f, stats, false};
                    gemm_phase<pg8::EpiScaleBf16, StaticOrder, true, true>(lds, g, S, E, tid);
                    asm volatile("s_waitcnt vmcnt(0)" ::: "memory"); __syncthreads(); if (tid == 0) { __builtin_amdgcn_fence(__ATOMIC_ACQUIRE, "agent"); asm volatile("s_waitcnt vmcnt(0)" ::: "memory"); } __syncthreads();
                    const Gemm gs{qx, kmem, M, D, 256, D, D, 256, 256};
                    const pg8::EpiSoftmax Es{Pb, D};
                    gemm_phase<pg8::EpiSoftmax, StaticOrder, false, true>(lds, gs, S, Es, tid);
                    asm volatile("s_waitcnt vmcnt(0)" ::: "memory"); __syncthreads(); if (tid == 0) { __builtin_amdgcn_fence(__ATOMIC_ACQUIRE, "agent"); asm volatile("s_waitcnt vmcnt(0)" ::: "memory"); } __syncthreads();
                    const Gemm go{Pb, vt, M, D, 256, D, 256, 256, 256L * 256};
                    const pg8::EpiScaleBf16 Eo{ox, D, 1.f, 0, 0, 1.f, nullptr, true};
                    gemm_phase<pg8::EpiScaleBf16, StaticOrder, true, true>(lds, go, S, Eo, tid);
                    { pg8::Unit u0; if (S.next(0, u0)) panel_sync((unsigned*)(ws + WS_PCNT) + (2 * l + 1) * 4096 + 64 * u0.pm); }
                    const Gemm gx{ox, (const bfr*)(wl + OFF_XO), M, D, D, D, D, 0, 256L * D};
                    const pg8::EpiResid Ex{xb, D, stats};
                    gemm_phase<pg8::EpiResid, StaticOrder, true, true>(lds, gx, S, Ex, tid); } PH_END
            }
    }
    { constexpr int l = 0; constexpr int f = 1;
            PH_BEGIN {
                const Gemm g{xb, (const bfr*)(wl + (f ? OFF_GU2 : OFF_GU1)), M, NGU, D, D, D, 0, 256L * D}; StaticOrder S; S.init(M, NGU, G, bx);
                const pg8::EpiSwiglu E{act, FF, (const LAS float*)(lds + RSTD_OFF)}; pg8::fill_rstd_table((LAS float*)(lds + RSTD_OFF), stats, S, tid);
                if (f == 0 && bx == 0 && tid < 16) ((float*)(ws + WS_KPART))[tid] = 0.f;
                gemm_phase<pg8::EpiSwiglu, StaticOrder, true, true>(lds, g, S, E, tid);
                { In in;
#pragma unroll
                    for (int i = 0; i < 21; ++i) in.p[i] = a.in[i];
                    convert_in_idle_slot<1 + 2 * l + f>(in, ws, lds, bx, G, wave, lane); __syncthreads(); }
                if (f == 0) {
                    const Gemm gk{memn, (const bfr*)(wl + OFF_XKV), NMEM, D, D, D, D, 0, 256L * D}; StaticOrder Sk; Sk.init(NMEM, D, G, (bx + G - 128 % G) % G);
                    const pg8::EpiScaleBf16 Ek{kmem, D, 1.f, 0, 0, 1.f, nullptr, true};
                    gemm_phase<pg8::EpiScaleBf16, StaticOrder, true, true>(lds, gk, Sk, Ek, tid);
                    const Gemm gv{(const bfr*)(wl + OFF_XKV) + (size_t)D * D, memn, D, NMEM, D, D, D, 0, 256L * D}; StaticOrder Sv; Sv.init(D, NMEM, G, (bx + G - 132 % G) % G);
                    const pg8::EpiScaleBf16 Ev{vt, NMEM, 1.f, 0, 0, 1.f, nullptr, true};
                    gemm_phase<pg8::EpiScaleBf16, StaticOrder, true, true>(lds, gv, Sv, Ev, tid);
                } } PH_END
            PH_BEGIN {
                const Gemm g{act, (const bfr*)(wl + (f ? OFF_D2 : OFF_D1)), M, D, FF, FF, FF, 0, 256L * FF}; StaticOrder S; S.init(M, D, G, bx);
                const pg8::EpiResid E{xb, D, stats};
                gemm_phase<pg8::EpiResid, StaticOrder, true, true>(lds, g, S, E, tid); } PH_END
            if (f == 0) {
                PH_BEGIN {
                    const Gemm g{xb, (const bfr*)(wl + OFF_MI), M, ZP, D, D, D, 0, 256L * D}; StaticOrder S; S.init(M, ZP, G, bx);
                    const pg8::EpiMixIn E{z, ZP, attn_body::C2, (float*)(ws + WS_KPART), (const LAS float*)(lds + RSTD_OFF)}; pg8::fill_rstd_table((LAS float*)(lds + RSTD_OFF), stats, S, tid);
                    gemm_phase<pg8::EpiMixIn, StaticOrder, true, true>(lds, g, S, E, tid);
                    fgate_phase(xb, (const float*)(ws + WS_WF) + (size_t)l * NH * D, a.in[8] + l * NH, cl, ctot, (LAS float*)lds, bx, G, tid, lane, wave);
                    } PH_END
                PH_BEGIN {
                    const attn_body::AttnTensors AT{(const attn_body::bf16*)(z + 3 * CW), (const attn_body::bf16*)(z + 4 * CW), (const attn_body::bf16*)(z + 5 * CW), (attn_body::bf16*)(z + 3 * CW), cl, ctot, (const float*)(ws + WS_KPART), ZP};
                    int hA = -1, hB = -1;
                    if (G == 256) { const int hs = vcu >> 5; float bv[NH];
#pragma unroll
                        for (int j = 0; j < NH; ++j) bv[j] = __builtin_bit_cast(float, __builtin_amdgcn_readfirstlane(__builtin_bit_cast(int, a.in[8][l * NH + j])));
#pragma unroll
                        for (int j = 0; j < NH; ++j) { int rank = 0;
#pragma unroll
                            for (int k = 0; k < NH; ++k) rank += ((bv[k] < bv[j]) || (bv[k] == bv[j] && k < j)) ? 1 : 0;
                            if (rank == hs) hA = j; if (rank == NH - 1 - hs) hB = j; }
                        hA = __builtin_amdgcn_readfirstlane(hA); hB = __builtin_amdgcn_readfirstlane(hB); }
                    attn_body::attn_phase<32>((char*)lds_raw, AT, G, vcu, tid, hA, hB);
                    } PH_END
                PH_BEGIN {
                    const Gemm g{z + 4 * CW, (const bfr*)(wl + OFF_MO), M, D, D, ZP, D, 0, 256L * D}; StaticOrder S; S.init(M, D, G, bx);
                    { pg8::Unit u0; if (S.next(0, u0)) { const int pb = (u0.pm * 256 + u0.pn * 64) / 2;
                        mixnorm_phase(z, a.in[7] + (size_t)l * 3 * CW, a.in[9] + l * CW, a.in[10] + l * CW, pb + wave, pb + 32, 8, lane);
                        panel_sync((unsigned*)(ws + WS_PCNT) + (2 * l + 0) * 4096 + 64 * u0.pm); } }
                    const pg8::EpiResid E{xb, D, stats};
                    gemm_phase<pg8::EpiResid, StaticOrder, true, true>(lds, g, S, E, tid); } PH_END
                PH_BEGIN {
                    const Gemm g{xb, (const bfr*)(wl + OFF_XQ), M, D, D, D, D, 0, 256L * D}; StaticOrder S; S.init(M, D, G, bx);
                    const pg8::EpiScaleBf16 E{qx, D, 0.0625f * LOG2E, 0, 0, 1.f, stats, false};
                    gemm_phase<pg8::EpiScaleBf16, StaticOrder, true, true>(lds, g, S, E, tid);
                    asm volatile("s_waitcnt vmcnt(0)" ::: "memory"); __syncthreads(); if (tid == 0) { __builtin_amdgcn_fence(__ATOMIC_ACQUIRE, "agent"); asm volatile("s_waitcnt vmcnt(0)" ::: "memory"); } __syncthreads();
                    const Gemm gs{qx, kmem, M, D, 256, D, D, 256, 256};
                    const pg8::EpiSoftmax Es{Pb, D};
                    gemm_phase<pg8::EpiSoftmax, StaticOrder, false, true>(lds, gs, S, Es, tid);
                    asm volatile("s_waitcnt vmcnt(0)" ::: "memory"); __syncthreads(); if (tid == 0) { __builtin_amdgcn_fence(__ATOMIC_ACQUIRE, "agent"); asm volatile("s_waitcnt vmcnt(0)" ::: "memory"); } __syncthreads();
                    const Gemm go{Pb, vt, M, D, 256, D, 256, 256, 256L * 256};
                    const pg8::EpiScaleBf16 Eo{ox, D, 1.f, 0, 0, 1.f, nullptr, true};
                    gemm_phase<pg8::EpiScaleBf16, StaticOrder, true, true>(lds, go, S, Eo, tid);
                    { pg8::Unit u0; if (S.next(0, u0)) panel_sync((unsigned*)(ws + WS_PCNT) + (2 * l + 1) * 4096 + 64 * u0.pm); }
                    const Gemm gx{ox, (const bfr*)(wl + OFF_XO), M, D, D, D, D, 0, 256L * D};
                    const pg8::EpiResid Ex{xb, D, stats};
                    gemm_phase<pg8::EpiResid, StaticOrder, true, true>(lds, gx, S, Ex, tid); } PH_END
            }
    }
    { constexpr int l = 1; constexpr int f = 0;
            PH_BEGIN {
                const Gemm g{xb, (const bfr*)(wl + (f ? OFF_GU2 : OFF_GU1)), M, NGU, D, D, D, 0, 256L * D}; StaticOrder S; S.init(M, NGU, G, bx);
                const pg8::EpiSwiglu E{act, FF, (const LAS float*)(lds + RSTD_OFF)}; pg8::fill_rstd_table((LAS float*)(lds + RSTD_OFF), stats, S, tid);
                if (f == 0 && bx == 0 && tid < 16) ((float*)(ws + WS_KPART))[tid] = 0.f;
                gemm_phase<pg8::EpiSwiglu, StaticOrder, true, true>(lds, g, S, E, tid);
                { In in;
#pragma unroll
                    for (int i = 0; i < 21; ++i) in.p[i] = a.in[i];
                    convert_in_idle_slot<1 + 2 * l + f>(in, ws, lds, bx, G, wave, lane); __syncthreads(); }
                if (f == 0) {
                    const Gemm gk{memn, (const bfr*)(wl + OFF_XKV), NMEM, D, D, D, D, 0, 256L * D}; StaticOrder Sk; Sk.init(NMEM, D, G, (bx + G - 128 % G) % G);
                    const pg8::EpiScaleBf16 Ek{kmem, D, 1.f, 0, 0, 1.f, nullptr, true};
                    gemm_phase<pg8::EpiScaleBf16, StaticOrder, true, true>(lds, gk, Sk, Ek, tid);
                    const Gemm gv{(const bfr*)(wl + OFF_XKV) + (size_t)D * D, memn, D, NMEM, D, D, D, 0, 256L * D}; StaticOrder Sv; Sv.init(D, NMEM, G, (bx + G - 132 % G) % G);
                    const pg8::EpiScaleBf16 Ev{vt, NMEM, 1.f, 0, 0, 1.f, nullptr, true};
                    gemm_phase<pg8::EpiScaleBf16, StaticOrder, true, true>(lds, gv, Sv, Ev, tid);
                } } PH_END
            PH_BEGIN {
                const Gemm g{act, (const bfr*)(wl + (f ? OFF_D2 : OFF_D1)), M, D, FF, FF, FF, 0, 256L * FF}; StaticOrder S; S.init(M, D, G, bx);
                const pg8::EpiResid E{xb, D, stats};
                gemm_phase<pg8::EpiResid, StaticOrder, true, true>(lds, g, S, E, tid); } PH_END
            if (f == 0) {
                PH_BEGIN {
                    const Gemm g{xb, (const bfr*)(wl + OFF_MI), M, ZP, D, D, D, 0, 256L * D}; StaticOrder S; S.init(M, ZP, G, bx);
                    const pg8::EpiMixIn E{z, ZP, attn_body::C2, (float*)(ws + WS_KPART), (const LAS float*)(lds + RSTD_OFF)}; pg8::fill_rstd_table((LAS float*)(lds + RSTD_OFF), stats, S, tid);
                    gemm_phase<pg8::EpiMixIn, StaticOrder, true, true>(lds, g, S, E, tid);
                    fgate_phase(xb, (const float*)(ws + WS_WF) + (size_t)l * NH * D, a.in[8] + l * NH, cl, ctot, (LAS float*)lds, bx, G, tid, lane, wave);
                    } PH_END
                PH_BEGIN {
                    const attn_body::AttnTensors AT{(const attn_body::bf16*)(z + 3 * CW), (const attn_body::bf16*)(z + 4 * CW), (const attn_body::bf16*)(z + 5 * CW), (attn_body::bf16*)(z + 3 * CW), cl, ctot, (const float*)(ws + WS_KPART), ZP};
                    int hA = -1, hB = -1;
                    if (G == 256) { const int hs = vcu >> 5; float bv[NH];
#pragma unroll
                        for (int j = 0; j < NH; ++j) bv[j] = __builtin_bit_cast(float, __builtin_amdgcn_readfirstlane(__builtin_bit_cast(int, a.in[8][l * NH + j])));
#pragma unroll
                        for (int j = 0; j < NH; ++j) { int rank = 0;
#pragma unroll
                            for (int k = 0; k < NH; ++k) rank += ((bv[k] < bv[j]) || (bv[k] == bv[j] && k < j)) ? 1 : 0;
                            if (rank == hs) hA = j; if (rank == NH - 1 - hs) hB = j; }
                        hA = __builtin_amdgcn_readfirstlane(hA); hB = __builtin_amdgcn_readfirstlane(hB); }
                    attn_body::attn_phase<32>((char*)lds_raw, AT, G, vcu, tid, hA, hB);
                    } PH_END
                PH_BEGIN {
                    const Gemm g{z + 4 * CW, (const bfr*)(wl + OFF_MO), M, D, D, ZP, D, 0, 256L * D}; StaticOrder S; S.init(M, D, G, bx);
                    { pg8::Unit u0; if (S.next(0, u0)) { const int pb = (u0.pm * 256 + u0.pn * 64) / 2;
                        mixnorm_phase(z, a.in[7] + (size_t)l * 3 * CW, a.in[9] + l * CW, a.in[10] + l * CW, pb + wave, pb + 32, 8, lane);
                        panel_sync((unsigned*)(ws + WS_PCNT) + (2 * l + 0) * 4096 + 64 * u0.pm); } }
                    const pg8::EpiResid E{xb, D, stats};
                    gemm_phase<pg8::EpiResid, StaticOrder, true, true>(lds, g, S, E, tid); } PH_END
                PH_BEGIN {
                    const Gemm g{xb, (const bfr*)(wl + OFF_XQ), M, D, D, D, D, 0, 256L * D}; StaticOrder S; S.init(M, D, G, bx);
                    const pg8::EpiScaleBf16 E{qx, D, 0.0625f * LOG2E, 0, 0, 1.f, stats, false};
                    gemm_phase<pg8::EpiScaleBf16, StaticOrder, true, true>(lds, g, S, E, tid);
                    asm volatile("s_waitcnt vmcnt(0)" ::: "memory"); __syncthreads(); if (tid == 0) { __builtin_amdgcn_fence(__ATOMIC_ACQUIRE, "agent"); asm volatile("s_waitcnt vmcnt(0)" ::: "memory"); } __syncthreads();
                    const Gemm gs{qx, kmem, M, D, 256, D, D, 256, 256};
                    const pg8::EpiSoftmax Es{Pb, D};
                    gemm_phase<pg8::EpiSoftmax, StaticOrder, false, true>(lds, gs, S, Es, tid);
                    asm volatile("s_waitcnt vmcnt(0)" ::: "memory"); __syncthreads(); if (tid == 0) { __builtin_amdgcn_fence(__ATOMIC_ACQUIRE, "agent"); asm volatile("s_waitcnt vmcnt(0)" ::: "memory"); } __syncthreads();
                    const Gemm go{Pb, vt, M, D, 256, D, 256, 256, 256L * 256};
                    const pg8::EpiScaleBf16 Eo{ox, D, 1.f, 0, 0, 1.f, nullptr, true};
                    gemm_phase<pg8::EpiScaleBf16, StaticOrder, true, true>(lds, go, S, Eo, tid);
                    { pg8::Unit u0; if (S.next(0, u0)) panel_sync((unsigned*)(ws + WS_PCNT) + (2 * l + 1) * 4096 + 64 * u0.pm); }
                    const Gemm gx{ox, (const bfr*)(wl + OFF_XO), M, D, D, D, D, 0, 256L * D};
                    const pg8::EpiResid Ex{xb, D, stats};
                    gemm_phase<pg8::EpiResid, StaticOrder, true, true>(lds, gx, S, Ex, tid); } PH_END
            }
    }
    { constexpr int l = 1; constexpr int f = 1;
            PH_BEGIN {
                const Gemm g{xb, (const bfr*)(wl + (f ? OFF_GU2 : OFF_GU1)), M, NGU, D, D, D, 0, 256L * D}; StaticOrder S; S.init(M, NGU, G, bx);
                const pg8::EpiSwiglu E{act, FF, (const LAS float*)(lds + RSTD_OFF)}; pg8::fill_rstd_table((LAS float*)(lds + RSTD_OFF), stats, S, tid);
                if (f == 0 && bx == 0 && tid < 16) ((float*)(ws + WS_KPART))[tid] = 0.f;
                gemm_phase<pg8::EpiSwiglu, StaticOrder, true, true>(lds, g, S, E, tid);
                { In in;
#pragma unroll
                    for (int i = 0; i < 21; ++i) in.p[i] = a.in[i];
                    convert_in_idle_slot<1 + 2 * l + f>(in, ws, lds, bx, G, wave, lane); __syncthreads(); }
                if (f == 0) {
                    const Gemm gk{memn, (const bfr*)(wl + OFF_XKV), NMEM, D, D, D, D, 0, 256L * D}; StaticOrder Sk; Sk.init(NMEM, D, G, (bx + G - 128 % G) % G);
                    const pg8::EpiScaleBf16 Ek{kmem, D, 1.f, 0, 0, 1.f, nullptr, true};
                    gemm_phase<pg8::EpiScaleBf16, StaticOrder, true, true>(lds, gk, Sk, Ek, tid);
                    const Gemm gv{(const bfr*)(wl + OFF_XKV) + (size_t)D * D, memn, D, NMEM, D, D, D, 0, 256L * D}; StaticOrder Sv; Sv.init(D, NMEM, G, (bx + G - 132 % G) % G);
                    const pg8::EpiScaleBf16 Ev{vt, NMEM, 1.f, 0, 0, 1.f, nullptr, true};
                    gemm_phase<pg8::EpiScaleBf16, StaticOrder, true, true>(lds, gv, Sv, Ev, tid);
                } } PH_END
            PH_BEGIN {
                const Gemm g{act, (const bfr*)(wl + (f ? OFF_D2 : OFF_D1)), M, D, FF, FF, FF, 0, 256L * FF}; StaticOrder S; S.init(M, D, G, bx);
                const pg8::EpiResid E{xb, D, stats};
                gemm_phase<pg8::EpiResid, StaticOrder, true, true>(lds, g, S, E, tid); } PH_END
            if (f == 0) {
                PH_BEGIN {
                    const Gemm g{xb, (const bfr*)(wl + OFF_MI), M, ZP, D, D, D, 0, 256L * D}; StaticOrder S; S.init(M, ZP, G, bx);
                    const pg8::EpiMixIn E{z, ZP, attn_body::C2, (float*)(ws + WS_KPART), (const LAS float*)(lds + RSTD_OFF)}; pg8::fill_rstd_table((LAS float*)(lds + RSTD_OFF), stats, S, tid);
                    gemm_phase<pg8::EpiMixIn, StaticOrder, true, true>(lds, g, S, E, tid);
                    fgate_phase(xb, (const float*)(ws + WS_WF) + (size_t)l * NH * D, a.in[8] + l * NH, cl, ctot, (LAS float*)lds, bx, G, tid, lane, wave);
                    } PH_END
                PH_BEGIN {
                    const attn_body::AttnTensors AT{(const attn_body::bf16*)(z + 3 * CW), (const attn_body::bf16*)(z + 4 * CW), (const attn_body::bf16*)(z + 5 * CW), (attn_body::bf16*)(z + 3 * CW), cl, ctot, (const float*)(ws + WS_KPART), ZP};
                    int hA = -1, hB = -1;
                    if (G == 256) { const int hs = vcu >> 5; float bv[NH];
#pragma unroll
                        for (int j = 0; j < NH; ++j) bv[j] = __builtin_bit_cast(float, __builtin_amdgcn_readfirstlane(__builtin_bit_cast(int, a.in[8][l * NH + j])));
#pragma unroll
                        for (int j = 0; j < NH; ++j) { int rank = 0;
#pragma unroll
                            for (int k = 0; k < NH; ++k) rank += ((bv[k] < bv[j]) || (bv[k] == bv[j] && k < j)) ? 1 : 0;
                            if (rank == hs) hA = j; if (rank == NH - 1 - hs) hB = j; }
                        hA = __builtin_amdgcn_readfirstlane(hA); hB = __builtin_amdgcn_readfirstlane(hB); }
                    attn_body::attn_phase<32>((char*)lds_raw, AT, G, vcu, tid, hA, hB);
                    } PH_END
                PH_BEGIN {
                    const Gemm g{z + 4 * CW, (const bfr*)(wl + OFF_MO), M, D, D, ZP, D, 0, 256L * D}; StaticOrder S; S.init(M, D, G, bx);
                    { pg8::Unit u0; if (S.next(0, u0)) { const int pb = (u0.pm * 256 + u0.pn * 64) / 2;
                        mixnorm_phase(z, a.in[7] + (size_t)l * 3 * CW, a.in[9] + l * CW, a.in[10] + l * CW, pb + wave, pb + 32, 8, lane);
                        panel_sync((unsigned*)(ws + WS_PCNT) + (2 * l + 0) * 4096 + 64 * u0.pm); } }
                    const pg8::EpiResid E{xb, D, stats};
                    gemm_phase<pg8::EpiResid, StaticOrder, true, true>(lds, g, S, E, tid); } PH_END
                PH_BEGIN {
                    const Gemm g{xb, (const bfr*)(wl + OFF_XQ), M, D, D, D, D, 0, 256L * D}; StaticOrder S; S.init(M, D, G, bx);
                    const pg8::EpiScaleBf16 E{qx, D, 0.0625f * LOG2E, 0, 0, 1.f, stats, false};
                    gemm_phase<pg8::EpiScaleBf16, StaticOrder, true, true>(lds, g, S, E, tid);
                    asm volatile("s_waitcnt vmcnt(0)" ::: "memory"); __syncthreads(); if (tid == 0) { __builtin_amdgcn_fence(__ATOMIC_ACQUIRE, "agent"); asm volatile("s_waitcnt vmcnt(0)" ::: "memory"); } __syncthreads();
                    const Gemm gs{qx, kmem, M, D, 256, D, D, 256, 256};
                    const pg8::EpiSoftmax Es{Pb, D};
                    gemm_phase<pg8::EpiSoftmax, StaticOrder, false, true>(lds, gs, S, Es, tid);
                    asm volatile("s_waitcnt vmcnt(0)" ::: "memory"); __syncthreads(); if (tid == 0) { __builtin_amdgcn_fence(__ATOMIC_ACQUIRE, "agent"); asm volatile("s_waitcnt vmcnt(0)" ::: "memory"); } __syncthreads();
                    const Gemm go{Pb, vt, M, D, 256, D, 256, 256, 256L * 256};
                    const pg8::EpiScaleBf16 Eo{ox, D, 1.f, 0, 0, 1.f, nullptr, true};
                    gemm_phase<pg8::EpiScaleBf16, StaticOrder, true, true>(lds, go, S, Eo, tid);
                    { pg8::Unit u0; if (S.next(0, u0)) panel_sync((unsigned*)(ws + WS_PCNT) + (2 * l + 1) * 4096 + 64 * u0.pm); }
                    const Gemm gx{ox, (const bfr*)(wl + OFF_XO), M, D, D, D, D, 0, 256L * D};
                    const pg8::EpiResid Ex{xb, D, stats};
                    gemm_phase<pg8::EpiResid, StaticOrder, true, true>(lds, gx, S, Ex, tid); } PH_END
            }
    }
    { const int l = 0; PH_BEGIN final_phase(xb, out, a.in[20], gw, NGW, lane); PH_END }
#undef PH_BEGIN
#undef PH_END
}

extern "C" void kernel_launch(void* const* d_in, const int* in_sizes, int n_in, void* d_out, int out_size, void* d_ws, size_t ws_size, hipStream_t stream) {
    static int grid = 0;
    if (grid == 0) {
        if (n_in != 21 || out_size != M * D || ws_size < WS_END) { fprintf(stderr, "kernel_launch: unexpected problem (n_in %d, out %d, ws %zu)\n", n_in, out_size, ws_size); grid = -1; return; }
        int dev = 0, cus = 0, per_cu = 0;
        hipGetDevice(&dev); hipDeviceGetAttribute(&cus, hipDeviceAttributeMultiprocessorCount, dev);
        if (hipFuncSetAttribute((const void*)mk_fwd, hipFuncAttributeMaxDynamicSharedMemorySize, LDS_BYTES) != hipSuccess) { fprintf(stderr, "kernel_launch: hipFuncSetAttribute(%d B LDS) failed\n", LDS_BYTES); }
        if (hipOccupancyMaxActiveBlocksPerMultiprocessor(&per_cu, (const void*)mk_fwd, 512, LDS_BYTES) != hipSuccess || per_cu < 1) { fprintf(stderr, "kernel_launch: occupancy query says %d\n", per_cu); per_cu = 1; }
        (void)hipGetLastError();
        grid = cus;
        if (grid != 256) fprintf(stderr, "kernel_launch: %d CUs; built for 256\n", grid);
    }
    if (grid < 0) return;
    Args a{};
    for (int i = 0; i < 21; ++i) a.in[i] = (const float*)d_in[i];
    a.out = (float*)d_out; a.ws = (unsigned char*)d_ws;
#if MK_ONE_LAUNCH
    a.ph_lo = 0; a.ph_hi = NPH;
    if (hipMemsetAsync((char*)d_ws + WS_BAR, 0, 80 * KiB, stream) != hipSuccess) { fprintf(stderr, "kernel_launch: memset of the barrier words failed\n"); return; }
    void* args[] = {&a};
    hipError_t e = hipLaunchCooperativeKernel((const void*)mk_fwd, dim3(grid), dim3(512), args, LDS_BYTES, stream);
    if (e != hipSuccess) fprintf(stderr, "kernel_launch: cooperative launch failed: %s (grid %d)\n", hipGetErrorString(e), grid);
#else
    for (int p = 0; p < NPH; ++p) { a.ph_lo = p; a.ph_hi = p + 1; hipLaunchKernelGGL(mk_fwd, dim3(grid), dim3(512), LDS_BYTES, stream, a); }
#endif
}
```

```cpp
#include <hip/hip_runtime.h>
#include <hip/hip_cooperative_groups.h>
#include <cstdio>
#include <cstdint>
#include <cmath>
typedef unsigned wt_u32x4 __attribute__((ext_vector_type(4)));
__device__ __forceinline__ void store16_wt(void* p, wt_u32x4 v) { asm volatile("global_store_dwordx4 %0, %1, off sc1\n\ts_nop 1" :: "v"(p), "v"(v) : "memory"); }
__device__ __forceinline__ float lane_get(float v, int src_lane) { return __builtin_bit_cast(float, __builtin_amdgcn_ds_bpermute(src_lane << 2, __builtin_bit_cast(int, v))); }
namespace pg8 {
#define PG8_LAS __attribute__((address_space(3)))
typedef unsigned short bf16_t;
typedef short bf16x8 __attribute__((ext_vector_type(8)));
typedef float f32x4 __attribute__((ext_vector_type(4)));
typedef unsigned u32x4 __attribute__((ext_vector_type(4)));
constexpr int BM = 256, BK = 64, HALF = 128, HTB = HALF * BK * 2  , STAGE_BYTES = 8 * HTB, NXCD = 8, WGM = 8;

__host__ __device__ __forceinline__ int lds_byte(int r, int c) { const int st = (r >> 4) * 2 + (c >> 5), rr = r & 15, cc = c & 31, ob = rr * 64 + cc * 2; return st * 1024 + (ob ^ (((ob >> 9) & 1) << 5)); }
__host__ __device__ __forceinline__ void stage_rc(int b, int& R, int& C) { const int st = b / 1024, sb = b % 1024, swz = sb ^ (((sb >> 9) & 1) << 5); R = (st >> 1) * 16 + swz / 64; C = (st & 1) * 32 + (swz % 64) / 2; }
__host__ __device__ __forceinline__ int perm32(int rho) { const int n = rho >> 4, i = rho & 15; return 8 * (i >> 2) + 4 * n + (i & 3); }

struct Unit { int pm, pn; };
struct Gemm { const bf16_t* A; const bf16_t* Bt; int M, N, K; int lda, ldb; long a_pn, b_pn; };

struct StaticOrder {
    int nM, nN, nwg, G, c;
    __host__ __device__ __forceinline__ void init(int M, int N, int G_, int c_) { nM = M / BM; nN = N / BM; nwg = nM * nN; G = G_; c = c_; }
    __host__ __device__ __forceinline__ bool next(int i, Unit& u) const {
        const long L = (long)i * G + c; if (L >= nwg) return false;
        int wgid = (int)L; { const int q = nwg / NXCD, r = nwg % NXCD, xcd = wgid % NXCD, off = wgid / NXCD; wgid = (xcd < r ? xcd * (q + 1) : r * (q + 1) + (xcd - r) * q) + off; }
        const int nig = WGM * nN, gid = wgid / nig, fm = gid * WGM, gsz = (nM - fm) < WGM ? (nM - fm) : WGM;
        u.pm = fm + ((wgid % nig) % gsz); u.pn = (wgid % nig) / gsz; return true;
    }
    __device__ __forceinline__ void a_ready(const Unit&) const {}
    __device__ __forceinline__ void done(const Unit&) const {}
};

__device__ __forceinline__ unsigned cvt_pk_bf16(float lo, float hi) { unsigned r; asm volatile("v_cvt_pk_bf16_f32 %0, %1, %2" : "=v"(r) : "v"(lo), "v"(hi)); return r; }
typedef float f32x2 __attribute__((ext_vector_type(2)));
__device__ __forceinline__ float row_rstd(const float* stats, int row) { const f32x4* sp = (const f32x4*)(stats + (size_t)row * 16); const f32x4 a = sp[0], b = sp[1], c = sp[2], d = sp[3];
    const float s = ((a[0] + a[1]) + (a[2] + a[3])) + ((b[0] + b[1]) + (b[2] + b[3])) + ((c[0] + c[1]) + (c[2] + c[3])) + ((d[0] + d[1]) + (d[2] + d[3])); return rsqrtf(s * (1.0f / 1024.0f) + 1e-6f); }
template <class Sched> __device__ __forceinline__ void fill_rstd_table(PG8_LAS float* rsL, const float* stats, const Sched& S, int tid) {
    Unit u; int n = 0; while (n < 8 && S.next(n, u)) ++n;
    for (int idx = tid; idx < n * 256; idx += 512) { S.next(idx >> 8, u); rsL[idx] = row_rstd(stats, u.pm * BM + (idx & 255)); }
    asm volatile("s_waitcnt lgkmcnt(0)" ::: "memory"); __builtin_amdgcn_s_barrier(); asm volatile("" ::: "memory");
}
struct EpiScaleBf16 {
    static constexpr bool PERM = true, AFTER_DRAIN = false, HAS_INIT = false;
    bf16_t* O; int ldc; float s_all; int pn_lo, pn_hi; float s_rng; const float* stats; bool wt;
    __device__ __forceinline__ void operator()(const f32x4 (&acc)[2][2][4][2], const Unit& u, int wr, int wc, int fr, int fq, int ui) const {
        const int row0 = u.pm * BM + wr * 64 + fr, col0 = u.pn * BM + wc * 32 + 8 * fq;
        const float sc = (u.pn >= pn_lo && u.pn < pn_hi) ? s_rng : s_all;
        float rs[2][4];
#pragma unroll
        for (int ai = 0; ai < 2; ++ai)
#pragma unroll
            for (int m = 0; m < 4; ++m) rs[ai][m] = stats ? row_rstd(stats, row0 + ai * HALF + m * 16) : 1.0f;
#pragma unroll
        for (int ai = 0; ai < 2; ++ai)
#pragma unroll
            for (int m = 0; m < 4; ++m) { bf16_t* rowp = O + (size_t)(row0 + ai * HALF + m * 16) * ldc + col0; const float scr = sc * rs[ai][m];
#pragma unroll
                for (int bj = 0; bj < 2; ++bj) { const f32x4 v0 = acc[ai][bj][m][0] * scr, v1 = acc[ai][bj][m][1] * scr;
                    u32x4 w; w.x = cvt_pk_bf16(v0[0], v0[1]); w.y = cvt_pk_bf16(v0[2], v0[3]); w.z = cvt_pk_bf16(v1[0], v1[1]); w.w = cvt_pk_bf16(v1[2], v1[3]);
                    if (wt) store16_wt(rowp + bj * HALF, w); else *(u32x4*)(rowp + bj * HALF) = w; } }
    }
};
struct EpiMixIn {
    static constexpr bool PERM = true, AFTER_DRAIN = false, HAS_INIT = false;
    bf16_t* O; int ldc; float qscale; float* kpart; const PG8_LAS float* rsL;
    __device__ __forceinline__ void operator()(const f32x4 (&acc)[2][2][4][2], const Unit& u, int wr, int wc, int fr, int fq, int ui) const {
        const int row0 = u.pm * BM + wr * 64 + fr, col0 = u.pn * BM + wc * 32 + 8 * fq;
        const float sc = (u.pn == 6 || u.pn == 7) ? qscale : 1.0f;
        float rs[2][4];
#pragma unroll
        for (int ai = 0; ai < 2; ++ai)
#pragma unroll
            for (int m = 0; m < 4; ++m) rs[ai][m] = rsL[ui * 256 + wr * 64 + fr + ai * HALF + m * 16];
#pragma unroll
        for (int ai = 0; ai < 2; ++ai)
#pragma unroll
            for (int m = 0; m < 4; ++m) { bf16_t* rowp = O + (size_t)(row0 + ai * HALF + m * 16) * ldc + col0; const float scr = sc * rs[ai][m];
#pragma unroll
                for (int bj = 0; bj < 2; ++bj) { const f32x4 v0 = acc[ai][bj][m][0] * scr, v1 = acc[ai][bj][m][1] * scr;
                    u32x4 w; w.x = cvt_pk_bf16(v0[0], v0[1]); w.y = cvt_pk_bf16(v0[2], v0[3]); w.z = cvt_pk_bf16(v1[0], v1[1]); w.w = cvt_pk_bf16(v1[2], v1[3]);
                    store16_wt(rowp + bj * HALF, w); } }
        if (u.pn == 8 || u.pn == 9) { const int lane = fq * 16 + fr;
#pragma unroll
            for (int bj = 0; bj < 2; ++bj) { float mx = 0.f;
#pragma unroll
                for (int ai = 0; ai < 2; ++ai)
#pragma unroll
                    for (int m = 0; m < 4; ++m) { const f32x4 a0 = acc[ai][bj][m][0], a1 = acc[ai][bj][m][1];
                        float p = ((a0[0] * a0[0] + a0[1] * a0[1]) + (a0[2] * a0[2] + a0[3] * a0[3])) + ((a1[0] * a1[0] + a1[1] * a1[1]) + (a1[2] * a1[2] + a1[3] * a1[3]));
                        p *= rs[ai][m] * rs[ai][m]; p += lane_get(p, lane ^ 16); p += lane_get(p, lane ^ 32); mx = fmaxf(mx, p); }
#pragma unroll
                for (int o = 1; o < 16; o <<= 1) mx = fmaxf(mx, lane_get(mx, lane ^ o));
                if (lane == 0) atomicMax((unsigned*)(kpart + ((u.pn - 8) * 4 + 2 * bj + (wc >> 1)) * 2 + (wc & 1)), __float_as_uint(mx)); } }
    }
};
__device__ __forceinline__ f32x4 silu_mul4(f32x4 g, f32x4 u) { const f32x4 t = g * (-1.4426950408889634f); f32x4 e;
    e[0] = __builtin_amdgcn_exp2f(t[0]); e[1] = __builtin_amdgcn_exp2f(t[1]); e[2] = __builtin_amdgcn_exp2f(t[2]); e[3] = __builtin_amdgcn_exp2f(t[3]);
    const f32x4 d = e + 1.0f; f32x4 r; r[0] = __builtin_amdgcn_rcpf(d[0]); r[1] = __builtin_amdgcn_rcpf(d[1]); r[2] = __builtin_amdgcn_rcpf(d[2]); r[3] = __builtin_amdgcn_rcpf(d[3]);
    return (g * r) * u; }
struct EpiSwiglu {
    static constexpr bool PERM = true, AFTER_DRAIN = false, HAS_INIT = false;
    bf16_t* O; int ldc; const PG8_LAS float* rsL;
    __device__ __forceinline__ void operator()(const f32x4 (&acc)[2][2][4][2], const Unit& u, int wr, int wc, int fr, int fq, int ui) const {
        const int row0 = u.pm * BM + wr * 64 + fr, col0 = u.pn * HALF + wc * 32 + 8 * fq; const PG8_LAS float* rsu = rsL + ui * 256 + wr * 64 + fr;
        float rs[2][4];
#pragma unroll
        for (int ai = 0; ai < 2; ++ai)
#pragma unroll
            for (int m = 0; m < 4; ++m) rs[ai][m] = rsu[ai * HALF + m * 16];
#pragma unroll
        for (int ai = 0; ai < 2; ++ai)
#pragma unroll
            for (int m = 0; m < 4; ++m) { bf16_t* rowp = O + (size_t)(row0 + ai * HALF + m * 16) * ldc + col0;
                const float rsv = rs[ai][m];
                const f32x4 g0 = acc[ai][0][m][0] * rsv, g1 = acc[ai][0][m][1] * rsv, u0 = acc[ai][1][m][0] * rsv, u1 = acc[ai][1][m][1] * rsv;
                const f32x4 o0 = silu_mul4(g0, u0), o1 = silu_mul4(g1, u1);
                u32x4 w; w.x = cvt_pk_bf16(o0[0], o0[1]); w.y = cvt_pk_bf16(o0[2], o0[3]); w.z = cvt_pk_bf16(o1[0], o1[1]); w.w = cvt_pk_bf16(o1[2], o1[3]);
                store16_wt(rowp, w); }
    }
};
struct EpiResid {
    static constexpr bool PERM = true, AFTER_DRAIN = false, HAS_INIT = true;
    bf16_t* XB; int ldc; float* stats;
    __device__ __forceinline__ void init(f32x4 (&acc)[2][2][4][2], const Unit& u, int wr, int wc, int fr, int fq) const {
        const bf16_t* const XB = this->XB; const int ldc = this->ldc; const int row0 = u.pm * BM + wr * 64 + fr, col0 = u.pn * BM + wc * 32 + 8 * fq;
        u32x4 raw[2][2][4];
#pragma unroll
        for (int ai = 0; ai < 2; ++ai)
#pragma unroll
            for (int m = 0; m < 4; ++m)
#pragma unroll
                for (int bj = 0; bj < 2; ++bj) raw[ai][bj][m] = *(const u32x4*)(XB + (size_t)(row0 + ai * HALF + m * 16) * ldc + col0 + bj * HALF);
#pragma unroll
        for (int ai = 0; ai < 2; ++ai)
#pragma unroll
            for (int m = 0; m < 4; ++m)
#pragma unroll
                for (int bj = 0; bj < 2; ++bj) { const u32x4 w = raw[ai][bj][m];
                    acc[ai][bj][m][0] = (f32x4){__builtin_bit_cast(float, w.x << 16), __builtin_bit_cast(float, w.x & 0xffff0000u), __builtin_bit_cast(float, w.y << 16), __builtin_bit_cast(float, w.y & 0xffff0000u)};
                    acc[ai][bj][m][1] = (f32x4){__builtin_bit_cast(float, w.z << 16), __builtin_bit_cast(float, w.z & 0xffff0000u), __builtin_bit_cast(float, w.w << 16), __builtin_bit_cast(float, w.w & 0xffff0000u)}; }
    }
    __device__ __forceinline__ void operator()(const f32x4 (&acc)[2][2][4][2], const Unit& u, int wr, int wc, int fr, int fq, int ui) const {
        bf16_t* const XB = this->XB; float* const stats = this->stats; const int ldc = this->ldc;
        const int row0 = u.pm * BM + wr * 64 + fr, col0 = u.pn * BM + wc * 32 + 8 * fq, lane = fq * 16 + fr;
#pragma unroll
        for (int ai = 0; ai < 2; ++ai)
#pragma unroll
            for (int m = 0; m < 4; ++m) { const int row = row0 + ai * HALF + m * 16; bf16_t* rowb = XB + (size_t)row * ldc + col0; float ss = 0.f;
#pragma unroll
                for (int bj = 0; bj < 2; ++bj) { const f32x4 x0 = acc[ai][bj][m][0], x1 = acc[ai][bj][m][1];
                    ss += ((x0[0] * x0[0] + x0[1] * x0[1]) + (x0[2] * x0[2] + x0[3] * x0[3])) + ((x1[0] * x1[0] + x1[1] * x1[1]) + (x1[2] * x1[2] + x1[3] * x1[3]));
                    u32x4 w; w.x = cvt_pk_bf16(x0[0], x0[1]); w.y = cvt_pk_bf16(x0[2], x0[3]); w.z = cvt_pk_bf16(x1[0], x1[1]); w.w = cvt_pk_bf16(x1[2], x1[3]); store16_wt(rowb + bj * HALF, w); }
                ss += lane_get(ss, lane ^ 16); ss += lane_get(ss, lane ^ 32);
                if (fq == 0) __hip_atomic_store((unsigned*)stats + (size_t)row * 16 + u.pn * 4 + wc, __float_as_uint(ss), __ATOMIC_RELAXED, __HIP_MEMORY_SCOPE_AGENT); }
    }
};
struct EpiSoftmax {
    static constexpr bool PERM = true, AFTER_DRAIN = true, HAS_INIT = false;
    bf16_t* O; int ldc;
    __device__ __forceinline__ void fused(f32x4 (&acc)[2][2][4][2], const Unit& u, int wr, int wc, int fr, int fq, PG8_LAS unsigned char* lds, int wid, int lane) const {
        PG8_LAS float* T1 = (PG8_LAS float*)lds;
        PG8_LAS float* T2 = (PG8_LAS float*)(lds + 4096);
#pragma unroll
        for (int ai = 0; ai < 2; ++ai)
#pragma unroll
            for (int m = 0; m < 4; ++m) { float mx = -INFINITY;
#pragma unroll
                for (int bj = 0; bj < 2; ++bj)
#pragma unroll
                    for (int n = 0; n < 2; ++n) { const f32x4 x = acc[ai][bj][m][n]; mx = fmaxf(mx, fmaxf(fmaxf(x[0], x[1]), fmaxf(x[2], x[3]))); }
                mx = fmaxf(mx, lane_get(mx, lane ^ 16)); mx = fmaxf(mx, lane_get(mx, lane ^ 32));
                if (fq == 0) T1[(ai * HALF + wr * 64 + m * 16 + fr) * 4 + wc] = mx; }
        asm volatile("s_waitcnt lgkmcnt(0)" ::: "memory"); __builtin_amdgcn_s_barrier(); asm volatile("" ::: "memory");
#pragma unroll
        for (int ai = 0; ai < 2; ++ai)
#pragma unroll
            for (int m = 0; m < 4; ++m) { const int r = ai * HALF + wr * 64 + m * 16 + fr; const f32x4 t = *(const PG8_LAS f32x4*)(T1 + r * 4);
                const float mx = fmaxf(fmaxf(t[0], t[1]), fmaxf(t[2], t[3])); float s = 0.f;
#pragma unroll
                for (int bj = 0; bj < 2; ++bj)
#pragma unroll
                    for (int n = 0; n < 2; ++n) { f32x4 x = acc[ai][bj][m][n];
                        x[0] = __builtin_amdgcn_exp2f(x[0] - mx); x[1] = __builtin_amdgcn_exp2f(x[1] - mx); x[2] = __builtin_amdgcn_exp2f(x[2] - mx); x[3] = __builtin_amdgcn_exp2f(x[3] - mx);
                        s += (x[0] + x[1]) + (x[2] + x[3]); acc[ai][bj][m][n] = x; }
                s += lane_get(s, lane ^ 16); s += lane_get(s, lane ^ 32);
                if (fq == 0) T2[r * 4 + wc] = s; }
        asm volatile("s_waitcnt lgkmcnt(0)" ::: "memory"); __builtin_amdgcn_s_barrier(); asm volatile("" ::: "memory");
        const int row0 = u.pm * BM + wr * 64 + fr, col0 = u.pn * BM + wc * 32 + 8 * fq;
#pragma unroll
        for (int ai = 0; ai < 2; ++ai)
#pragma unroll
            for (int m = 0; m < 4; ++m) { const int r = ai * HALF + wr * 64 + m * 16 + fr; const f32x4 t = *(const PG8_LAS f32x4*)(T2 + r * 4);
                const float inv = 1.0f / ((t[0] + t[1]) + (t[2] + t[3])); bf16_t* rowp = O + (size_t)(row0 + ai * HALF + m * 16) * ldc + col0;
#pragma unroll
                for (int bj = 0; bj < 2; ++bj) { const f32x4 v0 = acc[ai][bj][m][0] * inv, v1 = acc[ai][bj][m][1] * inv;
                    u32x4 w; w.x = cvt_pk_bf16(v0[0], v0[1]); w.y = cvt_pk_bf16(v0[2], v0[3]); w.z = cvt_pk_bf16(v1[0], v1[1]); w.w = cvt_pk_bf16(v1[2], v1[3]);
                    *(u32x4*)(rowp + bj * HALF) = w; } }
    }
};

template <class Epi, class Sched, bool ALIGN_EPI = false, bool SP2 = false>
__device__ __forceinline__ void gemm_phase(PG8_LAS unsigned char* lds, const Gemm g, const Sched S, const Epi E, const int tid) {
    const int wid = __builtin_amdgcn_readfirstlane(tid >> 6), lane = tid & 63, wr = wid >> 2, wc = wid & 3, fr = lane & 15, fq = lane >> 4;
    const int K = g.K, nt = K / BK;
    unsigned voffA[2], voffB[2];
#pragma unroll
    for (int i = 0; i < 2; ++i) { int R, C; stage_rc(tid * 16 + i * 8192, R, C); const int Rb = Epi::PERM ? ((R & ~31) + perm32(R & 31)) : R;
        voffA[i] = (unsigned)(R * g.lda + C) * 2u; voffB[i] = (unsigned)(Rb * g.ldb + C) * 2u; }
    const size_t kstep = (size_t)(BK * 2);
    const size_t hstepA = (size_t)HALF * g.lda * 2, hstepB = (size_t)HALF * g.ldb * 2;
    const size_t tstepA = 2 * hstepA, apn = (size_t)g.a_pn * 2, bpn = (size_t)g.b_pn * 2;
    const unsigned ldsw = (unsigned)wid * 1024u;
    const int aoff = lds_byte(wr * 64 + fr, fq * 8), boff = lds_byte(wc * 32 + fr, fq * 8);
#define PG8_SA(b, h) (((b) * 2 + (h)) * HTB)
#define PG8_SB(b, h) ((4 + (b) * 2 + (h)) * HTB)
#define PG8_STAGE(bufoff, gbase, voff) do { _Pragma("unroll") for (int _i = 0; _i < 2; ++_i) \
        __builtin_amdgcn_global_load_lds((const unsigned*)((const char*)(gbase) + (voff)[_i]), (PG8_LAS unsigned*)(lds + (bufoff) + ldsw + _i * 8192), 16, 0, 0); } while (0)
#define PG8_LDA(dst, b, h) do { _Pragma("unroll") for (int m = 0; m < 4; ++m) _Pragma("unroll") for (int k = 0; k < 2; ++k) dst[m][k] = *(const PG8_LAS bf16x8*)(lds + PG8_SA(b, h) + aoff + m * 2048 + k * 1024); } while (0)
#define PG8_LDB(dst, b, h) do { _Pragma("unroll") for (int n = 0; n < 2; ++n) _Pragma("unroll") for (int k = 0; k < 2; ++k) dst[n][k] = *(const PG8_LAS bf16x8*)(lds + PG8_SB(b, h) + boff + n * 2048 + k * 1024); } while (0)
#define PG8_MMA(ai, bj, At, Bt) do { __builtin_amdgcn_s_setprio(1); _Pragma("unroll") for (int m = 0; m < 4; ++m) _Pragma("unroll") for (int n = 0; n < 2; ++n) _Pragma("unroll") for (int k = 0; k < 2; ++k) \
        acc[ai][bj][m][n] = __builtin_amdgcn_mfma_f32_16x16x32_bf16(Bt[n][k], At[m][k], acc[ai][bj][m][n], 0, 0, 0); __builtin_amdgcn_s_setprio(0); } while (0)
#define PG8_WAIT_V(n) asm volatile("s_waitcnt vmcnt(" #n ")" ::: "memory")
#define PG8_WAIT_L(n) asm volatile("s_waitcnt lgkmcnt(" #n ")" ::: "memory")
#define PG8_BAR __builtin_amdgcn_s_barrier()
#define PG8_SCHED __builtin_amdgcn_sched_barrier(0)
    Unit cur, nxt; int ui = 0;
    if (!S.next(0, cur)) return;
    f32x4 acc[2][2][4][2];
    if constexpr (Epi::HAS_INIT) E.init(acc, cur, wr, wc, fr, fq);
    else {
#pragma unroll
    for (int a = 0; a < 2; ++a)
#pragma unroll
        for (int b = 0; b < 2; ++b)
#pragma unroll
            for (int m = 0; m < 4; ++m)
#pragma unroll
                for (int n = 0; n < 2; ++n) acc[a][b][m][n] = (f32x4){0.f, 0.f, 0.f, 0.f};
    }
    bf16x8 At[4][2], B0[2][2], B1[2][2];
    const char* cA = (const char*)g.A + (size_t)cur.pm * tstepA + (size_t)cur.pn * apn; const char* cB = (const char*)g.Bt + (size_t)cur.pn * bpn;
    S.a_ready(cur);
    if constexpr (SP2) {
        PG8_STAGE(PG8_SB(0, 0), cB, voffB); PG8_STAGE(PG8_SB(0, 1), cB + hstepB, voffB); PG8_STAGE(PG8_SA(0, 0), cA, voffA); PG8_STAGE(PG8_SA(0, 1), cA + hstepA, voffA);
        if (wr == 1) PG8_BAR;
        PG8_WAIT_V(2); PG8_BAR;
        PG8_STAGE(PG8_SB(1, 0), cB + kstep, voffB); PG8_STAGE(PG8_SA(1, 0), cA + kstep, voffA); PG8_STAGE(PG8_SB(1, 1), cB + hstepB + kstep, voffB);
        PG8_WAIT_V(6); PG8_BAR;
    } else {
        PG8_STAGE(PG8_SB(0, 0), cB, voffB); PG8_STAGE(PG8_SA(0, 0), cA, voffA); PG8_STAGE(PG8_SB(0, 1), cB + hstepB, voffB); PG8_STAGE(PG8_SA(0, 1), cA + hstepA, voffA);
        if (wr == 1) PG8_BAR;
        PG8_WAIT_V(4); PG8_BAR;
        PG8_STAGE(PG8_SB(1, 0), cB + kstep, voffB); PG8_STAGE(PG8_SA(1, 0), cA + kstep, voffA); PG8_STAGE(PG8_SB(1, 1), cB + hstepB + kstep, voffB);
        PG8_WAIT_V(6); PG8_BAR;
    }
    for (;;) {
        const bool has_next = S.next(ui + 1, nxt);
        const char* nA = has_next ? (const char*)g.A + (size_t)nxt.pm * tstepA + (size_t)nxt.pn * apn : cA; const char* nB = has_next ? (const char*)g.Bt + (size_t)nxt.pn * bpn : cB;
        for (int t = 0; t < nt; t += 2) {
            const bool last = (t == nt - 2);
            const char* a1 = cA + (size_t)(t + 1) * kstep;
            const char* a2 = last ? nA : cA + (size_t)(t + 2) * kstep; const char* b2 = last ? nB : cB + (size_t)(t + 2) * kstep;
            const char* a3 = a2 + kstep; const char* b3 = b2 + kstep;
            if (last && has_next) S.a_ready(nxt);
            if constexpr (SP2) {
            PG8_LDB(B0, 0, 0); PG8_LDB(B1, 0, 1); PG8_SCHED; PG8_LDA(At, 0, 0); PG8_STAGE(PG8_SA(1, 1), a1 + hstepA, voffA);
            PG8_WAIT_V(8); PG8_WAIT_L(0); PG8_BAR; PG8_MMA(0, 0, At, B0); PG8_MMA(0, 1, At, B1); PG8_BAR; PG8_SCHED;
            PG8_LDA(At, 0, 1); PG8_STAGE(PG8_SB(0, 0), b2, voffB); PG8_STAGE(PG8_SB(0, 1), b2 + hstepB, voffB); PG8_STAGE(PG8_SA(0, 0), a2, voffA);
            PG8_WAIT_V(8); PG8_WAIT_L(0); PG8_BAR; PG8_MMA(1, 0, At, B0); PG8_MMA(1, 1, At, B1); PG8_BAR; PG8_SCHED;
            PG8_LDB(B0, 1, 0); PG8_LDB(B1, 1, 1); PG8_SCHED; PG8_LDA(At, 1, 0); PG8_STAGE(PG8_SA(0, 1), a2 + hstepA, voffA);
            PG8_WAIT_V(8); PG8_WAIT_L(0); PG8_BAR; PG8_MMA(0, 0, At, B0); PG8_MMA(0, 1, At, B1); PG8_BAR; PG8_SCHED;
            PG8_LDA(At, 1, 1); PG8_STAGE(PG8_SB(1, 0), b3, voffB); PG8_STAGE(PG8_SB(1, 1), b3 + hstepB, voffB); PG8_STAGE(PG8_SA(1, 0), a3, voffA);
            PG8_WAIT_V(8); PG8_WAIT_L(0); PG8_BAR; PG8_MMA(1, 0, At, B0); PG8_MMA(1, 1, At, B1); PG8_BAR; PG8_SCHED;
            } else {
            PG8_LDB(B0, 0, 0); PG8_SCHED; PG8_LDA(At, 0, 0); PG8_STAGE(PG8_SA(1, 1), a1 + hstepA, voffA);
            PG8_WAIT_L(8); PG8_BAR; PG8_WAIT_L(0); PG8_MMA(0, 0, At, B0); PG8_BAR; PG8_SCHED;
            PG8_LDB(B1, 0, 1); PG8_STAGE(PG8_SB(0, 0), b2, voffB);
            PG8_BAR; PG8_WAIT_L(0); PG8_MMA(0, 1, At, B1); PG8_BAR;
            PG8_LDA(At, 0, 1); PG8_STAGE(PG8_SA(0, 0), a2, voffA);
            PG8_BAR; PG8_WAIT_L(0); PG8_MMA(1, 0, At, B0); PG8_BAR; PG8_SCHED;
            PG8_STAGE(PG8_SB(0, 1), b2 + hstepB, voffB);
            PG8_WAIT_V(6); PG8_BAR; PG8_MMA(1, 1, At, B1); PG8_BAR;
            PG8_LDB(B0, 1, 0); PG8_SCHED; PG8_LDA(At, 1, 0); PG8_STAGE(PG8_SA(0, 1), a2 + hstepA, voffA);
            PG8_WAIT_L(8); PG8_BAR; PG8_WAIT_L(0); PG8_MMA(0, 0, At, B0); PG8_BAR; PG8_SCHED;
            PG8_LDB(B1, 1, 1); PG8_STAGE(PG8_SB(1, 0), b3, voffB);
            PG8_BAR; PG8_WAIT_L(0); PG8_MMA(0, 1, At, B1); PG8_BAR;
            PG8_LDA(At, 1, 1); PG8_STAGE(PG8_SA(1, 0), a3, voffA);
            PG8_BAR; PG8_WAIT_L(0); PG8_MMA(1, 0, At, B0); PG8_BAR; PG8_SCHED;
            PG8_STAGE(PG8_SB(1, 1), b3 + hstepB, voffB);
            PG8_WAIT_V(6); PG8_BAR; PG8_MMA(1, 1, At, B1); PG8_BAR;
            }
        }
        if constexpr (ALIGN_EPI) { if (wr == 0) PG8_BAR; }
        if constexpr (!Epi::AFTER_DRAIN) { E(acc, cur, wr, wc, fr, fq, ui); S.done(cur); }
        if (!has_next) break;
        if constexpr (Epi::HAS_INIT) E.init(acc, nxt, wr, wc, fr, fq);
        else {
#pragma unroll
        for (int a = 0; a < 2; ++a)
#pragma unroll
            for (int b = 0; b < 2; ++b)
#pragma unroll
                for (int m = 0; m < 4; ++m)
#pragma unroll
                    for (int n = 0; n < 2; ++n) acc[a][b][m][n] = (f32x4){0.f, 0.f, 0.f, 0.f};
        }
        cur = nxt; cA = nA; cB = nB; ++ui;
        if constexpr (ALIGN_EPI) { if (wr == 1) PG8_BAR; }
    }
    PG8_WAIT_V(0);
    if constexpr (!ALIGN_EPI) { if (wr == 0) PG8_BAR; }
    PG8_BAR;
    if constexpr (Epi::AFTER_DRAIN) { E.fused(acc, cur, wr, wc, fr, fq, lds, wid, lane); S.done(cur); }
#undef PG8_SA
#undef PG8_SB
#undef PG8_STAGE
#undef PG8_LDA
#undef PG8_LDB
#undef PG8_MMA
#undef PG8_WAIT_V
#undef PG8_WAIT_L
#undef PG8_BAR
#undef PG8_SCHED
}
}

#include <hip/hip_bf16.h>
#include <cmath>
namespace attn_body {
using bf16=__hip_bfloat16;
using bf16x8=__attribute__((ext_vector_type(8)))short;
using s16x4=__attribute__((ext_vector_type(4)))short;
using f32x16=__attribute__((ext_vector_type(16)))float;
using u32x4=__attribute__((ext_vector_type(4)))unsigned;
using f32x4v=__attribute__((ext_vector_type(4)))float;
constexpr int BATCH=1,NHEAD=8,SEQ=16384,D=64,DM=3072;
constexpr int NW=8,QBLK=32,QB=QBLK*NW,KVBLK=64,NQB=SEQ/QB;
constexpr int ATTN_PITCH=DM, ATTN_UNIT_ROWS=QB;
__device__ __forceinline__ int crow(int r,int hi){return (r&3)+8*(r>>2)+4*hi;}
#define SBAR() __builtin_amdgcn_sched_barrier(0)
__device__ __forceinline__ void cmask(f32x16&p0,f32x16&p1,int jb,int qrel,int hi){
  const float NEG=-INFINITY; int kb=64*jb+4*hi;
  #pragma unroll
  for(int r=0;r<16;++r){int kv=kb+(r&3)+8*(r>>2); if(kv>qrel)p0[r]=NEG; if(kv+32>qrel)p1[r]=NEG;}
}

constexpr int NSLOT=3, SLOTB=8192;
constexpr int LDS_K=0, LDS_V=NSLOT*SLOTB, LDS_WS=2*NSLOT*SLOTB, LDS_OST=LDS_WS+NW*64*4, LDS_BIAS=LDS_OST+NW*4096, LDS_PRE=LDS_BIAS+SEQ*4, LDS_BYTES=LDS_PRE+1024;
constexpr float C2=0.125f*1.4426950408889634f;
__device__ __forceinline__ void glds16(const void*gsrc,unsigned lds_dst){unsigned keep;
  asm volatile("s_mov_b32 %0, m0\n\ts_mov_b32 m0, %2\n\ts_nop 0\n\tglobal_load_lds_dwordx4 %1, off\n\ts_mov_b32 m0, %0":"=&s"(keep):"v"(gsrc),"s"(lds_dst):"memory");}
__device__ __forceinline__ float max3f(float a,float b,float c){float r;asm("v_max3_f32 %0, %1, %2, %3":"=v"(r):"v"(a),"v"(b),"v"(c));return r;}
__device__ __forceinline__ float max2f(float a,float b){float r;asm("v_max_f32_e32 %0, %1, %2":"=v"(r):"v"(a),"v"(b));return r;}
__device__ __forceinline__ float fadd_s(float a,float b){float r;asm("v_add_f32_e32 %0, %1, %2":"=v"(r):"v"(a),"v"(b));return r;}
__device__ __forceinline__ float fsub_s(float a,float b){float r;asm("v_sub_f32_e32 %0, %1, %2":"=v"(r):"v"(a),"v"(b));return r;}
typedef float f32x2_t __attribute__((ext_vector_type(2))); typedef __bf16 bf16x2_t __attribute__((ext_vector_type(2)));
__device__ __forceinline__ unsigned cvtpk_s(float lo,float hi){f32x2_t v={lo,hi};bf16x2_t b=__builtin_convertvector(v,bf16x2_t);return __builtin_bit_cast(unsigned,b);}
#define WAIT_BAR(N) asm volatile("s_waitcnt vmcnt(" #N ") lgkmcnt(0)\n\ts_barrier":::"memory")

__device__ __forceinline__ void qkt(f32x16&p0,f32x16&p1,const char*Kslot,const bf16x8*qr,int r32,int hi){
  const char*kb=Kslot+hi*1024+r32*16;
  #pragma unroll
  for(int d0=0;d0<4;++d0){
    const bf16x8 b0=*reinterpret_cast<const bf16x8*>(kb+d0*2048);
    const bf16x8 b1=*reinterpret_cast<const bf16x8*>(kb+d0*2048+512);
    {p0=__builtin_amdgcn_mfma_f32_32x32x16_bf16(b0,qr[d0],p0,0,0,0);p1=__builtin_amdgcn_mfma_f32_32x32x16_bf16(b1,qr[d0],p1,0,0,0);}}
}
typedef __attribute__((address_space(3))) const char* lds_cptr;
typedef short v4i16_t __attribute__((ext_vector_type(4)));
__device__ __forceinline__ void kload8(bf16x8*kf,lds_cptr kp){
  kf[0]=*(const __attribute__((address_space(3))) bf16x8*)(kp);      kf[1]=*(const __attribute__((address_space(3))) bf16x8*)(kp+512);
  kf[2]=*(const __attribute__((address_space(3))) bf16x8*)(kp+2048); kf[3]=*(const __attribute__((address_space(3))) bf16x8*)(kp+2560);
  kf[4]=*(const __attribute__((address_space(3))) bf16x8*)(kp+4096); kf[5]=*(const __attribute__((address_space(3))) bf16x8*)(kp+4608);
  kf[6]=*(const __attribute__((address_space(3))) bf16x8*)(kp+6144); kf[7]=*(const __attribute__((address_space(3))) bf16x8*)(kp+6656);
}
__device__ __forceinline__ void kload2(bf16x8*kf,lds_cptr kp,int j){ kf[2*j]=*(const __attribute__((address_space(3))) bf16x8*)(kp+j*2048); kf[2*j+1]=*(const __attribute__((address_space(3))) bf16x8*)(kp+j*2048+512); }
__device__ __forceinline__ s16x4 vtr(lds_cptr p){ return __builtin_bit_cast(s16x4,__builtin_amdgcn_ds_read_tr16_b64_v4i16((__attribute__((address_space(3))) v4i16_t*)p)); }
__device__ __forceinline__ float rowmax(const f32x16&p0,const f32x16&p1){
  float a=max3f(p0[0],p0[1],p1[0]),b=max3f(p0[2],p0[3],p1[1]);a=max3f(a,p1[2],p1[3]);
  #pragma unroll
  for(int r=4;r<16;r+=4){a=max3f(a,p0[r],p0[r+1]);b=max3f(b,p0[r+2],p0[r+3]);a=max3f(a,p1[r],p1[r+1]);b=max3f(b,p1[r+2],p1[r+3]);}
  const float m=max2f(a,b);
  auto rr=__builtin_amdgcn_permlane32_swap(__float_as_uint(m),__float_as_uint(m),false,false);
  return max2f(__uint_as_float(rr[0]),__uint_as_float(rr[1]));
}
__device__ __forceinline__ void pv(f32x16*o,int vb,bf16x8 pa0,bf16x8 pa1,bf16x8 pa2,bf16x8 pa3){
  #pragma unroll
  for(int d0=0;d0<2;++d0){s16x4 lo[4],hi[4];
    #pragma unroll
    for(int ks=0;ks<4;++ks){
      asm volatile("ds_read_b64_tr_b16 %0,%1 offset:%c2":"=&v"(lo[ks]):"v"(vb),"i"(d0*4096+ks*1024):"memory");
      asm volatile("ds_read_b64_tr_b16 %0,%1 offset:%c2":"=&v"(hi[ks]):"v"(vb),"i"(d0*4096+ks*1024+512):"memory");}
    asm volatile("s_waitcnt lgkmcnt(0)":::"memory");SBAR();
    #define PK(k) (bf16x8){lo[k][0],lo[k][1],lo[k][2],lo[k][3],hi[k][0],hi[k][1],hi[k][2],hi[k][3]}
    o[d0]=__builtin_amdgcn_mfma_f32_32x32x16_bf16(pa0,PK(0),o[d0],0,0,0);
    o[d0]=__builtin_amdgcn_mfma_f32_32x32x16_bf16(pa1,PK(1),o[d0],0,0,0);
    o[d0]=__builtin_amdgcn_mfma_f32_32x32x16_bf16(pa2,PK(2),o[d0],0,0,0);
    o[d0]=__builtin_amdgcn_mfma_f32_32x32x16_bf16(pa3,PK(3),o[d0],0,0,0);
    #undef PK
  }
}

#ifndef ATTN_STORE16
#define ATTN_STORE16(p,v) store16_wt((p),(v))
#endif
template<int THRL> __device__ __forceinline__ void attn_unit(int b,int h,int qb,const bf16*Q,const bf16*__restrict__ K,const bf16*__restrict__ V,bf16*O,const float*__restrict__ cl,const float*__restrict__ ctot,const float*__restrict__ kpart,char*shm,const int tid,const int odm){
  const int lane=tid&63,r32=lane&31,hi=lane>>5; const int wid=__builtin_amdgcn_readfirstlane(tid>>6);
  const long rowbase=(long)b*SEQ; const int q0=qb*QB; const int NTF=(q0+QB)/KVBLK;
  const bf16*Qw=Q+(rowbase+q0+wid*QBLK)*DM+h*D;
  const unsigned lds0=(unsigned)(uintptr_t)shm;
  float*wsf=(float*)(shm+LDS_WS)+wid*64;
  const char*Kbase=shm+LDS_K; bf16x8 kf[8];
  const lds_cptr shm3=(lds_cptr)shm; const lds_cptr kp0=shm3+LDS_K+hi*1024+r32*16; const lds_cptr vp0=shm3+LDS_V+((lane>>4)&1)*32+(lane&3)*8+(4*hi+((lane&15)>>2))*64;
  bf16x8 qr[4];
  #pragma unroll
  for(int d0=0;d0<4;++d0)qr[d0]=*reinterpret_cast<const bf16x8*>(&Qw[(long)r32*DM+d0*16+hi*8]);
  typedef __attribute__((address_space(3))) float lds_f; typedef __attribute__((address_space(3))) f32x4v lds_f4;
  lds_f* preL=(lds_f*)(shm3+LDS_PRE); lds_f4* bias4=(lds_f4*)(shm3+LDS_BIAS); lds_f* wsq=(lds_f*)(shm3+LDS_WS);
  int ln_=lane; asm volatile("":"+v"(ln_));
  if(wid==0){ const f32x4v tq=*(const f32x4v*)(ctot+4*lane); const float s0=tq[0],s1=s0+tq[1],s2=s1+tq[2],s3=s2+tq[3]; float inc=s3;
    _Pragma("unroll") for(int of=1;of<64;of<<=1){ const float vv=lane_get(inc,ln_-of); if(ln_>=of)inc+=vv; }
    const float exc=inc-s3; preL[4*lane]=exc; preL[4*lane+1]=exc+s0; preL[4*lane+2]=exc+s1; preL[4*lane+3]=exc+s2; }
  { float qs=0.f;
    _Pragma("unroll") for(int d0=0;d0<4;++d0) _Pragma("unroll") for(int e=0;e<8;++e){ const float qf=__builtin_bit_cast(float,((unsigned)(unsigned short)qr[d0][e])<<16); qs+=qf*qf; }
    { auto rr=__builtin_amdgcn_permlane32_swap(__float_as_uint(qs),__float_as_uint(qs),false,false); qs=__uint_as_float(rr[0])+__uint_as_float(rr[1]); }
    _Pragma("unroll") for(int of=1;of<32;of<<=1) qs=fmaxf(qs,lane_get(qs,ln_^of));
    if(lane==0) wsq[wid*64]=qs; }
  asm volatile("s_waitcnt lgkmcnt(0)\n\ts_barrier":::"memory");
  int t0=0;
  { float qm=0.f; _Pragma("unroll") for(int w=0;w<NW;++w) qm=fmaxf(qm,wsq[w*64]);
    const float km=kpart[2*h]+kpart[2*h+1];
    const float QK=sqrtf(qm*km)*1.02f+0.01f;
    const float thr=-preL[4*qb]*1.4426950408889634f-2.f*QK-40.f;
    for(int base=0;base<NTF-4;base+=64){ const int tau=base+lane; const bool sk=(tau<NTF-4)&&(-preL[tau+1]*1.4426950408889634f<thr); t0+=__builtin_popcountll(__builtin_amdgcn_ballot_w64(sk)); }
    t0=__builtin_amdgcn_readfirstlane(t0)&~1; }
  const int NT=NTF-t0;
  const bf16*Kh=K+(rowbase+(long)t0*KVBLK)*DM+h*D,*Vh=V+(rowbase+(long)t0*KVBLK)*DM+h*D;
  const bf16*ksrc=Kh+(long)lane*DM+wid*8;
  const bf16*vsrc=Vh+(long)(16*(wid&3)+(lane>>2))*DM+(wid>>2)*32+(lane&3)*8;
  const unsigned kdst=lds0+LDS_K+wid*1024, vdst=lds0+LDS_V+wid*1024;
  #define DMA_K(t,slot) glds16(ksrc+(long)(t)*KVBLK*DM,(unsigned)__builtin_amdgcn_readfirstlane(kdst+(slot)))
  #define DMA_V(t,slot) glds16(vsrc+(long)(t)*KVBLK*DM,(unsigned)__builtin_amdgcn_readfirstlane(vdst+(slot)))
  DMA_K(0,0);DMA_V(0,0);DMA_K(1,SLOTB);
  float mhat=0.f,l_reg=0.f;f32x16 o[2];o[0]=f32x16{};o[1]=f32x16{};
  for(int i=tid;i<NT*16;i+=NW*64){ const f32x4v c=*(const f32x4v*)(cl+4*(t0*16+i)); const float pp=preL[t0+(i>>4)]; bias4[i]=(c+pp)*(-1.4426950408889634f); }

  const int qrel=wid*QBLK+r32;
  #define CMASK(P0,P1,t) do{int jb_=(t)-(NT-4); if(jb_>=0)cmask(P0,P1,jb_,qrel,hi);}while(0)
  #define LOADB1(C0,t,o8) do{ const lds_f4* bp_=bias4+(t)*16+hi+(o8); _Pragma("unroll") for(int j_=0;j_<4;++j_){ const f32x4v b0_=bp_[2*j_]; \
      _Pragma("unroll") for(int i_=0;i_<4;++i_){ C0[4*j_+i_]=b0_[i_]-mhat; } } }while(0)
  #define LOADB(C0,C1,t) do{ LOADB1(C0,t,0); LOADB1(C1,t,8); }while(0)
  bool resc=false;
  #define START(P0,P1) do{ const float rm=rowmax(P0,P1); resc=false; \
    { const float dl=rm; mhat=fadd_s(mhat,dl); \
      _Pragma("unroll") for(int r=0;r<16;++r){P0[r]=fsub_s(P0[r],dl);P1[r]=fsub_s(P1[r],dl);} } \
    _Pragma("unroll") for(int r=0;r<16;++r)P0[r]=__builtin_amdgcn_exp2f(P0[r]); }while(0)
  #define RESC() do{ if(resc){ asm volatile("s_waitcnt lgkmcnt(0)":::"memory"); \
      _Pragma("unroll") for(int d_=0;d_<2;++d_) _Pragma("unroll") for(int r=0;r<16;++r)o[d_][r]*=wsf[crow(r,hi)]; } }while(0)
  f32x16 pA0,pA1,pB0,pB1;
  int sl_prev=0,sl_cur=0,sl_next=SLOTB;
  #define ROT() do{sl_prev=sl_cur;sl_cur=sl_next;sl_next=(sl_next==(NSLOT-1)*SLOTB)?0:sl_next+SLOTB;}while(0)
  DMA_K(2,2*SLOTB);
  WAIT_BAR(3);
  LOADB(pA0,pA1,0);
  qkt(pA0,pA1,Kbase,qr,r32,hi);asm volatile("s_nop 15\n\ts_nop 7":"+v"(pA0),"+v"(pA1));CMASK(pA0,pA1,0);
  START(pA0,pA1);
  _Pragma("unroll") for(int r=0;r<16;++r)pA1[r]=__builtin_amdgcn_exp2f(pA1[r]);
  WAIT_BAR(0);
  DMA_K(3,0);DMA_V(1,SLOTB);
  ROT();
  kload8(kf,kp0+sl_cur);
  WAIT_BAR(2);
  s16x4 vlo[8],vhi[8]; u32x4 pw0,pw1,pw2,pw3;
  #define PKW(P,B) cvtpk_s(P[B],P[B+1])
  #define PAF(k) __builtin_bit_cast(bf16x8,pw##k)
  #define VFR(i) (bf16x8){vlo[i][0],vlo[i][1],vlo[i][2],vlo[i][3],vhi[i][0],vhi[i][1],vhi[i][2],vhi[i][3]}
  #define PIN(x) asm volatile("":"+v"(x))
  #define MX3(a,b,c) __builtin_fmaxf(__builtin_fmaxf((a),(b)),(c))
  #define GAPA(MF,A0,A1,A2,A3,W0,W1,PW) do{ MF; sacc+=A0; sacc+=A1; sacc+=A2; sacc+=A3; PIN(sacc); W0; W1; PIN(PW); SBAR(); }while(0)
  #define EX(v) __builtin_amdgcn_exp2f(v)
  #define GAPB(MF,X,B) do{ MF; X[B]=EX(X[B]); X[B+1]=EX(X[B+1]); X[B+2]=EX(X[B+2]); X[B+3]=EX(X[B+3]); PIN(X); SBAR(); }while(0)
  #define VRD(i) do{ vlo[i]=vtr(vp_+(((i)>>2)*4096+((i)&3)*1024)); vhi[i]=vtr(vp_+(((i)>>2)*4096+((i)&3)*1024+512)); }while(0)
  #define KRD(G,j) do{ if(G){ kload2(kf,kp0+sl_next,j); SBAR(); } }while(0)
  #define STEP(C0,C1,P0,P1,t,GK,GV,GL) do{ SBAR(); \
    LOADB1(C0,t,0); SBAR(); \
    const lds_cptr vp_=vp0+sl_prev; \
    VRD(0); SBAR(); float sacc=(P0[0]+P0[1]); \
    GAPA(C0=__builtin_amdgcn_mfma_f32_32x32x16_bf16(kf[0],qr[0],C0,0,0,0), P0[2],P0[3],P0[4],P0[5],     pw0[0]=PKW(P0,0), pw0[1]=PKW(P0,2), pw0); \
    LOADB1(C1,t,8); SBAR(); VRD(4); SBAR(); GAPA(C1=__builtin_amdgcn_mfma_f32_32x32x16_bf16(kf[1],qr[0],C1,0,0,0), P0[6],P0[7],P0[8],P0[9],     pw0[2]=PKW(P0,4), pw0[3]=PKW(P0,6), pw0); \
    VRD(1); SBAR(); GAPA(C0=__builtin_amdgcn_mfma_f32_32x32x16_bf16(kf[2],qr[1],C0,0,0,0),   P0[10],P0[11],P0[12],P0[13], pw1[0]=PKW(P0,8), pw1[1]=PKW(P0,10), pw1); \
    VRD(5); SBAR(); GAPA(C1=__builtin_amdgcn_mfma_f32_32x32x16_bf16(kf[3],qr[1],C1,0,0,0),   P0[14],P0[15],P1[0],P1[1],   pw1[2]=PKW(P0,12),pw1[3]=PKW(P0,14), pw1); \
    VRD(2); SBAR(); GAPA(C0=__builtin_amdgcn_mfma_f32_32x32x16_bf16(kf[4],qr[2],C0,0,0,0),   P1[2],P1[3],P1[4],P1[5],     pw2[0]=PKW(P1,0), pw2[1]=PKW(P1,2), pw2); \
    VRD(6); SBAR(); GAPA(C1=__builtin_amdgcn_mfma_f32_32x32x16_bf16(kf[5],qr[2],C1,0,0,0),   P1[6],P1[7],P1[8],P1[9],     pw2[2]=PKW(P1,4), pw2[3]=PKW(P1,6), pw2); \
    VRD(3); SBAR(); GAPA(C0=__builtin_amdgcn_mfma_f32_32x32x16_bf16(kf[6],qr[3],C0,0,0,0),   P1[10],P1[11],P1[12],P1[13], pw3[0]=PKW(P1,8), pw3[1]=PKW(P1,10), pw3); \
    VRD(7); SBAR(); GAPA(C1=__builtin_amdgcn_mfma_f32_32x32x16_bf16(kf[7],qr[3],C1,0,0,0),   P1[14],P1[15],0.f,0.f,       pw3[2]=PKW(P1,12),pw3[3]=PKW(P1,14), pw3); \
    l_reg+=sacc; \
    if(GK){DMA_K((t)+3,sl_cur);} if(GV){DMA_V((t)+1,sl_next);} \
    CMASK(C0,C1,t); \
    { float a=MX3(C0[0],C0[1],C1[0]),b=MX3(C0[2],C0[3],C1[1]); a=MX3(a,C1[2],C1[3]); \
      _Pragma("unroll") for(int r=4;r<16;r+=4){a=MX3(a,C0[r],C0[r+1]);b=MX3(b,C0[r+2],C0[r+3]);a=MX3(a,C1[r],C1[r+1]);b=MX3(b,C1[r+2],C1[r+3]);} \
      float rm=__builtin_fmaxf(a,b); { auto rr=__builtin_amdgcn_permlane32_swap(__float_as_uint(rm),__float_as_uint(rm),false,false); rm=__builtin_fmaxf(__uint_as_float(rr[0]),__uint_as_float(rr[1])); } \
      resc=false; \
      if(__builtin_expect(__any(rm>(float)THRL),0)){ const float dl=__builtin_fmaxf(rm,0.f); mhat+=dl; \
        _Pragma("unroll") for(int r=0;r<16;++r){C0[r]-=dl;C1[r]-=dl;} \
        const float f=__builtin_amdgcn_exp2f(-dl); l_reg*=f; if(hi==0)wsf[r32]=f; resc=true; } } \
    SBAR(); \
    GAPB(o[0]=__builtin_amdgcn_mfma_f32_32x32x16_bf16(PAF(0),VFR(0),o[0],0,0,0), C0,0); \
    GAPB(o[1]=__builtin_amdgcn_mfma_f32_32x32x16_bf16(PAF(0),VFR(4),o[1],0,0,0), C0,4); \
    KRD(GL,0); GAPB(o[0]=__builtin_amdgcn_mfma_f32_32x32x16_bf16(PAF(1),VFR(1),o[0],0,0,0), C0,8); \
    KRD(GL,1); GAPB(o[1]=__builtin_amdgcn_mfma_f32_32x32x16_bf16(PAF(1),VFR(5),o[1],0,0,0), C0,12); \
    KRD(GL,2); GAPB(o[0]=__builtin_amdgcn_mfma_f32_32x32x16_bf16(PAF(2),VFR(2),o[0],0,0,0), C1,0); \
    KRD(GL,3); GAPB(o[1]=__builtin_amdgcn_mfma_f32_32x32x16_bf16(PAF(2),VFR(6),o[1],0,0,0), C1,4); \
    GAPB(o[0]=__builtin_amdgcn_mfma_f32_32x32x16_bf16(PAF(3),VFR(3),o[0],0,0,0), C1,8); \
    GAPB(o[1]=__builtin_amdgcn_mfma_f32_32x32x16_bf16(PAF(3),VFR(7),o[1],0,0,0), C1,12); \
    }while(0)
  int t=1;
  #undef CMASK
  #define CMASK(P0,P1,t) do{}while(0)
  for(;t+5<NT;t+=2){
    STEP(pB0,pB1,pA0,pA1,t,true,true,true);     WAIT_BAR(2); RESC(); ROT();
    STEP(pA0,pA1,pB0,pB1,t+1,true,true,true);   WAIT_BAR(2); RESC(); ROT();
  }
  #undef CMASK
  #define CMASK(P0,P1,t) do{int jb_=(t)-(NT-4); if(jb_>=0)cmask(P0,P1,jb_,qrel,hi);}while(0)
  #define ENDW(tt) do{ if((tt)+3<NT){WAIT_BAR(2);} else if((tt)+2<NT){WAIT_BAR(1);} else {WAIT_BAR(0);} }while(0)
  for(;t+1<NT;t+=2){
    STEP(pB0,pB1,pA0,pA1,t,(t+3<NT),(t+1<NT),(t+1<NT));       ENDW(t);   RESC(); ROT();
    STEP(pA0,pA1,pB0,pB1,t+1,(t+4<NT),(t+2<NT),(t+2<NT));     ENDW(t+1); RESC(); ROT();
  }
  STEP(pB0,pB1,pA0,pA1,NT-1,false,false,false); RESC();
  { float sacc=pB0[0]+pB0[1]; _Pragma("unroll") for(int r=2;r<16;++r)sacc+=pB0[r]; _Pragma("unroll") for(int r=0;r<16;++r)sacc+=pB1[r]; l_reg+=sacc;
    pw0=(u32x4){PKW(pB0,0),PKW(pB0,2),PKW(pB0,4),PKW(pB0,6)};pw1=(u32x4){PKW(pB0,8),PKW(pB0,10),PKW(pB0,12),PKW(pB0,14)};pw2=(u32x4){PKW(pB1,0),PKW(pB1,2),PKW(pB1,4),PKW(pB1,6)};pw3=(u32x4){PKW(pB1,8),PKW(pB1,10),PKW(pB1,12),PKW(pB1,14)};
    SBAR(); pv(o,(int)(unsigned)(uintptr_t)vp0+sl_cur,PAF(0),PAF(1),PAF(2),PAF(3)); }
  #undef PKW
  #undef PAF
  #undef VFR
  #undef PIN
  #undef MX3
  #undef GAPA
  #undef GAPB
  #undef EX
  #undef VRD
  #undef KRD
  #undef STEP
  #undef ENDW
  {auto rr=__builtin_amdgcn_permlane32_swap(__float_as_uint(l_reg),__float_as_uint(l_reg),false,false);l_reg=__uint_as_float(rr[0])+__uint_as_float(rr[1]);}
  if(hi==0)wsf[32+r32]=l_reg;asm volatile("s_waitcnt lgkmcnt(0)":::"memory");
  float rli[16];
  #pragma unroll
  for(int r=0;r<16;++r)rli[r]=__builtin_amdgcn_rcpf(wsf[32+crow(r,hi)]);
  bf16*Ow=O+(rowbase+q0+wid*QBLK)*(long)odm+h*D;
  { bf16*stg=(bf16*)(shm+LDS_OST)+wid*2048;
    #pragma unroll
    for(int r=0;r<16;++r){const int orow=crow(r,hi);
      #pragma unroll
      for(int d0=0;d0<2;++d0)stg[orow*64+d0*32+r32]=__float2bfloat16(o[d0][r]*rli[r]);}
    asm volatile("s_waitcnt lgkmcnt(0)":::"memory");
    #pragma unroll
    for(int i=0;i<4;++i){const int row=i*8+(lane>>3),ch=lane&7; const u32x4 v=*(const u32x4*)(stg+row*64+ch*8); ATTN_STORE16(Ow+(long)row*odm+ch*8,v);} }
  asm volatile("s_waitcnt lgkmcnt(0)\n\ts_barrier":::"memory");
  #undef DMA_K
  #undef DMA_V
  #undef CMASK
  #undef LOADB
  #undef LOADB1
  #undef START
  #undef RESC
  #undef ROT
}
constexpr int ATTN_LDS_BYTES=LDS_BYTES;
struct AttnTensors { const bf16* Q; const bf16* K; const bf16* V; bf16* O; const float* cl; const float* ctot; const float* kpart; int odm; };
template<int THRL> __device__ __forceinline__ void attn_phase(char*lds,const AttnTensors&T,int G,int vcu,int tid){
  constexpr int NP=NHEAD*NQB/2;
  for(int L=vcu;L<2*NP;L+=G){ const int p=L%NP, s=p%(NQB/2), qb=(L<NP)?(NQB-1-s):s, h=(L<NP)?p/(NQB/2):((p/(NQB/2)+NHEAD/2)%NHEAD);
    attn_unit<THRL>(0,h,qb,T.Q,T.K,T.V,T.O,T.cl+(long)h*SEQ,T.ctot+(long)h*(SEQ/64),T.kpart,lds,tid,T.odm); }
}
#undef SBAR
#undef WAIT_BAR
}

namespace cg = cooperative_groups;
#define LAS __attribute__((address_space(3)))
typedef unsigned short bfr;
typedef unsigned v4u __attribute__((ext_vector_type(4)));
typedef float f32x4 __attribute__((ext_vector_type(4)));
constexpr int M = 16384, D = 1024, FF = 2816, NGU = 2 * FF, ZP = 3072, INC = 3080, NMEM = 256, NH = 8, CW = 512, DEPTH = 2;
constexpr float EPS = 1e-6f, LOG2E = 1.4426950408889634f;
constexpr size_t KiB = 1024, MiB = 1u << 20;
constexpr size_t WS_MEMN = 0, WS_KMEM = 512 * KiB, WS_VT = 1024 * KiB, WS_MEMKV_L = 1 * MiB;
constexpr size_t WS_CL = 3 * MiB, WS_CTOT = 3 * MiB + 512 * KiB, WS_WF = 3 * MiB + 768 * KiB, WS_KPART = 3 * MiB + 576 * KiB, WS_BAR = 3 * MiB + 640 * KiB, WS_PCNT = 3 * MiB + 656 * KiB,     WS_STATS = 4 * MiB;
constexpr size_t WS_W = 8 * MiB, W_LAYER = 49 * MiB;
constexpr size_t OFF_GU1 = 0, OFF_D1 = 11 * MiB, OFF_MI = 16 * MiB + 512 * KiB, OFF_MO = 22 * MiB + 512 * KiB, OFF_XQ = 24 * MiB + 512 * KiB, OFF_XKV = 26 * MiB + 512 * KiB,
                 OFF_XO = 30 * MiB + 512 * KiB, OFF_GU2 = 32 * MiB + 512 * KiB, OFF_D2 = 43 * MiB + 512 * KiB;
static_assert(OFF_D2 + (size_t)D * FF * 2 == W_LAYER && OFF_D1 == (size_t)NGU * D * 2, "weight map");
constexpr size_t WS_XB = 106 * MiB, WS_BIG = 138 * MiB, WS_END = 234 * MiB;
constexpr int RSTD_OFF = 139264;
constexpr int LDS_MISC = 155648 - 64;
constexpr int LDS_BYTES = 155648;
static_assert(attn_body::LDS_BYTES <= LDS_MISC && pg8::STAGE_BYTES <= LDS_MISC, "LDS map");
static_assert(attn_body::LDS_BYTES <= LDS_BYTES && pg8::STAGE_BYTES <= LDS_BYTES, "LDS map");

__device__ __forceinline__ float wave_sum(float v, int lane) {
#pragma unroll
    for (int o = 1; o < 64; o <<= 1) v += lane_get(v, lane ^ o);
    return v;
}
__device__ __forceinline__ unsigned f2bf(float f) { unsigned u = __builtin_bit_cast(unsigned, f); return (u + 0x7fffu + ((u >> 16) & 1u)) >> 16; }
__device__ __forceinline__ unsigned pk2(float lo, float hi) { return f2bf(lo) | (f2bf(hi) << 16); }
__device__ __forceinline__ float bf_lo(unsigned u) { return __builtin_bit_cast(float, u << 16); }
__device__ __forceinline__ float bf_hi(unsigned u) { return __builtin_bit_cast(float, u & 0xffff0000u); }

constexpr int TR_SCR_BYTES = 17408;
__device__ __forceinline__ void p0_transpose_item(const float* W, int srcN, int K, int ndst, bfr* WT, LAS float* scr, int item, int lane, const float* g, int mode, float wsc = 1.0f) {
    const int nblk = ndst / 64, kb = item / nblk, nb = item % nblk, k0 = 64 * kb, n0 = 64 * nb;
    int sc = n0; if (mode == 1) { const int tile = n0 >> 8, loc = n0 & 255; sc = (loc < 128) ? (tile * 128 + loc) : (FF + tile * 128 + loc - 128); }
    const float* src = W + (size_t)k0 * srcN + sc + lane;
    float v[64];
#pragma unroll
    for (int kk = 0; kk < 64; ++kk) v[kk] = src[(size_t)kk * srcN];
    if (g) {
#pragma unroll
        for (int kk = 0; kk < 64; ++kk) v[kk] *= g[k0 + kk] * wsc; }
    else if (wsc != 1.0f) {
#pragma unroll
        for (int kk = 0; kk < 64; ++kk) v[kk] *= wsc; }
#pragma unroll
    for (int kk = 0; kk < 64; ++kk) scr[kk * 65 + lane] = v[kk];
    asm volatile("s_waitcnt lgkmcnt(0)" ::: "memory");
    const int c = lane & 7;
#pragma unroll
    for (int j = 0; j < 8; ++j) { const int n = (lane >> 3) + 8 * j; const LAS float* s = scr + (8 * c) * 65 + n;
        v4u o; o.x = pk2(s[0 * 65], s[1 * 65]); o.y = pk2(s[2 * 65], s[3 * 65]); o.z = pk2(s[4 * 65], s[5 * 65]); o.w = pk2(s[6 * 65], s[7 * 65]);
        store16_wt(WT + (size_t)(n0 + n) * K + k0 + 8 * c, o); }
    asm volatile("s_waitcnt lgkmcnt(0)" ::: "memory");
}
struct In { const float* p[21]; };
constexpr int I_GU = (D / 64) * (NGU / 64), I_DN = (FF / 64) * (D / 64), I_MI = (D / 64) * (ZP / 64), I_SQ = (D / 64) * (D / 64), I_KV = (D / 64) * (2 * D / 64);
constexpr int PER_LAYER = 2 * I_GU + 2 * I_DN + I_MI + 3 * I_SQ + I_KV;
__device__ __forceinline__ void convert_mat_item(const In& in, unsigned char* ws, int l, int mat, int r, LAS float* scr, int lane) {
    unsigned char* wl = ws + WS_W + (size_t)l * W_LAYER;
    switch (mat) {
    case 0: p0_transpose_item(in.p[3] + (size_t)l * D * NGU, NGU, D, NGU, (bfr*)(wl + OFF_GU1), scr, r, lane, in.p[2] + l * D, 1); break;
    case 1: p0_transpose_item(in.p[4] + (size_t)l * FF * D, D, FF, D, (bfr*)(wl + OFF_D1), scr, r, lane, nullptr, 0, 0.5f); break;
    case 2: p0_transpose_item(in.p[6] + (size_t)l * D * INC, INC, D, ZP, (bfr*)(wl + OFF_MI), scr, r, lane, in.p[5] + l * D, 0); break;
    case 3: p0_transpose_item(in.p[11] + (size_t)l * D * D, D, D, D, (bfr*)(wl + OFF_MO), scr, r, lane, nullptr, 0); break;
    case 4: p0_transpose_item(in.p[14] + (size_t)l * D * D, D, D, D, (bfr*)(wl + OFF_XQ), scr, r, lane, in.p[12] + l * D, 0); break;
    case 5: p0_transpose_item(in.p[15] + (size_t)l * D * 2 * D, 2 * D, D, 2 * D, (bfr*)(wl + OFF_XKV), scr, r, lane, in.p[13] + l * D, 0); break;
    case 6: p0_transpose_item(in.p[16] + (size_t)l * D * D, D, D, D, (bfr*)(wl + OFF_XO), scr, r, lane, nullptr, 0); break;
    case 7: p0_transpose_item(in.p[18] + (size_t)l * D * NGU, NGU, D, NGU, (bfr*)(wl + OFF_GU2), scr, r, lane, in.p[17] + l * D, 1); break;
    default: p0_transpose_item(in.p[19] + (size_t)l * FF * D, D, FF, D, (bfr*)(wl + OFF_D2), scr, r, lane, nullptr, 0, 0.5f); break;
    }
}
template <int STAGE> __device__ __forceinline__ constexpr int stage_items() {
    return STAGE == 0 ? I_GU + I_KV : STAGE == 1 ? I_DN + I_MI + 3 * I_SQ + I_GU : STAGE == 2 ? 2 * I_DN + I_GU + I_KV : STAGE == 3 ? I_MI + 3 * I_SQ + I_GU : I_DN;
}
#define CV_TRY(L_, MAT_, CNT_) if (k < (CNT_)) { convert_mat_item(in, ws, L_, MAT_, k, scr, lane); return; } k -= (CNT_);
template <int STAGE> __device__ __forceinline__ void convert_stage_item(const In& in, unsigned char* ws, int k, LAS float* scr, int lane) {
    if constexpr (STAGE == 0) { CV_TRY(0, 0, I_GU) CV_TRY(0, 5, I_KV) }
    else if constexpr (STAGE == 1) { CV_TRY(0, 1, I_DN) CV_TRY(0, 2, I_MI) CV_TRY(0, 3, I_SQ) CV_TRY(0, 4, I_SQ) CV_TRY(0, 6, I_SQ) CV_TRY(0, 7, I_GU) }
    else if constexpr (STAGE == 2) { CV_TRY(0, 8, I_DN) CV_TRY(1, 0, I_GU) CV_TRY(1, 5, I_KV) CV_TRY(1, 1, I_DN) }
    else if constexpr (STAGE == 3) { CV_TRY(1, 2, I_MI) CV_TRY(1, 3, I_SQ) CV_TRY(1, 4, I_SQ) CV_TRY(1, 6, I_SQ) CV_TRY(1, 7, I_GU) }
    else { CV_TRY(1, 8, I_DN) }
}
#undef CV_TRY
static_assert(stage_items<0>() + stage_items<1>() + stage_items<2>() + stage_items<3>() + stage_items<4>() == 2 * PER_LAYER, "conversion schedule covers every item once");
template <int STAGE> __device__ __forceinline__ void convert_in_idle_slot(const In& in, unsigned char* ws, LAS unsigned char* lds, int bx, int G, int wave, int lane) {
    constexpr int NU = (M / 256) * (NGU / 256);
    const int r = NU % G, idx = ((r != 0) ? bx - r : bx) - 8, nl = ((r != 0) ? G - r : G) - 8;
    if (idx < 0 || nl <= 0) return;
    LAS float* scr = (LAS float*)(lds + wave * TR_SCR_BYTES);
    for (int it = idx * 8 + wave; it < stage_items<STAGE>(); it += nl * 8) convert_stage_item<STAGE>(in, ws, it, scr, lane);
}
__device__ __forceinline__ void prologue_phase(const In& in, float* out, unsigned char* ws, LAS unsigned char* lds, int gw, int NGW, int wave, int lane) {
    LAS float* scr = (LAS float*)(lds + wave * TR_SCR_BYTES);
    for (int it = gw; it < stage_items<0>(); it += NGW) convert_stage_item<0>(in, ws, it, scr, lane);
    float* wf = (float*)(ws + WS_WF);
    for (int i = gw * 64 + lane; i < DEPTH * NH * D; i += NGW * 64) { const int l = i / (NH * D), h = (i / D) % NH, k = i % D; wf[i] = in.p[5][l * D + k] * in.p[6][((size_t)l * D + k) * INC + ZP + h]; }
    for (int m = gw; m < NMEM; m += NGW) { const f32x4* xr = (const f32x4*)(in.p[1] + (size_t)m * D) + lane; f32x4 v[4]; float s = 0.f;
#pragma unroll
        for (int j = 0; j < 4; ++j) { v[j] = xr[64 * j]; s += (v[j].x * v[j].x + v[j].y * v[j].y) + (v[j].z * v[j].z + v[j].w * v[j].w); }
        const float rstd = rsqrtf(wave_sum(s, lane) * (1.f / D) + EPS); unsigned long long* o8 = (unsigned long long*)((bfr*)(ws + WS_MEMN) + (size_t)m * D) + lane;
#pragma unroll
        for (int j = 0; j < 4; ++j) o8[64 * j] = (unsigned long long)pk2(v[j].x * rstd, v[j].y * rstd) | ((unsigned long long)pk2(v[j].z * rstd, v[j].w * rstd) << 32); }
    for (int m0 = gw; m0 < M; m0 += 4 * NGW) { f32x4 v[4][4]; float s[4];
#pragma unroll
        for (int u = 0; u < 4; ++u) { const int m = m0 + u * NGW; const f32x4* xr = (const f32x4*)(in.p[0] + (size_t)(m < M ? m : m0) * D) + lane;
#pragma unroll
            for (int j = 0; j < 4; ++j) v[u][j] = xr[64 * j]; }
#pragma unroll
        for (int u = 0; u < 4; ++u) { const int m = m0 + u * NGW; s[u] = 0.f; unsigned long long* o8 = (unsigned long long*)((bfr*)(ws + WS_XB) + (size_t)(m < M ? m : m0) * D) + lane;
#pragma unroll
            for (int j = 0; j < 4; ++j) { s[u] += (v[u][j].x * v[u][j].x + v[u][j].y * v[u][j].y) + (v[u][j].z * v[u][j].z + v[u][j].w * v[u][j].w);
                if (m < M) o8[64 * j] = (unsigned long long)pk2(v[u][j].x, v[u][j].y) | ((unsigned long long)pk2(v[u][j].z, v[u][j].w) << 32); } }
#pragma unroll
        for (int o = 1; o < 64; o <<= 1) {
#pragma unroll
            for (int u = 0; u < 4; ++u) s[u] += lane_get(s[u], lane ^ o); }
#pragma unroll
        for (int u = 0; u < 4; ++u) { const int m = m0 + u * NGW; if (m < M && lane < 16) ((float*)(ws + WS_STATS))[(size_t)m * 16 + lane] = lane == 0 ? s[u] : 0.f; } }
}
__device__ __forceinline__ void norm_phase(const float* x, bfr* xb, int gw, int NGW, int lane, float* zero16) {
    if (zero16 && gw == 0 && lane < 16) zero16[lane] = 0.f;
    for (int m = gw; m < M; m += NGW) { const f32x4* xr = (const f32x4*)(x + (size_t)m * D) + lane; f32x4 v[4]; float s = 0.f;
#pragma unroll
        for (int j = 0; j < 4; ++j) { v[j] = xr[64 * j]; s += (v[j].x * v[j].x + v[j].y * v[j].y) + (v[j].z * v[j].z + v[j].w * v[j].w); }
        const float rstd = rsqrtf(wave_sum(s, lane) * (1.f / D) + EPS); unsigned long long* o8 = (unsigned long long*)(xb + (size_t)m * D) + lane;
#pragma unroll
        for (int j = 0; j < 4; ++j) o8[64 * j] = (unsigned long long)pk2(v[j].x * rstd, v[j].y * rstd) | ((unsigned long long)pk2(v[j].z * rstd, v[j].w * rstd) << 32); }
}
__device__ __forceinline__ void final_phase(const bfr* xbs, float* x, const float* g, int gw, int NGW, int lane) {
    const f32x4* gr = (const f32x4*)g + lane; f32x4 gv[4];
#pragma unroll
    for (int j = 0; j < 4; ++j) gv[j] = gr[64 * j];
    for (int m0 = gw; m0 < M; m0 += 4 * NGW) { f32x4 v[4][4]; float s[4];
#pragma unroll
        for (int u = 0; u < 4; ++u) { const int m = m0 + u * NGW; typedef unsigned u32x2 __attribute__((ext_vector_type(2))); const u32x2* xr = (const u32x2*)(xbs + (size_t)(m < M ? m : m0) * D) + lane;
#pragma unroll
            for (int j = 0; j < 4; ++j) { const u32x2 w = xr[64 * j]; v[u][j] = (f32x4){bf_lo(w.x), bf_hi(w.x), bf_lo(w.y), bf_hi(w.y)}; } }
#pragma unroll
        for (int u = 0; u < 4; ++u) { s[u] = 0.f;
#pragma unroll
            for (int j = 0; j < 4; ++j) s[u] += (v[u][j].x * v[u][j].x + v[u][j].y * v[u][j].y) + (v[u][j].z * v[u][j].z + v[u][j].w * v[u][j].w); }
#pragma unroll
        for (int o = 1; o < 64; o <<= 1) {
#pragma unroll
            for (int u = 0; u < 4; ++u) s[u] += lane_get(s[u], lane ^ o); }
#pragma unroll
        for (int u = 0; u < 4; ++u) { const int m = m0 + u * NGW; if (m < M) { const float rstd = rsqrtf(s[u] * (1.f / D) + EPS); f32x4* xr = (f32x4*)(x + (size_t)m * D) + lane;
#pragma unroll
            for (int j = 0; j < 4; ++j) xr[64 * j] = v[u][j] * rstd * gv[j]; } }
    }
}
__device__ __forceinline__ void fgate_phase(const bfr* x, const float* wf, const float* bfg, float* cl, float* ctot, LAS float* scr, int bx, int G, int tid, int lane, int wave) {
    for (int chunk = bx; chunk < M / 64; chunk += G) {
#pragma unroll 1
        for (int j = 0; j < 8; j += 2) { const int row = chunk * 64 + wave * 8 + j; typedef unsigned u32x2 __attribute__((ext_vector_type(2))); const u32x2* xa = (const u32x2*)(x + (size_t)row * D) + lane; const u32x2* xb2 = xa + D / 4; f32x4 va[4], vb[4]; float r[18]; int zo = 0; asm volatile("" : "+v"(zo));
#pragma unroll
            for (int jj = 0; jj < 4; ++jj) { const u32x2 wa = xa[64 * jj], wb = xb2[64 * jj]; va[jj] = (f32x4){bf_lo(wa.x), bf_hi(wa.x), bf_lo(wa.y), bf_hi(wa.y)}; vb[jj] = (f32x4){bf_lo(wb.x), bf_hi(wb.x), bf_lo(wb.y), bf_hi(wb.y)}; }
            r[16] = 0.f; r[17] = 0.f;
#pragma unroll
            for (int jj = 0; jj < 4; ++jj) { r[16] += (va[jj].x * va[jj].x + va[jj].y * va[jj].y) + (va[jj].z * va[jj].z + va[jj].w * va[jj].w); r[17] += (vb[jj].x * vb[jj].x + vb[jj].y * vb[jj].y) + (vb[jj].z * vb[jj].z + vb[jj].w * vb[jj].w); }
#pragma unroll
            for (int h = 0; h < NH; ++h) { const f32x4* wr = (const f32x4*)(wf + h * D) + lane + zo; float da = 0.f, db = 0.f;
#pragma unroll
                for (int jj = 0; jj < 4; ++jj) { const f32x4 w = wr[64 * jj]; da += (va[jj].x * w.x + va[jj].y * w.y) + (va[jj].z * w.z + va[jj].w * w.w); db += (vb[jj].x * w.x + vb[jj].y * w.y) + (vb[jj].z * w.z + vb[jj].w * w.w); }
                r[h] = da; r[8 + h] = db; }
#pragma unroll
            for (int o = 1; o < 64; o <<= 1) {
#pragma unroll
                for (int q = 0; q < 18; ++q) r[q] += lane_get(r[q], lane ^ o); }
            const float rsa = rsqrtf(r[16] * (1.f / D) + EPS), rsb = rsqrtf(r[17] * (1.f / D) + EPS);
            if (lane < 16) { const int h = lane & 7; float dsel = r[0];
#pragma unroll
                for (int q = 1; q < 16; ++q) dsel = (lane == q) ? r[q] : dsel;
                const float zz = dsel * (lane < 8 ? rsa : rsb) + bfg[h]; const float lf = fminf(zz, 0.f) - 0.6931471805599453f * __builtin_amdgcn_logf(1.0f + __builtin_amdgcn_exp2f(-LOG2E * fabsf(zz)));
                scr[(wave * 8 + j + (lane >> 3)) * 8 + h] = lf; } }
        __syncthreads();
        if (tid < NH) { float run = 0.f; for (int r = 0; r < 64; ++r) { run += scr[r * 8 + tid]; cl[(size_t)tid * M + chunk * 64 + r] = run; } ctot[tid * (M / 64) + chunk] = run; }
        __syncthreads();
    }
}
__device__ __forceinline__ void mixnorm_phase(bfr* z, const float* wconv, const float* gc, const float* ga, int p0, int pend, int pstep, int lane) {
    const int c8 = lane * 8; float w0[8], w1[8], w2[8], gcv[8], gav[8];
#pragma unroll
    for (int i = 0; i < 8; ++i) { w0[i] = wconv[c8 + i]; w1[i] = wconv[CW + c8 + i]; w2[i] = wconv[2 * CW + c8 + i]; gcv[i] = gc[c8 + i]; gav[i] = ga[c8 + i]; }
    for (int p = p0; p < pend; p += pstep) { const int r0 = 2 * p; bfr* zr = z + (size_t)r0 * ZP; const v4u z4 = {0u, 0u, 0u, 0u};
        const v4u zbA = *(const v4u*)(zr + c8), zbB = *(const v4u*)(zr + ZP + c8), oA = *(const v4u*)(zr + 3 * CW + c8), oB = *(const v4u*)(zr + ZP + 3 * CW + c8);
        const v4u cc0 = *(const v4u*)(zr + CW + c8), vv0 = *(const v4u*)(zr + 2 * CW + c8), cc1 = *(const v4u*)(zr + ZP + CW + c8), vv1 = *(const v4u*)(zr + ZP + 2 * CW + c8);
        const v4u cm1 = r0 >= 2 ? *(const v4u*)(zr - ZP + CW + c8) : z4, vm1 = r0 >= 2 ? *(const v4u*)(zr - ZP + 2 * CW + c8) : z4;
        const v4u cm2 = r0 >= 2 ? *(const v4u*)(zr - 2 * ZP + CW + c8) : z4, vm2 = r0 >= 2 ? *(const v4u*)(zr - 2 * ZP + 2 * CW + c8) : z4;
        float yA[8], yB[8], pA[8], pB[8]; float s4[4] = {0.f, 0.f, 0.f, 0.f};
#pragma unroll
        for (int q = 0; q < 4; ++q) {
            { const float um2 = bf_lo(cm2[q]) * bf_lo(vm2[q]), um1 = bf_lo(cm1[q]) * bf_lo(vm1[q]), u0 = bf_lo(cc0[q]) * bf_lo(vv0[q]), u1 = bf_lo(cc1[q]) * bf_lo(vv1[q]);
              const float a = bf_lo(zbA[q]) * (w0[2 * q] * um2 + w1[2 * q] * um1 + w2[2 * q] * u0), b = bf_lo(zbB[q]) * (w0[2 * q] * um1 + w1[2 * q] * u0 + w2[2 * q] * u1);
              yA[2 * q] = a; yB[2 * q] = b; s4[0] += a * a; s4[1] += b * b; const float e = bf_lo(oA[q]), f = bf_lo(oB[q]); pA[2 * q] = e; pB[2 * q] = f; s4[2] += e * e; s4[3] += f * f; }
            { const float um2 = bf_hi(cm2[q]) * bf_hi(vm2[q]), um1 = bf_hi(cm1[q]) * bf_hi(vm1[q]), u0 = bf_hi(cc0[q]) * bf_hi(vv0[q]), u1 = bf_hi(cc1[q]) * bf_hi(vv1[q]);
              const float a = bf_hi(zbA[q]) * (w0[2 * q + 1] * um2 + w1[2 * q + 1] * um1 + w2[2 * q + 1] * u0), b = bf_hi(zbB[q]) * (w0[2 * q + 1] * um1 + w1[2 * q + 1] * u0 + w2[2 * q + 1] * u1);
              yA[2 * q + 1] = a; yB[2 * q + 1] = b; s4[0] += a * a; s4[1] += b * b; const float e = bf_hi(oA[q]), f = bf_hi(oB[q]); pA[2 * q + 1] = e; pB[2 * q + 1] = f; s4[2] += e * e; s4[3] += f * f; } }
#pragma unroll
        for (int o = 1; o < 64; o <<= 1) {
#pragma unroll
            for (int u = 0; u < 4; ++u) s4[u] += lane_get(s4[u], lane ^ o); }
        const float rcA = rsqrtf(s4[0] * (1.f / CW) + EPS), rcB = rsqrtf(s4[1] * (1.f / CW) + EPS), raA = rsqrtf(s4[2] * (1.f / CW) + EPS), raB = rsqrtf(s4[3] * (1.f / CW) + EPS);
        v4u ocA, ocB, oaA, oaB;
#pragma unroll
        for (int q = 0; q < 4; ++q) { ocA[q] = pk2(yA[2 * q] * rcA * gcv[2 * q], yA[2 * q + 1] * rcA * gcv[2 * q + 1]); ocB[q] = pk2(yB[2 * q] * rcB * gcv[2 * q], yB[2 * q + 1] * rcB * gcv[2 * q + 1]);
            oaA[q] = pk2(pA[2 * q] * raA * gav[2 * q], pA[2 * q + 1] * raA * gav[2 * q + 1]); oaB[q] = pk2(pB[2 * q] * raB * gav[2 * q], pB[2 * q + 1] * raB * gav[2 * q + 1]); }
        store16_wt(zr + 4 * CW + c8, ocA); store16_wt(zr + 5 * CW + c8, oaA); store16_wt(zr + ZP + 4 * CW + c8, ocB); store16_wt(zr + ZP + 5 * CW + c8, oaB); }
}

#define XB_TMO      128
#define XB_XCNT(j)  (256  + 64 * (j))
#define XB_XSUB(j)  (1280 + 64 * (j))
#define XB_XGEN(j)  (2304 + 64 * (j))
#define XB_TOP      3328
#define XB_TOPGEN   3392
#define XCD_BAR_WORDS 3456
#define XB_SPIN_CAP (1u << 18)

__device__ __forceinline__ unsigned xb_ld(unsigned* p)              { return __hip_atomic_load(p, __ATOMIC_RELAXED, __HIP_MEMORY_SCOPE_AGENT); }
__device__ __forceinline__ unsigned xb_add(unsigned* p, unsigned v) { return __hip_atomic_fetch_add(p, v, __ATOMIC_RELAXED, __HIP_MEMORY_SCOPE_AGENT); }
__device__ __forceinline__ unsigned xb_xcc_id() { return (unsigned)__builtin_amdgcn_s_getreg((3 << 11) | 20) & 0xFu; }
#define XB_SPIN(cond, bar) do { unsigned _sp = 0; while (cond) { __builtin_amdgcn_s_sleep(1); \
    if ((++_sp & 255u) == 0u) { if (xb_ld(&(bar)[XB_TMO])) break; if (_sp > XB_SPIN_CAP) { atomicAdd(&(bar)[XB_TMO], 1u); break; } } } } while (0)

struct XcdBarrier {
    unsigned* bar; unsigned x;
    volatile LAS unsigned* st;
};

__device__ __forceinline__ XcdBarrier xcd_barrier_post(unsigned* bar, volatile LAS unsigned* st) {
    XcdBarrier b; b.bar = bar; b.x = xb_xcc_id(); b.st = st;
    if (threadIdx.x == 0) (void)xb_add(&bar[XB_XCNT(b.x)], 1u);
    return b;
}
__device__ __forceinline__ void xcd_barrier_complete(unsigned* bar, unsigned x, unsigned& nloc, unsigned& nx) {
    const unsigned G = gridDim.x * gridDim.y * gridDim.z;
    unsigned sum, cnt, mine, sp = 0u;
    for (;;) {
        sum = 0u; cnt = 0u; mine = 0u;
#pragma unroll
        for (unsigned j = 0; j < 16; ++j) { const unsigned c = xb_ld(&bar[XB_XCNT(j)]); sum += c; cnt += (c > 0u) ? 1u : 0u; mine = (j == x) ? c : mine; }
        if (sum == G) break;
        __builtin_amdgcn_s_sleep(1);
        if ((++sp & 255u) == 0u) { if (xb_ld(&bar[XB_TMO])) break; if (sp > XB_SPIN_CAP) { atomicAdd(&bar[XB_TMO], 1u); break; } }
    }
    nloc = mine > 0u ? mine : 1u; nx = cnt > 0u ? cnt : 1u;
}

template <bool FLUSH> __device__ __forceinline__ void xcd_barrier(const XcdBarrier& b) {
    asm volatile("s_waitcnt vmcnt(0)" ::: "memory");
    __syncthreads();
    if (threadIdx.x == 0) {
        unsigned* bar = b.bar;
        __builtin_amdgcn_s_waitcnt(0);
        unsigned nloc = b.st[0], nx = b.st[1];
        if (nloc == 0u) { xcd_barrier_complete(bar, b.x, nloc, nx); b.st[0] = nloc; b.st[1] = nx; }
        const unsigned old = xb_add(&bar[XB_XSUB(b.x)], 1u);
        const unsigned gen = old / nloc;
        if (old + 1u == (gen + 1u) * nloc) {
            if (FLUSH) __builtin_amdgcn_fence(__ATOMIC_RELEASE, "agent");
            asm volatile("s_waitcnt vmcnt(0)" ::: "memory");
            const unsigned og = xb_add(&bar[XB_TOP], 1u);
            const unsigned tg = og / nx;
            if (og + 1u == (tg + 1u) * nx) xb_add(&bar[XB_TOPGEN], 1u);
            else XB_SPIN(xb_ld(&bar[XB_TOPGEN]) == tg, bar);
            __builtin_amdgcn_fence(__ATOMIC_ACQUIRE, "agent");
            xb_add(&bar[XB_XGEN(b.x)], 1u);
            asm volatile("s_waitcnt vmcnt(0)" ::: "memory");
        } else {
            XB_SPIN(xb_ld(&bar[XB_XGEN(b.x)]) == gen, bar);
            __builtin_amdgcn_fence(__ATOMIC_ACQUIRE, "agent");
            asm volatile("s_waitcnt vmcnt(0)" ::: "memory");
        }
    }
    __syncthreads();
}

__device__ __forceinline__ int opaque_s(int v, int z) { return __builtin_amdgcn_readfirstlane(v + z); }
template <class T> __device__ __forceinline__ T* opaque_p(T* p, int z) { return (T*)((unsigned char*)p + (size_t)(unsigned)__builtin_amdgcn_readfirstlane(z)); }
__device__ __forceinline__ void panel_sync(unsigned* w) {
    asm volatile("s_waitcnt vmcnt(0)" ::: "memory"); __syncthreads();
    if (threadIdx.x == 0) { __hip_atomic_fetch_add(w, 1u, __ATOMIC_RELAXED, __HIP_MEMORY_SCOPE_AGENT); unsigned sp = 0;
        while (__hip_atomic_load(w, __ATOMIC_RELAXED, __HIP_MEMORY_SCOPE_AGENT) < 4u) { __builtin_amdgcn_s_sleep(1); if (++sp > (1u << 22)) break; }
        __builtin_amdgcn_fence(__ATOMIC_ACQUIRE, "agent"); asm volatile("s_waitcnt vmcnt(0)" ::: "memory"); }
    __syncthreads();
}
struct Args { const float* in[21]; float* out; unsigned char* ws; int ph_lo, ph_hi; };
constexpr int NPH = 1 + DEPTH * 8 + 1;
#ifndef MK_ONE_LAUNCH
#define MK_ONE_LAUNCH 1
#endif
__global__ void __launch_bounds__(512, 2) mk_fwd(Args a) {
    extern __shared__ __attribute__((aligned(16))) unsigned char lds_raw[];
    LAS unsigned char* lds = (LAS unsigned char*)lds_raw;
    const int lo = a.ph_lo, hi = a.ph_hi; int ph = 0;
    if (threadIdx.x < 16) ((LAS unsigned*)(lds + LDS_MISC))[threadIdx.x] = 0u;
    __syncthreads();
    XcdBarrier xbar; xbar.bar = nullptr; xbar.x = 0; xbar.st = nullptr;
    if (hi - lo > 1) xbar = xcd_barrier_post((unsigned*)(a.ws + WS_BAR), (volatile LAS unsigned*)(lds + LDS_MISC));
    if (hi < 0) cg::this_grid().sync();
#define PH_BEGIN if (ph >= lo && ph < hi) { int tid = threadIdx.x, zz_ = 0; asm volatile("" : "+v"(tid), "+v"(zz_)); \
    unsigned char* const ws = opaque_p(a.ws, zz_); float* const out = opaque_p(a.out, zz_); const int G = opaque_s((int)gridDim.x, zz_), bx = opaque_s((int)blockIdx.x, zz_); \
    const int lane = tid & 63, wave = __builtin_amdgcn_readfirstlane(tid >> 6), vcu = (G % 8 == 0) ? (bx % 8) * (G / 8) + bx / 8 : bx, gw = bx * 8 + wave, NGW = G * 8; \
    (void)lane; (void)vcu; (void)gw; (void)NGW; \
    bfr* const xb = (bfr*)(ws + WS_XB); bfr* const big = (bfr*)(ws + WS_BIG); bfr* const memn = (bfr*)(ws + WS_MEMN); \
    bfr* const act = big; bfr* const z = big; bfr* const qx = big; bfr* const Pb = big + (size_t)M * D; bfr* const ox = big + 2 * (size_t)M * D; \
    float* const cl = (float*)(ws + WS_CL); float* const ctot = (float*)(ws + WS_CTOT); float* const stats = (float*)(ws + WS_STATS); (void)stats; \
    const unsigned char* const wl = ws + WS_W + (size_t)l * W_LAYER; bfr* const kmem = (bfr*)(ws + WS_KMEM + (size_t)l * WS_MEMKV_L); bfr* const vt = (bfr*)(ws + WS_VT + (size_t)l * WS_MEMKV_L); \
    (void)xb; (void)memn; (void)act; (void)z; (void)qx; (void)Pb; (void)ox; (void)cl; (void)ctot; (void)wl; (void)kmem; (void)vt;
#define PH_END    if (ph + 1 < hi) xcd_barrier<true>(xbar); } ++ph;
#define PH_END_NF if (ph + 1 < hi) xcd_barrier<false>(xbar); } ++ph;
    using pg8::Gemm; using pg8::StaticOrder; using pg8::gemm_phase;

    { const int l = 0; PH_BEGIN { In in;
#pragma unroll
        for (int i = 0; i < 21; ++i) in.p[i] = a.in[i];
        prologue_phase(in, out, ws, lds, gw, NGW, wave, lane); } PH_END }

    { constexpr int l = 0; constexpr int f = 0;
            PH_BEGIN {
                const Gemm g{xb, (const bfr*)(wl + (f ? OFF_GU2 : OFF_GU1)), M, NGU, D, D, D, 0, 256L * D}; StaticOrder S; S.init(M, NGU, G, bx);
                const pg8::EpiSwiglu E{act, FF, (const LAS float*)(lds + RSTD_OFF)}; pg8::fill_rstd_table((LAS float*)(lds + RSTD_OFF), stats, S, tid);
                if (f == 0 && bx == 0 && tid < 16) __hip_atomic_store((unsigned*)(ws + WS_KPART) + tid, 0u, __ATOMIC_RELAXED, __HIP_MEMORY_SCOPE_AGENT);
                gemm_phase<pg8::EpiSwiglu, StaticOrder, true, true>(lds, g, S, E, tid);
                { In in;
#pragma unroll
                    for (int i = 0; i < 21; ++i) in.p[i] = a.in[i];
                    convert_in_idle_slot<1 + 2 * l + f>(in, ws, lds, bx, G, wave, lane); __syncthreads(); }
                if (f == 0) {
                    const Gemm gk{memn, (const bfr*)(wl + OFF_XKV), NMEM, D, D, D, D, 0, 256L * D}; StaticOrder Sk; Sk.init(NMEM, D, G, (bx + G - 128 % G) % G);
                    const pg8::EpiScaleBf16 Ek{kmem, D, 1.f, 0, 0, 1.f, nullptr, true};
                    gemm_phase<pg8::EpiScaleBf16, StaticOrder, true, true>(lds, gk, Sk, Ek, tid);
                    const Gemm gv{(const bfr*)(wl + OFF_XKV) + (size_t)D * D, memn, D, NMEM, D, D, D, 0, 256L * D}; StaticOrder Sv; Sv.init(D, NMEM, G, (bx + G - 132 % G) % G);
                    const pg8::EpiScaleBf16 Ev{vt, NMEM, 1.f, 0, 0, 1.f, nullptr, true};
                    gemm_phase<pg8::EpiScaleBf16, StaticOrder, true, true>(lds, gv, Sv, Ev, tid);
                } } PH_END_NF
            PH_BEGIN {
                const Gemm g{act, (const bfr*)(wl + (f ? OFF_D2 : OFF_D1)), M, D, FF, FF, FF, 0, 256L * FF}; StaticOrder S; S.init(M, D, G, bx);
                const pg8::EpiResid E{xb, D, stats};
                gemm_phase<pg8::EpiResid, StaticOrder, true, true>(lds, g, S, E, tid); } PH_END_NF
            if (f == 0) {
                PH_BEGIN {
                    const Gemm g{xb, (const bfr*)(wl + OFF_MI), M, ZP, D, D, D, 0, 256L * D}; StaticOrder S; S.init(M, ZP, G, bx);
                    const pg8::EpiMixIn E{z, ZP, attn_body::C2, (float*)(ws + WS_KPART), (const LAS float*)(lds + RSTD_OFF)}; pg8::fill_rstd_table((LAS float*)(lds + RSTD_OFF), stats, S, tid);
                    gemm_phase<pg8::EpiMixIn, StaticOrder, true, true>(lds, g, S, E, tid);
                    fgate_phase(xb, (const float*)(ws + WS_WF) + (size_t)l * NH * D, a.in[8] + l * NH, cl, ctot, (LAS float*)lds, bx, G, tid, lane, wave);
                    } PH_END
                PH_BEGIN {
                    const attn_body::AttnTensors AT{(const attn_body::bf16*)(z + 3 * CW), (const attn_body::bf16*)(z + 4 * CW), (const attn_body::bf16*)(z + 5 * CW), (attn_body::bf16*)(z + 3 * CW), cl, ctot, (const float*)(ws + WS_KPART), ZP};
                    attn_body::attn_phase<32>((char*)lds_raw, AT, G, vcu, tid);
                    } PH_END_NF
                PH_BEGIN {
                    const Gemm g{z + 4 * CW, (const bfr*)(wl + OFF_MO), M, D, D, ZP, D, 0, 256L * D}; StaticOrder S; S.init(M, D, G, bx);
                    { pg8::Unit u0; if (S.next(0, u0)) { const int pb = (u0.pm * 256 + u0.pn * 64) / 2;
                        mixnorm_phase(z, a.in[7] + (size_t)l * 3 * CW, a.in[9] + l * CW, a.in[10] + l * CW, pb + wave, pb + 32, 8, lane);
                        panel_sync((unsigned*)(ws + WS_PCNT) + (2 * l + 0) * 4096 + 64 * u0.pm); } }
                    const pg8::EpiResid E{xb, D, stats};
                    gemm_phase<pg8::EpiResid, StaticOrder, true, true>(lds, g, S, E, tid); } PH_END_NF
                PH_BEGIN {
                    const Gemm g{xb, (const bfr*)(wl + OFF_XQ), M, D, D, D, D, 0, 256L * D}; StaticOrder S; S.init(M, D, G, bx);
                    const pg8::EpiScaleBf16 E{qx, D, 0.0625f * LOG2E, 0, 0, 1.f, stats, false};
                    gemm_phase<pg8::EpiScaleBf16, StaticOrder, true, true>(lds, g, S, E, tid);
                    asm volatile("s_waitcnt vmcnt(0)" ::: "memory"); __syncthreads(); if (tid == 0) { __builtin_amdgcn_fence(__ATOMIC_ACQUIRE, "agent"); asm volatile("s_waitcnt vmcnt(0)" ::: "memory"); } __syncthreads();
                    const Gemm gs{qx, kmem, M, D, 256, D, D, 256, 256};
                    const pg8::EpiSoftmax Es{Pb, D};
                    gemm_phase<pg8::EpiSoftmax, StaticOrder, false, true>(lds, gs, S, Es, tid);
                    asm volatile("s_waitcnt vmcnt(0)" ::: "memory"); __syncthreads(); if (tid == 0) { __builtin_amdgcn_fence(__ATOMIC_ACQUIRE, "agent"); asm volatile("s_waitcnt vmcnt(0)" ::: "memory"); } __syncthreads();
                    const Gemm go{Pb, vt, M, D, 256, D, 256, 256, 256L * 256};
                    const pg8::EpiScaleBf16 Eo{ox, D, 1.f, 0, 0, 1.f, nullptr, true};
                    gemm_phase<pg8::EpiScaleBf16, StaticOrder, true, true>(lds, go, S, Eo, tid);
                    { pg8::Unit u0; if (S.next(0, u0)) panel_sync((unsigned*)(ws + WS_PCNT) + (2 * l + 1) * 4096 + 64 * u0.pm); }
                    const Gemm gx{ox, (const bfr*)(wl + OFF_XO), M, D, D, D, D, 0, 256L * D};
                    const pg8::EpiResid Ex{xb, D, stats};
                    gemm_phase<pg8::EpiResid, StaticOrder, true, true>(lds, gx, S, Ex, tid); } PH_END
            }
    }
    { constexpr int l = 0; constexpr int f = 1;
            PH_BEGIN {
                const Gemm g{xb, (const bfr*)(wl + (f ? OFF_GU2 : OFF_GU1)), M, NGU, D, D, D, 0, 256L * D}; StaticOrder S; S.init(M, NGU, G, bx);
                const pg8::EpiSwiglu E{act, FF, (const LAS float*)(lds + RSTD_OFF)}; pg8::fill_rstd_table((LAS float*)(lds + RSTD_OFF), stats, S, tid);
                if (f == 0 && bx == 0 && tid < 16) __hip_atomic_store((unsigned*)(ws + WS_KPART) + tid, 0u, __ATOMIC_RELAXED, __HIP_MEMORY_SCOPE_AGENT);
                gemm_phase<pg8::EpiSwiglu, StaticOrder, true, true>(lds, g, S, E, tid);
                { In in;
#pragma unroll
                    for (int i = 0; i < 21; ++i) in.p[i] = a.in[i];
                    convert_in_idle_slot<1 + 2 * l + f>(in, ws, lds, bx, G, wave, lane); __syncthreads(); }
                if (f == 0) {
                    const Gemm gk{memn, (const bfr*)(wl + OFF_XKV), NMEM, D, D, D, D, 0, 256L * D}; StaticOrder Sk; Sk.init(NMEM, D, G, (bx + G - 128 % G) % G);
                    const pg8::EpiScaleBf16 Ek{kmem, D, 1.f, 0, 0, 1.f, nullptr, true};
                    gemm_phase<pg8::EpiScaleBf16, StaticOrder, true, true>(lds, gk, Sk, Ek, tid);
                    const Gemm gv{(const bfr*)(wl + OFF_XKV) + (size_t)D * D, memn, D, NMEM, D, D, D, 0, 256L * D}; StaticOrder Sv; Sv.init(D, NMEM, G, (bx + G - 132 % G) % G);
                    const pg8::EpiScaleBf16 Ev{vt, NMEM, 1.f, 0, 0, 1.f, nullptr, true};
                    gemm_phase<pg8::EpiScaleBf16, StaticOrder, true, true>(lds, gv, Sv, Ev, tid);
                } } PH_END_NF
            PH_BEGIN {
                const Gemm g{act, (const bfr*)(wl + (f ? OFF_D2 : OFF_D1)), M, D, FF, FF, FF, 0, 256L * FF}; StaticOrder S; S.init(M, D, G, bx);
                const pg8::EpiResid E{xb, D, stats};
                gemm_phase<pg8::EpiResid, StaticOrder, true, true>(lds, g, S, E, tid); } PH_END_NF
            if (f == 0) {
                PH_BEGIN {
                    const Gemm g{xb, (const bfr*)(wl + OFF_MI), M, ZP, D, D, D, 0, 256L * D}; StaticOrder S; S.init(M, ZP, G, bx);
                    const pg8::EpiMixIn E{z, ZP, attn_body::C2, (float*)(ws + WS_KPART), (const LAS float*)(lds + RSTD_OFF)}; pg8::fill_rstd_table((LAS float*)(lds + RSTD_OFF), stats, S, tid);
                    gemm_phase<pg8::EpiMixIn, StaticOrder, true, true>(lds, g, S, E, tid);
                    fgate_phase(xb, (const float*)(ws + WS_WF) + (size_t)l * NH * D, a.in[8] + l * NH, cl, ctot, (LAS float*)lds, bx, G, tid, lane, wave);
                    } PH_END
                PH_BEGIN {
                    const attn_body::AttnTensors AT{(const attn_body::bf16*)(z + 3 * CW), (const attn_body::bf16*)(z + 4 * CW), (const attn_body::bf16*)(z + 5 * CW), (attn_body::bf16*)(z + 3 * CW), cl, ctot, (const float*)(ws + WS_KPART), ZP};
                    attn_body::attn_phase<32>((char*)lds_raw, AT, G, vcu, tid);
                    } PH_END_NF
                PH_BEGIN {
                    const Gemm g{z + 4 * CW, (const bfr*)(wl + OFF_MO), M, D, D, ZP, D, 0, 256L * D}; StaticOrder S; S.init(M, D, G, bx);
                    { pg8::Unit u0; if (S.next(0, u0)) { const int pb = (u0.pm * 256 + u0.pn * 64) / 2;
                        mixnorm_phase(z, a.in[7] + (size_t)l * 3 * CW, a.in[9] + l * CW, a.in[10] + l * CW, pb + wave, pb + 32, 8, lane);
                        panel_sync((unsigned*)(ws + WS_PCNT) + (2 * l + 0) * 4096 + 64 * u0.pm); } }
                    const pg8::EpiResid E{xb, D, stats};
                    gemm_phase<pg8::EpiResid, StaticOrder, true, true>(lds, g, S, E, tid); } PH_END_NF
                PH_BEGIN {
                    const Gemm g{xb, (const bfr*)(wl + OFF_XQ), M, D, D, D, D, 0, 256L * D}; StaticOrder S; S.init(M, D, G, bx);
                    const pg8::EpiScaleBf16 E{qx, D, 0.0625f * LOG2E, 0, 0, 1.f, stats, false};
                    gemm_phase<pg8::EpiScaleBf16, StaticOrder, true, true>(lds, g, S, E, tid);
                    asm volatile("s_waitcnt vmcnt(0)" ::: "memory"); __syncthreads(); if (tid == 0) { __builtin_amdgcn_fence(__ATOMIC_ACQUIRE, "agent"); asm volatile("s_waitcnt vmcnt(0)" ::: "memory"); } __syncthreads();
                    const Gemm gs{qx, kmem, M, D, 256, D, D, 256, 256};
                    const pg8::EpiSoftmax Es{Pb, D};
                    gemm_phase<pg8::EpiSoftmax, StaticOrder, false, true>(lds, gs, S, Es, tid);
                    asm volatile("s_waitcnt vmcnt(0)" ::: "memory"); __syncthreads(); if (tid == 0) { __builtin_amdgcn_fence(__ATOMIC_ACQUIRE, "agent"); asm volatile("s_waitcnt vmcnt(0)" ::: "memory"); } __syncthreads();
                    const Gemm go{Pb, vt, M, D, 256, D, 256, 256, 256L * 256};
                    const pg8::EpiScaleBf16 Eo{ox, D, 1.f, 0, 0, 1.f, nullptr, true};
                    gemm_phase<pg8::EpiScaleBf16, StaticOrder, true, true>(lds, go, S, Eo, tid);
                    { pg8::Unit u0; if (S.next(0, u0)) panel_sync((unsigned*)(ws + WS_PCNT) + (2 * l + 1) * 4096 + 64 * u0.pm); }
                    const Gemm gx{ox, (const bfr*)(wl + OFF_XO), M, D, D, D, D, 0, 256L * D};
                    const pg8::EpiResid Ex{xb, D, stats};
                    gemm_phase<pg8::EpiResid, StaticOrder, true, true>(lds, gx, S, Ex, tid); } PH_END
            }
    }
    { constexpr int l = 1; constexpr int f = 0;
            PH_BEGIN {
                const Gemm g{xb, (const bfr*)(wl + (f ? OFF_GU2 : OFF_GU1)), M, NGU, D, D, D, 0, 256L * D}; StaticOrder S; S.init(M, NGU, G, bx);
                const pg8::EpiSwiglu E{act, FF, (const LAS float*)(lds + RSTD_OFF)}; pg8::fill_rstd_table((LAS float*)(lds + RSTD_OFF), stats, S, tid);
                if (f == 0 && bx == 0 && tid < 16) __hip_atomic_store((unsigned*)(ws + WS_KPART) + tid, 0u, __ATOMIC_RELAXED, __HIP_MEMORY_SCOPE_AGENT);
                gemm_phase<pg8::EpiSwiglu, StaticOrder, true, true>(lds, g, S, E, tid);
                { In in;
#pragma unroll
                    for (int i = 0; i < 21; ++i) in.p[i] = a.in[i];
                    convert_in_idle_slot<1 + 2 * l + f>(in, ws, lds, bx, G, wave, lane); __syncthreads(); }
                if (f == 0) {
                    const Gemm gk{memn, (const bfr*)(wl + OFF_XKV), NMEM, D, D, D, D, 0, 256L * D}; StaticOrder Sk; Sk.init(NMEM, D, G, (bx + G - 128 % G) % G);
                    const pg8::EpiScaleBf16 Ek{kmem, D, 1.f, 0, 0, 1.f, nullptr, true};
                    gemm_phase<pg8::EpiScaleBf16, StaticOrder, true, true>(lds, gk, Sk, Ek, tid);
                    const Gemm gv{(const bfr*)(wl + OFF_XKV) + (size_t)D * D, memn, D, NMEM, D, D, D, 0, 256L * D}; StaticOrder Sv; Sv.init(D, NMEM, G, (bx + G - 132 % G) % G);
                    const pg8::EpiScaleBf16 Ev{vt, NMEM, 1.f, 0, 0, 1.f, nullptr, true};
                    gemm_phase<pg8::EpiScaleBf16, StaticOrder, true, true>(lds, gv, Sv, Ev, tid);
                } } PH_END_NF
            PH_BEGIN {
                const Gemm g{act, (const bfr*)(wl + (f ? OFF_D2 : OFF_D1)), M, D, FF, FF, FF, 0, 256L * FF}; StaticOrder S; S.init(M, D, G, bx);
                const pg8::EpiResid E{xb, D, stats};
                gemm_phase<pg8::EpiResid, StaticOrder, true, true>(lds, g, S, E, tid); } PH_END_NF
            if (f == 0) {
                PH_BEGIN {
                    const Gemm g{xb, (const bfr*)(wl + OFF_MI), M, ZP, D, D, D, 0, 256L * D}; StaticOrder S; S.init(M, ZP, G, bx);
                    const pg8::EpiMixIn E{z, ZP, attn_body::C2, (float*)(ws + WS_KPART), (const LAS float*)(lds + RSTD_OFF)}; pg8::fill_rstd_table((LAS float*)(lds + RSTD_OFF), stats, S, tid);
                    gemm_phase<pg8::EpiMixIn, StaticOrder, true, true>(lds, g, S, E, tid);
                    fgate_phase(xb, (const float*)(ws + WS_WF) + (size_t)l * NH * D, a.in[8] + l * NH, cl, ctot, (LAS float*)lds, bx, G, tid, lane, wave);
                    } PH_END
                PH_BEGIN {
                    const attn_body::AttnTensors AT{(const attn_body::bf16*)(z + 3 * CW), (const attn_body::bf16*)(z + 4 * CW), (const attn_body::bf16*)(z + 5 * CW), (attn_body::bf16*)(z + 3 * CW), cl, ctot, (const float*)(ws + WS_KPART), ZP};
                    attn_body::attn_phase<32>((char*)lds_raw, AT, G, vcu, tid);
                    } PH_END_NF
                PH_BEGIN {
                    const Gemm g{z + 4 * CW, (const bfr*)(wl + OFF_MO), M, D, D, ZP, D, 0, 256L * D}; StaticOrder S; S.init(M, D, G, bx);
                    { pg8::Unit u0; if (S.next(0, u0)) { const int pb = (u0.pm * 256 + u0.pn * 64) / 2;
                        mixnorm_phase(z, a.in[7] + (size_t)l * 3 * CW, a.in[9] + l * CW, a.in[10] + l * CW, pb + wave, pb + 32, 8, lane);
                        panel_sync((unsigned*)(ws + WS_PCNT) + (2 * l + 0) * 4096 + 64 * u0.pm); } }
                    const pg8::EpiResid E{xb, D, stats};
                    gemm_phase<pg8::EpiResid, StaticOrder, true, true>(lds, g, S, E, tid); } PH_END_NF
                PH_BEGIN {
                    const Gemm g{xb, (const bfr*)(wl + OFF_XQ), M, D, D, D, D, 0, 256L * D}; StaticOrder S; S.init(M, D, G, bx);
                    const pg8::EpiScaleBf16 E{qx, D, 0.0625f * LOG2E, 0, 0, 1.f, stats, false};
                    gemm_phase<pg8::EpiScaleBf16, StaticOrder, true, true>(lds, g, S, E, tid);
                    asm volatile("s_waitcnt vmcnt(0)" ::: "memory"); __syncthreads(); if (tid == 0) { __builtin_amdgcn_fence(__ATOMIC_ACQUIRE, "agent"); asm volatile("s_waitcnt vmcnt(0)" ::: "memory"); } __syncthreads();
                    const Gemm gs{qx, kmem, M, D, 256, D, D, 256, 256};
                    const pg8::EpiSoftmax Es{Pb, D};
                    gemm_phase<pg8::EpiSoftmax, StaticOrder, false, true>(lds, gs, S, Es, tid);
                    asm volatile("s_waitcnt vmcnt(0)" ::: "memory"); __syncthreads(); if (tid == 0) { __builtin_amdgcn_fence(__ATOMIC_ACQUIRE, "agent"); asm volatile("s_waitcnt vmcnt(0)" ::: "memory"); } __syncthreads();
                    const Gemm go{Pb, vt, M, D, 256, D, 256, 256, 256L * 256};
                    const pg8::EpiScaleBf16 Eo{ox, D, 1.f, 0, 0, 1.f, nullptr, true};
                    gemm_phase<pg8::EpiScaleBf16, StaticOrder, true, true>(lds, go, S, Eo, tid);
                    { pg8::Unit u0; if (S.next(0, u0)) panel_sync((unsigned*)(ws + WS_PCNT) + (2 * l + 1) * 4096 + 64 * u0.pm); }
                    const Gemm gx{ox, (const bfr*)(wl + OFF_XO), M, D, D, D, D, 0, 256L * D};
                    const pg8::EpiResid Ex{xb, D, stats};
                    gemm_phase<pg8::EpiResid, StaticOrder, true, true>(lds, gx, S, Ex, tid); } PH_END
            }
    }
    { constexpr int l = 1; constexpr int f = 1;
            PH_BEGIN {
                const Gemm g{xb, (const bfr*)(wl + (f ? OFF_GU2 : OFF_GU1)), M, NGU, D, D, D, 0, 256L * D}; StaticOrder S; S.init(M, NGU, G, bx);
                const pg8::EpiSwiglu E{act, FF, (const LAS float*)(lds + RSTD_OFF)}; pg8::fill_rstd_table((LAS float*)(lds + RSTD_OFF), stats, S, tid);
                if (f == 0 && bx == 0 && tid < 16) __hip_atomic_store((unsigned*)(ws + WS_KPART) + tid, 0u, __ATOMIC_RELAXED, __HIP_MEMORY_SCOPE_AGENT);
                gemm_phase<pg8::EpiSwiglu, StaticOrder, true, true>(lds, g, S, E, tid);
                { In in;
#pragma unroll
                    for (int i = 0; i < 21; ++i) in.p[i] = a.in[i];
                    convert_in_idle_slot<1 + 2 * l + f>(in, ws, lds, bx, G, wave, lane); __syncthreads(); }
                if (f == 0) {
                    const Gemm gk{memn, (const bfr*)(wl + OFF_XKV), NMEM, D, D, D, D, 0, 256L * D}; StaticOrder Sk; Sk.init(NMEM, D, G, (bx + G - 128 % G) % G);
                    const pg8::EpiScaleBf16 Ek{kmem, D, 1.f, 0, 0, 1.f, nullptr, true};
                    gemm_phase<pg8::EpiScaleBf16, StaticOrder, true, true>(lds, gk, Sk, Ek, tid);
                    const Gemm gv{(const bfr*)(wl + OFF_XKV) + (size_t)D * D, memn, D, NMEM, D, D, D, 0, 256L * D}; StaticOrder Sv; Sv.init(D, NMEM, G, (bx + G - 132 % G) % G);
                    const pg8::EpiScaleBf16 Ev{vt, NMEM, 1.f, 0, 0, 1.f, nullptr, true};
                    gemm_phase<pg8::EpiScaleBf16, StaticOrder, true, true>(lds, gv, Sv, Ev, tid);
                } } PH_END_NF
            PH_BEGIN {
                const Gemm g{act, (const bfr*)(wl + (f ? OFF_D2 : OFF_D1)), M, D, FF, FF, FF, 0, 256L * FF}; StaticOrder S; S.init(M, D, G, bx);
                const pg8::EpiResid E{xb, D, stats};
                gemm_phase<pg8::EpiResid, StaticOrder, true, true>(lds, g, S, E, tid); } PH_END_NF
            if (f == 0) {
                PH_BEGIN {
                    const Gemm g{xb, (const bfr*)(wl + OFF_MI), M, ZP, D, D, D, 0, 256L * D}; StaticOrder S; S.init(M, ZP, G, bx);
                    const pg8::EpiMixIn E{z, ZP, attn_body::C2, (float*)(ws + WS_KPART), (const LAS float*)(lds + RSTD_OFF)}; pg8::fill_rstd_table((LAS float*)(lds + RSTD_OFF), stats, S, tid);
                    gemm_phase<pg8::EpiMixIn, StaticOrder, true, true>(lds, g, S, E, tid);
                    fgate_phase(xb, (const float*)(ws + WS_WF) + (size_t)l * NH * D, a.in[8] + l * NH, cl, ctot, (LAS float*)lds, bx, G, tid, lane, wave);
                    } PH_END
                PH_BEGIN {
                    const attn_body::AttnTensors AT{(const attn_body::bf16*)(z + 3 * CW), (const attn_body::bf16*)(z + 4 * CW), (const attn_body::bf16*)(z + 5 * CW), (attn_body::bf16*)(z + 3 * CW), cl, ctot, (const float*)(ws + WS_KPART), ZP};
                    attn_body::attn_phase<32>((char*)lds_raw, AT, G, vcu, tid);
                    } PH_END_NF
                PH_BEGIN {
                    const Gemm g{z + 4 * CW, (const bfr*)(wl + OFF_MO), M, D, D, ZP, D, 0, 256L * D}; StaticOrder S; S.init(M, D, G, bx);
                    { pg8::Unit u0; if (S.next(0, u0)) { const int pb = (u0.pm * 256 + u0.pn * 64) / 2;
                        mixnorm_phase(z, a.in[7] + (size_t)l * 3 * CW, a.in[9] + l * CW, a.in[10] + l * CW, pb + wave, pb + 32, 8, lane);
                        panel_sync((unsigned*)(ws + WS_PCNT) + (2 * l + 0) * 4096 + 64 * u0.pm); } }
                    const pg8::EpiResid E{xb, D, stats};
                    gemm_phase<pg8::EpiResid, StaticOrder, true, true>(lds, g, S, E, tid); } PH_END_NF
                PH_BEGIN {
                    const Gemm g{xb, (const bfr*)(wl + OFF_XQ), M, D, D, D, D, 0, 256L * D}; StaticOrder S; S.init(M, D, G, bx);
                    const pg8::EpiScaleBf16 E{qx, D, 0.0625f * LOG2E, 0, 0, 1.f, stats, false};
                    gemm_phase<pg8::EpiScaleBf16, StaticOrder, true, true>(lds, g, S, E, tid);
                    asm volatile("s_waitcnt vmcnt(0)" ::: "memory"); __syncthreads(); if (tid == 0) { __builtin_amdgcn_fence(__ATOMIC_ACQUIRE, "agent"); asm volatile("s_waitcnt vmcnt(0)" ::: "memory"); } __syncthreads();
                    const Gemm gs{qx, kmem, M, D, 256, D, D, 256, 256};
                    const pg8::EpiSoftmax Es{Pb, D};
                    gemm_phase<pg8::EpiSoftmax, StaticOrder, false, true>(lds, gs, S, Es, tid);
                    asm volatile("s_waitcnt vmcnt(0)" ::: "memory"); __syncthreads(); if (tid == 0) { __builtin_amdgcn_fence(__ATOMIC_ACQUIRE, "agent"); asm volatile("s_waitcnt vmcnt(0)" ::: "memory"); } __syncthreads();
                    const Gemm go{Pb, vt, M, D, 256, D, 256, 256, 256L * 256};
                    const pg8::EpiScaleBf16 Eo{ox, D, 1.f, 0, 0, 1.f, nullptr, true};
                    gemm_phase<pg8::EpiScaleBf16, StaticOrder, true, true>(lds, go, S, Eo, tid);
                    { pg8::Unit u0; if (S.next(0, u0)) panel_sync((unsigned*)(ws + WS_PCNT) + (2 * l + 1) * 4096 + 64 * u0.pm); }
                    const Gemm gx{ox, (const bfr*)(wl + OFF_XO), M, D, D, D, D, 0, 256L * D};
                    const pg8::EpiResid Ex{xb, D, stats};
                    gemm_phase<pg8::EpiResid, StaticOrder, true, true>(lds, gx, S, Ex, tid); } PH_END
            }
    }
    { const int l = 0; PH_BEGIN final_phase(xb, out, a.in[20], gw, NGW, lane); PH_END }
#undef PH_BEGIN
#undef PH_END
#undef PH_END_NF
}

extern "C" void kernel_launch(void* const* d_in, const int* in_sizes, int n_in, void* d_out, int out_size, void* d_ws, size_t ws_size, hipStream_t stream) {
    static int grid = 0;
    if (grid == 0) {
        if (n_in != 21 || out_size != M * D || ws_size < WS_END) { fprintf(stderr, "kernel_launch: unexpected problem (n_in %d, out %d, ws %zu)\n", n_in, out_size, ws_size); grid = -1; return; }
        int dev = 0, cus = 0, per_cu = 0;
        hipGetDevice(&dev); hipDeviceGetAttribute(&cus, hipDeviceAttributeMultiprocessorCount, dev);
        if (hipFuncSetAttribute((const void*)mk_fwd, hipFuncAttributeMaxDynamicSharedMemorySize, LDS_BYTES) != hipSuccess) { fprintf(stderr, "kernel_launch: hipFuncSetAttribute(%d B LDS) failed\n", LDS_BYTES); }
        if (hipOccupancyMaxActiveBlocksPerMultiprocessor(&per_cu, (const void*)mk_fwd, 512, LDS_BYTES) != hipSuccess || per_cu < 1) { fprintf(stderr, "kernel_launch: occupancy query says %d\n", per_cu); per_cu = 1; }
        (void)hipGetLastError();
        grid = cus;
        if (grid != 256) fprintf(stderr, "kernel_launch: %d CUs; built for 256\n", grid);
    }
    if (grid < 0) return;
    Args a{};
    for (int i = 0; i < 21; ++i) a.in[i] = (const float*)d_in[i];
    a.out = (float*)d_out; a.ws = (unsigned char*)d_ws;
#if MK_ONE_LAUNCH
    a.ph_lo = 0; a.ph_hi = NPH;
    if (hipMemsetAsync((char*)d_ws + WS_BAR, 0, 80 * KiB, stream) != hipSuccess) { fprintf(stderr, "kernel_launch: memset of the barrier words failed\n"); return; }
    void* args[] = {&a};
    hipError_t e = hipLaunchCooperativeKernel((const void*)mk_fwd, dim3(grid), dim3(512), args, LDS_BYTES, stream);
    if (e != hipSuccess) fprintf(stderr, "kernel_launch: cooperative launch failed: %s (grid %d)\n", hipGetErrorString(e), grid);
#else
    for (int p = 0; p < NPH; ++p) { a.ph_lo = p; a.ph_hi = p + 1; hipLaunchKernelGGL(mk_fwd, dim3(grid), dim3(512), LDS_BYTES, stream, a); }
#endif
}
```
